# Optimizing an MI355X kernel written in HIP

```python
import jax, jax.numpy as jnp
from jax import lax
import numpy as np

D_MODEL = 1024
BATCH = 8
SEQ = 4096
DEPTH = 4

HEAD_DIM = 64
MIX_WIDTH = D_MODEL
ATT_Q_HEADS = (MIX_WIDTH // 2) // HEAD_DIM
ATT_KV_HEADS = 2
ATT_GROUP = ATT_Q_HEADS // ATT_KV_HEADS
ATT_WIDTH = ATT_Q_HEADS * HEAD_DIM
ATT_KV_WIDTH = ATT_KV_HEADS * HEAD_DIM
WINDOW = 128
BLOCK = 128
RWKV_HEADS = (MIX_WIDTH // 4) // HEAD_DIM
RWKV_WIDTH = RWKV_HEADS * HEAD_DIM
DECAY_LORA = 64
ICLR_LORA = 64
GATE_LORA = 128
RWKV_GN_EPS = 64e-5
CONV_WIDTH = MIX_WIDTH - ATT_WIDTH - RWKV_WIDTH
CONV_K = 3
ATT_PROJ_WIDTH = ATT_WIDTH + 2 * ATT_KV_WIDTH
RWKV_SIZES = (RWKV_WIDTH, RWKV_WIDTH, RWKV_WIDTH, DECAY_LORA, ICLR_LORA, GATE_LORA)
RWKV_PROJ_WIDTH = 3 * RWKV_WIDTH + DECAY_LORA + ICLR_LORA + GATE_LORA
CONV_PROJ_WIDTH = 3 * CONV_WIDTH
PROJ_WIDTH = ATT_PROJ_WIDTH + RWKV_PROJ_WIDTH + CONV_PROJ_WIDTH
D_FF = 2816
N_MOD = 9
EPS = 1e-6

kernel_name = "hymba_style_hybrid_swa_rwkv7_shortconv_macaron_adaln"


def rms_norm(x, gain):
    xf = x.astype(jnp.float32)
    y = xf * lax.rsqrt(jnp.mean(xf * xf, axis=-1, keepdims=True) + EPS)
    return (y * gain.astype(jnp.float32)).astype(x.dtype)


def swiglu(x, w_in, w_out):
    gate, up = jnp.split(x @ w_in, 2, axis=-1)
    return (jax.nn.silu(gate) * up) @ w_out


def token_shift(p):
    return jnp.pad(p, ((0, 0), (1, 0), (0, 0)))[:, :-1]


def sliding_window_sink_attention(qkv, q_gain, k_gain, sinks):
    B, T, _ = qkv.shape
    nb = T // BLOCK
    q, k, v = jnp.split(qkv, [ATT_WIDTH, ATT_WIDTH + ATT_KV_WIDTH], axis=-1)
    q = rms_norm(q.reshape(B, T, ATT_Q_HEADS, HEAD_DIM), q_gain)
    k = rms_norm(k.reshape(B, T, ATT_KV_HEADS, HEAD_DIM), k_gain)
    v = v.reshape(B, T, ATT_KV_HEADS, HEAD_DIM)
    qb = q.reshape(B, nb, BLOCK, ATT_KV_HEADS, ATT_GROUP, HEAD_DIM)

    def band(z):
        zb = z.reshape(B, nb, BLOCK, ATT_KV_HEADS, HEAD_DIM)
        prev = jnp.pad(zb, ((0, 0), (1, 0), (0, 0), (0, 0), (0, 0)))[:, :-1]
        return jnp.concatenate([prev, zb], axis=2)

    kb, vb = band(k), band(v)
    scores = jnp.einsum('bnqhgd,bnkhd->bnhgqk', qb, kb).astype(jnp.float32) * (HEAD_DIM ** -0.5)
    blk = jnp.arange(nb)[:, None, None] * BLOCK
    q_pos = blk + jnp.arange(BLOCK)[None, :, None]
    k_pos = blk - BLOCK + jnp.arange(2 * BLOCK)[None, None, :]
    diff = q_pos - k_pos
    mask = (k_pos >= 0) & (diff >= 0) & (diff < WINDOW)
    scores = jnp.where(mask[None, :, None, None], scores, -jnp.inf)
    sink = sinks.astype(jnp.float32).reshape(ATT_KV_HEADS, ATT_GROUP)[None, None, :, :, None, None]
    sink = jnp.broadcast_to(sink, scores.shape[:-1] + (1,))
    probs = jax.nn.softmax(jnp.concatenate([scores, sink], axis=-1), axis=-1)[..., :-1]
    out = jnp.einsum('bnhgqk,bnkhd->bnqhgd', probs.astype(v.dtype), vb)
    return out.reshape(B, T, ATT_WIDTH)


def rwkv7_time_mix(p, mu, w0, w_w2, a0, w_a2, w_g2, k_k, k_a, r_k, gn_w, gn_b):
    B, T, _ = p.shape
    f32 = jnp.float32
    p = p + mu * (token_shift(p) - p)
    r, k, v, wd, ad, gd = jnp.split(p, np.cumsum(RWKV_SIZES)[:-1].tolist(), axis=-1)
    r, k, v = r.astype(f32), k.astype(f32), v.astype(f32)
    w_log = -jax.nn.softplus(-(w0 + jnp.tanh(wd) @ w_w2).astype(f32)) - 0.5
    decay = jnp.exp(-jnp.exp(w_log))
    a = jax.nn.sigmoid((a0 + ad @ w_a2).astype(f32))
    g = (jax.nn.sigmoid(gd) @ w_g2).astype(f32)
    kk = (k * k_k).reshape(B, T, RWKV_HEADS, HEAD_DIM)
    kk = kk / jnp.maximum(jnp.linalg.norm(kk, axis=-1, keepdims=True), 1e-12)
    k = k * (1.0 + (a - 1.0) * k_a)
    hs = lambda z: z.reshape(B, T, RWKV_HEADS, HEAD_DIM)
    r, k, v, a, decay = hs(r), hs(k), hs(v), hs(a), hs(decay)

    def step(S, inp):
        r_t, w_t, k_t, v_t, kk_t, a_t = inp
        s_kk = jnp.einsum('bhvk,bhk->bhv', S, kk_t)
        S = (S * w_t[:, :, None, :] - s_kk[..., None] * (kk_t * a_t)[:, :, None, :]
             + v_t[..., None] * k_t[:, :, None, :])
        return S, jnp.einsum('bhvk,bhk->bhv', S, r_t)

    xs = tuple(jnp.swapaxes(z, 0, 1) for z in (r, decay, k, v, kk, a))
    S0 = jnp.zeros((B, RWKV_HEADS, HEAD_DIM, HEAD_DIM), f32)
    _, y = lax.scan(step, S0, xs)
    y = jnp.swapaxes(y, 0, 1)
    mean = jnp.mean(y, axis=-1, keepdims=True)
    var = jnp.mean(jnp.square(y - mean), axis=-1, keepdims=True)
    y = ((y - mean) * lax.rsqrt(var + RWKV_GN_EPS)).reshape(B, T, RWKV_WIDTH) * gn_w + gn_b
    bonus = jnp.sum(r * k * r_k, axis=-1, keepdims=True) * v
    y = (y + bonus.reshape(B, T, RWKV_WIDTH)) * g
    return y.astype(p.dtype)


def short_conv_mix(p, conv_w):
    b_gate, c_gate, h = jnp.split(p, [CONV_WIDTH, 2 * CONV_WIDTH], axis=-1)
    u = c_gate * h
    y = lax.conv_general_dilated(u, conv_w[:, None, :].astype(u.dtype), window_strides=(1,),
                                 padding=[(CONV_K - 1, 0)], dimension_numbers=('NWC', 'WIO', 'NWC'),
                                 feature_group_count=CONV_WIDTH)
    return b_gate * y


def setup_inputs(seed: int = 0) -> dict:
    key = jax.random.key(seed)
    ks = iter(jax.random.split(key, 32))
    nrm = lambda shape, s: jax.random.normal(next(ks), shape, jnp.float32) * s
    L, D = DEPTH, D_MODEL
    return {
        'x': nrm((BATCH, SEQ, D), 1.0),
        'c': nrm((BATCH, D), 1.0),
        'w_ada': nrm((L, D, N_MOD * D), 0.1 * D ** -0.5),
        'b_ada': nrm((L, N_MOD * D), 0.01),
        'g_ffn1': 1.0 + nrm((L, D), 0.05),
        'w_ffn1_in': nrm((L, D, 2 * D_FF), D ** -0.5),
        'w_ffn1_out': nrm((L, D_FF, D), D_FF ** -0.5),
        'g_mix': 1.0 + nrm((L, D), 0.05),
        'w_mix_in': nrm((L, D, PROJ_WIDTH), D ** -0.5),
        'w_mix_out': nrm((L, MIX_WIDTH, D), MIX_WIDTH ** -0.5),
        'att_q_gain': 1.0 + nrm((L, HEAD_DIM), 0.05),
        'att_k_gain': 1.0 + nrm((L, HEAD_DIM), 0.05),
        'att_sinks': nrm((L, ATT_Q_HEADS), 1.0),
        'rwkv_mu': jax.random.uniform(next(ks), (L, RWKV_PROJ_WIDTH), jnp.float32),
        'rwkv_w0': jax.random.uniform(next(ks), (L, RWKV_WIDTH), jnp.float32, -6.0, -1.0),
        'rwkv_w_w2': nrm((L, DECAY_LORA, RWKV_WIDTH), 0.1 * DECAY_LORA ** -0.5),
        'rwkv_a0': nrm((L, RWKV_WIDTH), 0.1),
        'rwkv_a_w2': nrm((L, ICLR_LORA, RWKV_WIDTH), 0.1 * ICLR_LORA ** -0.5),
        'rwkv_g_w2': nrm((L, GATE_LORA, RWKV_WIDTH), GATE_LORA ** -0.5),
        'rwkv_k_k': 1.0 + nrm((L, RWKV_WIDTH), 0.1),
        'rwkv_k_a': 1.0 + nrm((L, RWKV_WIDTH), 0.1),
        'rwkv_r_k': nrm((L, RWKV_HEADS, HEAD_DIM), 0.1),
        'rwkv_gn_w': 1.0 + nrm((L, RWKV_WIDTH), 0.05),
        'rwkv_gn_b': nrm((L, RWKV_WIDTH), 0.01),
        'conv_w': nrm((L, CONV_K, CONV_WIDTH), CONV_K ** -0.5),
        'g_ffn2': 1.0 + nrm((L, D), 0.05),
        'w_ffn2_in': nrm((L, D, 2 * D_FF), D ** -0.5),
        'w_ffn2_out': nrm((L, D_FF, D), D_FF ** -0.5),
    }


def reference(x, c, w_ada, b_ada, g_ffn1, w_ffn1_in, w_ffn1_out, g_mix, w_mix_in, w_mix_out,
              att_q_gain, att_k_gain, att_sinks, rwkv_mu, rwkv_w0, rwkv_w_w2, rwkv_a0, rwkv_a_w2,
              rwkv_g_w2, rwkv_k_k, rwkv_k_a, rwkv_r_k, rwkv_gn_w, rwkv_gn_b, conv_w,
              g_ffn2, w_ffn2_in, w_ffn2_out):
    h = x
    B = x.shape[0]
    c_act = jax.nn.silu(c)
    for l in range(DEPTH):
        mod = (c_act @ w_ada[l] + b_ada[l]).reshape(B, N_MOD, D_MODEL)
        sh1, sc1, gt1, sh2, sc2, gt2, sh3, sc3, gt3 = [mod[:, i, None, :] for i in range(N_MOD)]
        hn = rms_norm(h, g_ffn1[l]) * (1.0 + sc1) + sh1
        h = h + 0.5 * (1.0 + gt1) * swiglu(hn, w_ffn1_in[l], w_ffn1_out[l])
        hn = rms_norm(h, g_mix[l]) * (1.0 + sc2) + sh2
        proj = hn @ w_mix_in[l]
        p_att, p_rwkv, p_conv = jnp.split(proj, [ATT_PROJ_WIDTH, ATT_PROJ_WIDTH + RWKV_PROJ_WIDTH], axis=-1)
        y_att = sliding_window_sink_attention(p_att, att_q_gain[l], att_k_gain[l], att_sinks[l])
        y_rwkv = rwkv7_time_mix(p_rwkv, rwkv_mu[l], rwkv_w0[l], rwkv_w_w2[l], rwkv_a0[l], rwkv_a_w2[l],
                                rwkv_g_w2[l], rwkv_k_k[l], rwkv_k_a[l], rwkv_r_k[l], rwkv_gn_w[l], rwkv_gn_b[l])
        y_conv = short_conv_mix(p_conv, conv_w[l])
        mixed = jnp.concatenate([y_att, y_rwkv, y_conv], axis=-1) @ w_mix_out[l]
        h = h + (1.0 + gt2) * mixed
        hn = rms_norm(h, g_ffn2[l]) * (1.0 + sc3) + sh3
        h = h + 0.5 * (1.0 + gt3) * swiglu(hn, w_ffn2_in[l], w_ffn2_out[l])
    return h
```

```cpp
#define ATTN_VAR(l) (P.ph_hi > 100000 ? (l) + 1 : 0)
#include <hip/hip_runtime.h>
#include <hip/hip_cooperative_groups.h>
#include <cstdio>
#include <cstdint>
namespace cg = cooperative_groups;

#ifndef MK_LAUNCHES
#define MK_LAUNCHES 1
#endif

namespace pg8 {
#define PG8_LAS __attribute__((address_space(3)))
typedef unsigned short bf16_t;
typedef short bf16x8 __attribute__((ext_vector_type(8)));
typedef float f32x4 __attribute__((ext_vector_type(4)));
typedef unsigned u32x4 __attribute__((ext_vector_type(4)));
constexpr int BM = 256, BK = 64, HALF = 128, HTB = HALF * BK * 2  , STAGE_BYTES = 8 * HTB, NXCD = 8, WGM = 8;

__host__ __device__ __forceinline__ int lds_byte(int r, int c) { const int st = (r >> 4) * 2 + (c >> 5), rr = r & 15, cc = c & 31, ob = rr * 64 + cc * 2; return st * 1024 + (ob ^ (((ob >> 9) & 1) << 5)); }
__host__ __device__ __forceinline__ void stage_rc(int b, int& R, int& C) { const int st = b / 1024, sb = b % 1024, swz = sb ^ (((sb >> 9) & 1) << 5); R = (st >> 1) * 16 + swz / 64; C = (st & 1) * 32 + (swz % 64) / 2; }
__host__ __device__ __forceinline__ int perm32(int rho) { const int n = rho >> 4, i = rho & 15; return 8 * (i >> 2) + 4 * n + (i & 3); }

struct Unit { int pm, pn; };
struct Gemm { const bf16_t* A; const bf16_t* Bt; int M, N, K; };

struct StaticOrder {
    int nM, nN, nwg, G, c;
    __host__ __device__ void init(int M, int N, int G_, int c_) { nM = M / BM; nN = N / BM; nwg = nM * nN; G = G_; c = c_; }
    __host__ __device__ bool next(int i, Unit& u) const {
        const long L = (long)i * G + c; if (L >= nwg) return false;
        int wgid = (int)L; { const int q = nwg / NXCD, r = nwg % NXCD, xcd = wgid % NXCD, off = wgid / NXCD; wgid = (xcd < r ? xcd * (q + 1) : r * (q + 1) + (xcd - r) * q) + off; }
        const int nig = WGM * nN, gid = wgid / nig, fm = gid * WGM, gsz = (nM - fm) < WGM ? (nM - fm) : WGM;
        u.pm = fm + ((wgid % nig) % gsz); u.pn = (wgid % nig) / gsz; return true;
    }
    __device__ __forceinline__ void a_ready(const Unit&) const {}
    __device__ __forceinline__ void done(const Unit&) const {}
};
typedef __bf16 bf16v2_t __attribute__((ext_vector_type(2)));
typedef float f32x2_t __attribute__((ext_vector_type(2)));
__device__ __forceinline__ unsigned cvt_pk_bf16(float lo, float hi) { const f32x2_t v = {lo, hi}; const bf16v2_t b = __builtin_convertvector(v, bf16v2_t); return __builtin_bit_cast(unsigned, b); }

template <class Epi, class Sched>
__device__ __forceinline__ void gemm_phase(PG8_LAS unsigned char* lds, const Gemm g, const Sched& S, const Epi& E, const int tid) {
    const int wid = __builtin_amdgcn_readfirstlane(tid >> 6), lane = tid & 63, wr = wid >> 2, wc = wid & 3, fr = lane & 15, fq = lane >> 4;
    const int K = g.K, nt = K / BK;
    unsigned voffA[2], voffB[2];
#pragma unroll
    for (int i = 0; i < 2; ++i) { int R, C; stage_rc(tid * 16 + i * 8192, R, C); const int Rb = E.perm ? ((R & ~31) + perm32(R & 31)) : R;
        voffA[i] = (unsigned)(R * K + C) * 2u; voffB[i] = (unsigned)(Rb * K + C) * 2u; }
    const size_t kstep = (size_t)(BK * 2);
    const size_t hstep = (size_t)HALF * K * 2;
    const size_t tstep = 2 * hstep;
    const unsigned ldsw = (unsigned)wid * 1024u;
    const int aoff = lds_byte(wr * 64 + fr, fq * 8), boff = lds_byte(wc * 32 + fr, fq * 8);
#define PG8_SA(b, h) (((b) * 2 + (h)) * HTB)
#define PG8_SB(b, h) ((4 + (b) * 2 + (h)) * HTB)
#define PG8_STAGE(bufoff, gbase, voff) do { _Pragma("unroll") for (int _i = 0; _i < 2; ++_i) \
        __builtin_amdgcn_global_load_lds((const unsigned*)((const char*)(gbase) + (voff)[_i]), (PG8_LAS unsigned*)(lds + (bufoff) + ldsw + _i * 8192), 16, 0, 0); } while (0)
#define PG8_LDA(dst, b, h) do { _Pragma("unroll") for (int m = 0; m < 4; ++m) _Pragma("unroll") for (int k = 0; k < 2; ++k) dst[m][k] = *(const PG8_LAS bf16x8*)(lds + PG8_SA(b, h) + aoff + m * 2048 + k * 1024); } while (0)
#define PG8_LDB(dst, b, h) do { _Pragma("unroll") for (int n = 0; n < 2; ++n) _Pragma("unroll") for (int k = 0; k < 2; ++k) dst[n][k] = *(const PG8_LAS bf16x8*)(lds + PG8_SB(b, h) + boff + n * 2048 + k * 1024); } while (0)
#define PG8_MMA(ai, bj, At, Bt) do { __builtin_amdgcn_s_setprio(1); _Pragma("unroll") for (int m = 0; m < 4; ++m) _Pragma("unroll") for (int n = 0; n < 2; ++n) _Pragma("unroll") for (int k = 0; k < 2; ++k) \
        acc[ai][bj][m][n] = __builtin_amdgcn_mfma_f32_16x16x32_bf16(Bt[n][k], At[m][k], acc[ai][bj][m][n], 0, 0, 0); __builtin_amdgcn_s_setprio(0); } while (0)
#define PG8_WAIT_V(n) asm volatile("s_waitcnt vmcnt(" #n ")" ::: "memory")
#define PG8_WAIT_L(n) asm volatile("s_waitcnt lgkmcnt(" #n ")" ::: "memory")
#define PG8_BAR __builtin_amdgcn_s_barrier()
#define PG8_SCHED __builtin_amdgcn_sched_barrier(0)
    Unit cur, nxt; int ui = 0;
    if (!S.next(0, cur)) return;
    f32x4 acc[2][2][4][2];
#pragma unroll
    for (int a = 0; a < 2; ++a)
#pragma unroll
        for (int b = 0; b < 2; ++b)
#pragma unroll
            for (int m = 0; m < 4; ++m)
#pragma unroll
                for (int n = 0; n < 2; ++n) acc[a][b][m][n] = (f32x4){0.f, 0.f, 0.f, 0.f};
    bf16x8 At[4][2], B0[2][2], B1[2][2];
    const char* cA = (const char*)g.A + (size_t)cur.pm * tstep; const char* cB = (const char*)g.Bt + (size_t)cur.pn * tstep;
    S.a_ready(cur);
    PG8_STAGE(PG8_SB(0, 0), cB, voffB); PG8_STAGE(PG8_SA(0, 0), cA, voffA); PG8_STAGE(PG8_SB(0, 1), cB + hstep, voffB); PG8_STAGE(PG8_SA(0, 1), cA + hstep, voffA);
    if (wr == 1) PG8_BAR;
    PG8_WAIT_V(4); PG8_BAR;
    PG8_STAGE(PG8_SB(1, 0), cB + kstep, voffB); PG8_STAGE(PG8_SA(1, 0), cA + kstep, voffA); PG8_STAGE(PG8_SB(1, 1), cB + hstep + kstep, voffB);
    PG8_WAIT_V(6); PG8_BAR;
    for (;;) {
        const bool has_next = S.next(ui + 1, nxt);
        const char* nA = has_next ? (const char*)g.A + (size_t)nxt.pm * tstep : cA; const char* nB = has_next ? (const char*)g.Bt + (size_t)nxt.pn * tstep : cB;
        for (int t = 0; t < nt; t += 2) {
            const bool last = (t == nt - 2);
            const char* a1 = cA + (size_t)(t + 1) * kstep;
            const char* a2 = last ? nA : cA + (size_t)(t + 2) * kstep; const char* b2 = last ? nB : cB + (size_t)(t + 2) * kstep;
            const char* a3 = a2 + kstep; const char* b3 = b2 + kstep;
            if (last && has_next) S.a_ready(nxt);
            PG8_LDB(B0, 0, 0); PG8_SCHED; PG8_LDA(At, 0, 0); PG8_STAGE(PG8_SA(1, 1), a1 + hstep, voffA);
            PG8_WAIT_L(8); PG8_BAR; PG8_WAIT_L(0); PG8_MMA(0, 0, At, B0); PG8_BAR; PG8_SCHED;
            PG8_LDB(B1, 0, 1); PG8_STAGE(PG8_SB(0, 0), b2, voffB);
            PG8_BAR; PG8_WAIT_L(0); PG8_MMA(0, 1, At, B1); PG8_BAR;
            PG8_LDA(At, 0, 1); PG8_STAGE(PG8_SA(0, 0), a2, voffA);
            PG8_BAR; PG8_WAIT_L(0); PG8_MMA(1, 0, At, B0); PG8_BAR; PG8_SCHED;
            PG8_STAGE(PG8_SB(0, 1), b2 + hstep, voffB);
            PG8_WAIT_V(6); PG8_BAR; PG8_MMA(1, 1, At, B1); PG8_BAR;
            PG8_LDB(B0, 1, 0); PG8_SCHED; PG8_LDA(At, 1, 0); PG8_STAGE(PG8_SA(0, 1), a2 + hstep, voffA);
            PG8_WAIT_L(8); PG8_BAR; PG8_WAIT_L(0); PG8_MMA(0, 0, At, B0); PG8_BAR; PG8_SCHED;
            PG8_LDB(B1, 1, 1); PG8_STAGE(PG8_SB(1, 0), b3, voffB);
            PG8_BAR; PG8_WAIT_L(0); PG8_MMA(0, 1, At, B1); PG8_BAR;
            PG8_LDA(At, 1, 1); PG8_STAGE(PG8_SA(1, 0), a3, voffA);
            PG8_BAR; PG8_WAIT_L(0); PG8_MMA(1, 0, At, B0); PG8_BAR; PG8_SCHED;
            PG8_STAGE(PG8_SB(1, 1), b3 + hstep, voffB);
            PG8_WAIT_V(6); PG8_BAR; PG8_MMA(1, 1, At, B1); PG8_BAR;
        }
        if constexpr (!Epi::AFTER_DRAIN) { E(acc, cur, wr, wc, fr, fq); S.done(cur); }
        if (!has_next) break;
#pragma unroll
        for (int a = 0; a < 2; ++a)
#pragma unroll
            for (int b = 0; b < 2; ++b)
#pragma unroll
                for (int m = 0; m < 4; ++m)
#pragma unroll
                    for (int n = 0; n < 2; ++n) acc[a][b][m][n] = (f32x4){0.f, 0.f, 0.f, 0.f};
        cur = nxt; cA = nA; cB = nB; ++ui;
    }
    PG8_WAIT_V(0);
    if (wr == 0) PG8_BAR;
    PG8_BAR;
    if constexpr (Epi::AFTER_DRAIN) { E.fused(acc, cur, wr, wc, fr, fq, lds, wid, lane); S.done(cur); }
#undef PG8_SA
#undef PG8_SB
#undef PG8_STAGE
#undef PG8_LDA
#undef PG8_LDB
#undef PG8_MMA
#undef PG8_WAIT_V
#undef PG8_WAIT_L
#undef PG8_BAR
#undef PG8_SCHED
}

__device__ __forceinline__ float silu_f(float x) { return x * __builtin_amdgcn_rcpf(1.f + __builtin_amdgcn_exp2f(-1.44269504089f * x)); }

struct EpiSwiglu {
    static constexpr bool PERM = true, AFTER_DRAIN = false;
    bf16_t* O;
    __device__ __forceinline__ void operator()(const f32x4 (&acc)[2][2][4][2], const Unit& u, int wr, int wc, int fr, int fq) const {
        const int row0 = u.pm * BM + wr * 64 + fr, col0 = u.pn * 128 + wc * 32 + 8 * fq;
#pragma unroll
        for (int ai = 0; ai < 2; ++ai)
#pragma unroll
            for (int m = 0; m < 4; ++m) {
                bf16_t* rowp = O + (size_t)(row0 + ai * HALF + m * 16) * 2816 + col0;
                const f32x4 g0 = acc[ai][0][m][0], g1 = acc[ai][0][m][1], u0 = acc[ai][1][m][0], u1 = acc[ai][1][m][1];
                u32x4 o;
                o.x = cvt_pk_bf16(silu_f(g0[0]) * u0[0], silu_f(g0[1]) * u0[1]); o.y = cvt_pk_bf16(silu_f(g0[2]) * u0[2], silu_f(g0[3]) * u0[3]);
                o.z = cvt_pk_bf16(silu_f(g1[0]) * u1[0], silu_f(g1[1]) * u1[1]); o.w = cvt_pk_bf16(silu_f(g1[2]) * u1[2], silu_f(g1[3]) * u1[3]);
                *(u32x4*)rowp = o;
            }
    }
};
struct EpiResid {
    static constexpr bool PERM = false, AFTER_DRAIN = false;
    const float* hin; float* hout; const float* gt; float scale;
    __device__ __forceinline__ void operator()(const f32x4 (&acc)[2][2][4][2], const Unit& u, int wr, int wc, int fr, int fq) const {
        const int row0 = u.pm * BM + wr * 64 + fr, col0 = u.pn * BM + wc * 32 + 4 * fq;
        const float* gp = gt + (size_t)(u.pm >> 4) * 9216 + col0;
        f32x4 gv[2][2];
#pragma unroll
        for (int bj = 0; bj < 2; ++bj)
#pragma unroll
            for (int n = 0; n < 2; ++n) { const f32x4 t = *(const f32x4*)(gp + bj * HALF + n * 16); gv[bj][n] = (t + 1.0f) * scale; }
#pragma unroll
        for (int ai = 0; ai < 2; ++ai)
#pragma unroll
            for (int m = 0; m < 4; ++m) {
                const size_t off = (size_t)(row0 + ai * HALF + m * 16) * 1024 + col0;
#pragma unroll
                for (int bj = 0; bj < 2; ++bj)
#pragma unroll
                    for (int n = 0; n < 2; ++n) {
                        const f32x4 hv = *(const f32x4*)(hin + off + bj * HALF + n * 16);
                        *(f32x4*)(hout + off + bj * HALF + n * 16) = hv + gv[bj][n] * acc[ai][bj][m][n];
                    }
            }
    }
};
struct EpiProj {
    static constexpr bool PERM = false, AFTER_DRAIN = false;
    bf16_t* att; float* rw; bf16_t* cv;
    __device__ __forceinline__ void operator()(const f32x4 (&acc)[2][2][4][2], const Unit& u, int wr, int wc, int fr, int fq) const {
        const int row0 = u.pm * BM + wr * 64 + fr, cl = wc * 32 + 4 * fq;
        if (u.pn >= 3 && u.pn < 7) {
            const int col0 = (u.pn - 3) * BM + cl;
#pragma unroll
            for (int ai = 0; ai < 2; ++ai)
#pragma unroll
                for (int m = 0; m < 4; ++m) { float* rowp = rw + (size_t)(row0 + ai * HALF + m * 16) * 1024 + col0;
#pragma unroll
                    for (int bj = 0; bj < 2; ++bj)
#pragma unroll
                        for (int n = 0; n < 2; ++n) *(f32x4*)(rowp + bj * HALF + n * 16) = acc[ai][bj][m][n]; }
        } else {
            bf16_t* base = u.pn < 3 ? att : cv; const int col0 = (u.pn < 3 ? u.pn : u.pn - 7) * BM + cl;
#pragma unroll
            for (int ai = 0; ai < 2; ++ai)
#pragma unroll
                for (int m = 0; m < 4; ++m) { bf16_t* rowp = base + (size_t)(row0 + ai * HALF + m * 16) * 768 + col0;
#pragma unroll
                    for (int bj = 0; bj < 2; ++bj)
#pragma unroll
                        for (int n = 0; n < 2; ++n) { const f32x4 v = acc[ai][bj][m][n]; uint2 o; o.x = cvt_pk_bf16(v[0], v[1]); o.y = cvt_pk_bf16(v[2], v[3]); *(uint2*)(rowp + bj * HALF + n * 16) = o; } }
        }
    }
};
struct EpiAny {
    int kind; bool perm;
    EpiSwiglu sw; EpiResid rs; EpiProj pj;
    static constexpr bool AFTER_DRAIN = false;
    __device__ __forceinline__ void operator()(const f32x4 (&acc)[2][2][4][2], const Unit& u, int wr, int wc, int fr, int fq) const {
        if (kind == 0) sw(acc, u, wr, wc, fr, fq); else if (kind == 1) rs(acc, u, wr, wc, fr, fq); else pj(acc, u, wr, wc, fr, fq);
    }
};
}

#define LAS __attribute__((address_space(3)))
using pg8::bf16_t; using pg8::bf16x8; using pg8::f32x4; using pg8::u32x4; using pg8::cvt_pk_bf16;
constexpr int NTOK = 32768, SEQL = 4096, DM = 1024, DFF = 2816, DEPTH = 4;
constexpr int LDS_BYTES = 131072;
constexpr int PPL = 14;
constexpr int NPH = 1 + DEPTH * PPL;

constexpr size_t OFF_MOD = 0;
constexpr size_t OFF_LORA = OFF_MOD + 1179648;
constexpr size_t OFF_BONUS = OFF_LORA + 131072;
constexpr size_t OFF_WB = OFF_BONUS + 524288;
constexpr size_t WB_FFN1IN = 0, WB_FFN1OUT = 5767168, WB_MIXIN = WB_FFN1OUT + 2883584, WB_MIXOUT = WB_MIXIN + 2621440,
                 WB_FFN2IN = WB_MIXOUT + 1048576, WB_FFN2OUT = WB_FFN2IN + 5767168, WB_ELEMS = WB_FFN2OUT + 2883584;
constexpr size_t OFF_HN = OFF_WB + WB_ELEMS * 2;
constexpr size_t OFF_R1 = OFF_HN + (size_t)NTOK * 1024 * 2;
constexpr size_t R1_CONV = (size_t)NTOK * 768 * 2, R1_RWKV = 2 * R1_CONV, R1_BYTES = R1_RWKV + (size_t)NTOK * 1024 * 4;
constexpr size_t OFF_R2 = OFF_R1 + R1_BYTES;
constexpr size_t R2_G = (size_t)NTOK * 4 * 384 * 4;
constexpr size_t WS_END = OFF_R2 + R2_G + (size_t)NTOK * 256 * 2;

struct Params { const float* in[28]; float* out; unsigned char* ws; int ph_lo, ph_hi; };

__device__ __forceinline__ float wave_sum(float v) {
#pragma unroll
    for (int o = 1; o < 64; o <<= 1) v += __shfl_xor(v, o);
    return v;
}
template <int CTRL> __device__ __forceinline__ float dpp_f(float x) { return __int_as_float(__builtin_amdgcn_update_dpp(0, __float_as_int(x), CTRL, 0xf, 0xf, true)); }
__device__ __forceinline__ float rowsum16(float x) {
    x += dpp_f<0x128>(x); x += dpp_f<0x124>(x); x += dpp_f<0x122>(x); x += dpp_f<0x121>(x); return x;
}
__device__ __forceinline__ float bflo(unsigned u) { return __uint_as_float(u << 16); }
__device__ __forceinline__ float bfhi(unsigned u) { return __uint_as_float(u & 0xffff0000u); }
__device__ __forceinline__ float sigmoid_f(float x) { return __builtin_amdgcn_rcpf(1.f + __builtin_amdgcn_exp2f(-1.44269504089f * x)); }

__device__ __forceinline__ void phase_mod(const Params& P, LAS unsigned char* lds, int tid, int wid, int lane, int bid, int nblk) {
    LAS float* cact = (LAS float*)lds;
    LAS float* red = (LAS float*)(lds + 32768);
    const float* c = P.in[1];
    float* MOD = (float*)(P.ws + OFF_MOD);
    for (int i = tid; i < 8192; i += 512) { const float v = c[i]; cact[i] = v / (1.f + __expf(-v)); }
    __syncthreads();
    for (int item = bid; item < 288; item += nblk) {
        const int l = item / 72, j0 = (item % 72) * 128, k0 = wid * 128;
        const float* W = P.in[2] + (size_t)l * 1024 * 9216 + j0 + 2 * lane;
        float a0[8], a1[8];
#pragma unroll
        for (int b = 0; b < 8; ++b) { a0[b] = 0.f; a1[b] = 0.f; }
#pragma unroll 8
        for (int k = 0; k < 128; ++k) {
            const float2 w = *(const float2*)(W + (size_t)(k0 + k) * 9216);
#pragma unroll
            for (int b = 0; b < 8; ++b) { const float ca = cact[b * 1024 + k0 + k]; a0[b] += ca * w.x; a1[b] += ca * w.y; }
        }
#pragma unroll
        for (int b = 0; b < 8; ++b) { red[(wid * 8 + b) * 128 + 2 * lane] = a0[b]; red[(wid * 8 + b) * 128 + 2 * lane + 1] = a1[b]; }
        __syncthreads();
        for (int o = tid; o < 1024; o += 512) {
            const int b = o >> 7, ci = o & 127; float s = 0.f;
#pragma unroll
            for (int w = 0; w < 8; ++w) s += red[(w * 8 + b) * 128 + ci];
            MOD[(size_t)(l * 8 + b) * 9216 + j0 + ci] = s + P.in[3][l * 9216 + j0 + ci];
        }
        __syncthreads();
    }
}

__device__ __forceinline__ void transpose_item(const float* W, int K, int N, bf16_t* WT, int k0, int n0, int drow0, LAS float* scr, int lane) {
#pragma unroll 8
    for (int i = 0; i < 32; ++i) { const int kk = 2 * i + (lane >> 5); scr[kk * 33 + (lane & 31)] = W[(size_t)(k0 + kk) * N + n0 + (lane & 31)]; }
    asm volatile("s_waitcnt lgkmcnt(0)" ::: "memory");
    const int c = lane & 7;
#pragma unroll
    for (int j = 0; j < 4; ++j) { const int n = (lane >> 3) + 8 * j; const LAS float* s = scr + (8 * c) * 33 + n;
        u32x4 o; o.x = cvt_pk_bf16(s[0 * 33], s[1 * 33]); o.y = cvt_pk_bf16(s[2 * 33], s[3 * 33]); o.z = cvt_pk_bf16(s[4 * 33], s[5 * 33]); o.w = cvt_pk_bf16(s[6 * 33], s[7 * 33]);
        *(u32x4*)(WT + (size_t)(drow0 + n) * K + k0 + 8 * c) = o; }
    asm volatile("s_waitcnt lgkmcnt(0)" ::: "memory");
}
__device__ __forceinline__ int swiglu_row(int n0) { return n0 < DFF ? ((n0 >> 7) * 256 + (n0 & 127)) : (((n0 - DFF) >> 7) * 256 + 128 + ((n0 - DFF) & 127)); }
__device__ __forceinline__ void phase_convert(const Params& P, int l, LAS unsigned char* lds, int wid, int lane, int bid, int nblk) {
    LAS float* scr = (LAS float*)(lds + wid * 8448);
    bf16_t* WB = (bf16_t*)(P.ws + OFF_WB);
    bf16_t* LT = (bf16_t*)(P.ws + OFF_LORA);
    const int gw = bid * 8 + wid, NGW = nblk * 8;
    constexpr int I_IN = 16 * 176, I_OUT = 44 * 32, I_MI = 16 * 80, I_MO = 16 * 32;
    constexpr int NIT = 2 * I_IN + 2 * I_OUT + I_MI + I_MO + 32;
    for (int it = gw; it < NIT; it += NGW) {
        int r = it;
        if (r < I_IN) { const int kb = r / 176, nb = r % 176; transpose_item(P.in[5] + (size_t)l * 1024 * 5632, 1024, 5632, WB + WB_FFN1IN, kb * 64, nb * 32, swiglu_row(nb * 32), scr, lane); continue; } r -= I_IN;
        if (r < I_OUT) { const int kb = r / 32, nb = r % 32; transpose_item(P.in[6] + (size_t)l * 2816 * 1024, 2816, 1024, WB + WB_FFN1OUT, kb * 64, nb * 32, nb * 32, scr, lane); continue; } r -= I_OUT;
        if (r < I_MI) { const int kb = r / 80, nb = r % 80; transpose_item(P.in[8] + (size_t)l * 1024 * 2560, 1024, 2560, WB + WB_MIXIN, kb * 64, nb * 32, nb * 32, scr, lane); continue; } r -= I_MI;
        if (r < I_MO) { const int kb = r / 32, nb = r % 32; transpose_item(P.in[9] + (size_t)l * 1024 * 1024, 1024, 1024, WB + WB_MIXOUT, kb * 64, nb * 32, nb * 32, scr, lane); continue; } r -= I_MO;
        if (r < I_IN) { const int kb = r / 176, nb = r % 176; transpose_item(P.in[26] + (size_t)l * 1024 * 5632, 1024, 5632, WB + WB_FFN2IN, kb * 64, nb * 32, swiglu_row(nb * 32), scr, lane); continue; } r -= I_IN;
        if (r < I_OUT) { const int kb = r / 32, nb = r % 32; transpose_item(P.in[27] + (size_t)l * 2816 * 1024, 2816, 1024, WB + WB_FFN2OUT, kb * 64, nb * 32, nb * 32, scr, lane); continue; } r -= I_OUT;
        if (r < 8) { transpose_item(P.in[15] + (size_t)l * 64 * 256, 64, 256, LT, 0, r * 32, r * 32, scr, lane); continue; } r -= 8;
        if (r < 8) { transpose_item(P.in[17] + (size_t)l * 64 * 256, 64, 256, LT + 16384, 0, r * 32, r * 32, scr, lane); continue; } r -= 8;
        { const int kb = r / 8, nb = r % 8; transpose_item(P.in[18] + (size_t)l * 128 * 256, 128, 256, LT + 32768, kb * 64, nb * 32, nb * 32, scr, lane); }
    }
}

__device__ __forceinline__ void phase_norm(const Params& P, const float* hin, const float* gain, const float* modl  , int wid, int lane, int bid, int nblk) {
    bf16_t* HN = (bf16_t*)(P.ws + OFF_HN);
    for (int row = bid * 8 + wid; row < NTOK; row += nblk * 8) {
        const f32x4* xr = (const f32x4*)(hin + (size_t)row * 1024) + lane;
        f32x4 v[4]; float ss = 0.f;
#pragma unroll
        for (int j = 0; j < 4; ++j) { v[j] = xr[64 * j]; ss += (v[j][0] * v[j][0] + v[j][1] * v[j][1]) + (v[j][2] * v[j][2] + v[j][3] * v[j][3]); }
        const float rstd = rsqrtf(wave_sum(ss) * (1.f / 1024.f) + 1e-6f);
        const float* sh = modl + (size_t)(row >> 12) * 9216; const float* sc = sh + 1024;
        uint2* o8 = (uint2*)(HN + (size_t)row * 1024) + lane;
#pragma unroll
        for (int j = 0; j < 4; ++j) {
            const int col = lane * 4 + 256 * j;
            const f32x4 g = *(const f32x4*)(gain + col), s1 = *(const f32x4*)(sc + col), s0 = *(const f32x4*)(sh + col);
            const f32x4 y = v[j] * rstd * g * (s1 + 1.0f) + s0;
            uint2 o; o.x = cvt_pk_bf16(y[0], y[1]); o.y = cvt_pk_bf16(y[2], y[3]); o8[64 * j] = o;
        }
    }
}

__device__ __forceinline__ bf16x8 pack8(const float* f) {
    u32x4 o; o.x = cvt_pk_bf16(f[0], f[1]); o.y = cvt_pk_bf16(f[2], f[3]); o.z = cvt_pk_bf16(f[4], f[5]); o.w = cvt_pk_bf16(f[6], f[7]);
    return __builtin_bit_cast(bf16x8, o);
}
__device__ __forceinline__ void attn_item(const Params& P, int l, int item, LAS unsigned char* lds, int tid, int wid, int lane, int var) {
    const bf16_t* PA = (const bf16_t*)(P.ws + OFF_R1);
    bf16_t* Y = (bf16_t*)(P.ws + OFF_HN);
    const int b = item >> 6, n = (item >> 1) & 31, hk = item & 1;
    LAS bf16_t* Ks = (LAS bf16_t*)lds;
    LAS bf16_t* Vt = (LAS bf16_t*)(lds + 36864);
    const float* kg = P.in[11] + l * 64; const float* qg = P.in[10] + l * 64;
    {
        const int row = tid >> 1, half = tid & 1, kt = n * 128 - 128 + row;
        u32x4 kv[4], vv[4];
        if (kt >= 0) {
            const bf16_t* src = PA + (size_t)(b * SEQL + kt) * 768 + 512 + hk * 64 + half * 32;
#pragma unroll
            for (int i = 0; i < 4; ++i) { kv[i] = ((const u32x4*)src)[i]; vv[i] = ((const u32x4*)(src + 128))[i]; }
        } else {
#pragma unroll
            for (int i = 0; i < 4; ++i) { kv[i] = (u32x4){0u, 0u, 0u, 0u}; vv[i] = (u32x4){0u, 0u, 0u, 0u}; }
        }
        float kf[32]; float ss = 0.f;
#pragma unroll
        for (int i = 0; i < 4; ++i)
#pragma unroll
            for (int j = 0; j < 4; ++j) { const float a = bflo(kv[i][j]), c = bfhi(kv[i][j]); kf[i * 8 + 2 * j] = a; kf[i * 8 + 2 * j + 1] = c; ss += a * a + c * c; }
        ss += __shfl_xor(ss, 1);
        const float rstd = rsqrtf(ss * (1.f / 64.f) + 1e-6f);
#pragma unroll
        for (int i = 0; i < 32; ++i) kf[i] *= rstd * kg[half * 32 + i];
#pragma unroll
        for (int i = 0; i < 4; ++i) *(LAS bf16x8*)(Ks + row * 72 + half * 32 + i * 8) = pack8(kf + i * 8);
        const int r32 = row & 31, kp = (row & ~31) + ((r32 & 15) >> 2) * 8 + (r32 >> 4) * 4 + (r32 & 3);
#pragma unroll
        for (int i = 0; i < 4; ++i)
#pragma unroll
            for (int j = 0; j < 4; ++j) { const unsigned w = vv[i][j]; Vt[(half * 32 + i * 8 + 2 * j) * 264 + kp] = (bf16_t)(w & 0xffffu); Vt[(half * 32 + i * 8 + 2 * j + 1) * 264 + kp] = (bf16_t)(w >> 16); }
    }
    __syncthreads();
    const int fr = lane & 15, fq = lane >> 4, hq = hk * 4 + (wid >> 1);
    const float sink = P.in[12][l * 8 + hq];
    for (int i = 0; i < 4; ++i) {
        if (var == 1) { asm volatile("s_waitcnt vmcnt(0) lgkmcnt(0)" ::: "memory"); __syncthreads(); }
        const int q0 = ((wid & 1) * 4 + i) * 16, kb0 = q0 >> 5;
        const bf16_t* qp = PA + (size_t)(b * SEQL + n * 128 + q0 + fr) * 768 + hq * 64 + fq * 8;
        const u32x4 qa = *(const u32x4*)qp, qb = *(const u32x4*)(qp + 32);
        float qf[16]; float ss = 0.f;
#pragma unroll
        for (int j = 0; j < 4; ++j) { qf[2 * j] = bflo(qa[j]); qf[2 * j + 1] = bfhi(qa[j]); qf[8 + 2 * j] = bflo(qb[j]); qf[8 + 2 * j + 1] = bfhi(qb[j]); }
#pragma unroll
        for (int j = 0; j < 16; ++j) ss += qf[j] * qf[j];
        ss += __shfl_xor(ss, 16); ss += __shfl_xor(ss, 32);
        const float rstd = rsqrtf(ss * (1.f / 64.f) + 1e-6f) * 0.125f;
#pragma unroll
        for (int j = 0; j < 8; ++j) { qf[j] *= rstd * qg[fq * 8 + j]; qf[8 + j] *= rstd * qg[32 + fq * 8 + j]; }
        const bf16x8 Q0 = pack8(qf), Q1 = pack8(qf + 8);
        f32x4 s[10];
#pragma unroll
        for (int tt = 0; tt < 10; ++tt) {
            const LAS bf16_t* kr = Ks + ((2 * kb0 + tt) * 16 + fr) * 72 + fq * 8;
            const bf16x8 K0 = *(const LAS bf16x8*)kr, K1 = *(const LAS bf16x8*)(kr + 32);
            f32x4 z = (f32x4){0.f, 0.f, 0.f, 0.f};
            z = __builtin_amdgcn_mfma_f32_16x16x32_bf16(K0, Q0, z, 0, 0, 0);
            s[tt] = __builtin_amdgcn_mfma_f32_16x16x32_bf16(K1, Q1, z, 0, 0, 0);
        }
        if (var == 3) {
#pragma unroll
            for (int tt = 0; tt < 10; ++tt) s[tt] = (f32x4){0.25f, 0.5f, 0.125f, 0.375f};
        }
        const int qi = q0 + fr;
        float m = sink;
#pragma unroll
        for (int tt = 0; tt < 10; ++tt)
#pragma unroll
            for (int j = 0; j < 4; ++j) {
                const int kidx = (2 * kb0 + tt) * 16 + fq * 4 + j;
                const bool vis = (kidx > qi) && (kidx <= qi + 128) && (n > 0 || kidx >= 128);
                const float sv = vis ? s[tt][j] : -INFINITY; s[tt][j] = sv; m = fmaxf(m, sv);
            }
        m = fmaxf(m, __shfl_xor(m, 16)); m = fmaxf(m, __shfl_xor(m, 32));
        float sum = 0.f;
#pragma unroll
        for (int tt = 0; tt < 10; ++tt)
#pragma unroll
            for (int j = 0; j < 4; ++j) { const float p = __expf(s[tt][j] - m); s[tt][j] = p; sum += p; }
        sum += __shfl_xor(sum, 16); sum += __shfl_xor(sum, 32);
        sum += __expf(sink - m);
        const float inv = 1.f / sum;
        f32x4 o[4];
#pragma unroll
        for (int dt = 0; dt < 4; ++dt) o[dt] = (f32x4){0.f, 0.f, 0.f, 0.f};
        if (var == 2) {
#pragma unroll
            for (int dt = 0; dt < 4; ++dt) o[dt] = s[dt] + s[4 + dt] + s[(8 + dt) > 9 ? 9 : 8 + dt];
        } else
        {
#pragma unroll
        for (int kb = 0; kb < 5; ++kb) {
            float pf[8];
#pragma unroll
            for (int j = 0; j < 4; ++j) { pf[j] = s[2 * kb][j] * inv; pf[4 + j] = s[2 * kb + 1][j] * inv; }
            const bf16x8 Pf = pack8(pf);
#pragma unroll
            for (int dt = 0; dt < 4; ++dt) {
                const bf16x8 Vf = *(const LAS bf16x8*)(Vt + (dt * 16 + fr) * 264 + (kb0 + kb) * 32 + fq * 8);
                o[dt] = __builtin_amdgcn_mfma_f32_16x16x32_bf16(Pf, Vf, o[dt], 0, 0, 0);
            }
        }
        }
#pragma unroll
        for (int dt = 0; dt < 4; ++dt)
#pragma unroll
            for (int j = 0; j < 4; ++j)
                Y[(size_t)(b * SEQL + n * 128 + q0 + fq * 4 + j) * 1024 + hq * 64 + dt * 16 + fr] = (bf16_t)(cvt_pk_bf16(o[dt][j], 0.f) & 0xffffu);
    }
    __syncthreads();
}

__device__ __forceinline__ void conv_part(const Params& P, int l, int tid, int bid, int nblk) {
    const bf16_t* PC = (const bf16_t*)(P.ws + OFF_R1 + R1_CONV);
    bf16_t* Y = (bf16_t*)(P.ws + OFF_HN);
    const float* cw = P.in[24] + l * 768;
    for (int idx = bid * 512 + tid; idx < NTOK * 32; idx += nblk * 512) {
        const int tok = idx >> 5, c = (idx & 31) * 8, t = tok & (SEQL - 1);
        const bf16_t* p = PC + (size_t)tok * 768 + c;
        const u32x4 bg = *(const u32x4*)p;
        float u[3][8];
#pragma unroll
        for (int d = 0; d < 3; ++d) {
            if (t >= d) { const u32x4 cg4 = *(const u32x4*)(p - d * 768 + 256), hg = *(const u32x4*)(p - d * 768 + 512);
#pragma unroll
                for (int j = 0; j < 4; ++j) { u[d][2 * j] = bflo(cg4[j]) * bflo(hg[j]); u[d][2 * j + 1] = bfhi(cg4[j]) * bfhi(hg[j]); }
            } else {
#pragma unroll
                for (int j = 0; j < 8; ++j) u[d][j] = 0.f;
            }
        }
        float y[8];
#pragma unroll
        for (int j = 0; j < 8; ++j) {
            const float bgv = (j & 1) ? bfhi(bg[j >> 1]) : bflo(bg[j >> 1]);
            y[j] = bgv * (cw[c + j] * u[2][j] + cw[256 + c + j] * u[1][j] + cw[512 + c + j] * u[0][j]);
        }
        *(bf16x8*)(Y + (size_t)tok * 1024 + 768 + c) = pack8(y);
    }
}

__device__ __forceinline__ void prep_tile(const Params& P, int l, int tile, LAS unsigned char* lds, int tid, int wid, int lane) {
    const float* PR = (const float*)(P.ws + OFF_R1 + R1_RWKV);
    float* REC = (float*)(P.ws + OFF_R2);
    bf16_t* G = (bf16_t*)(P.ws + OFF_R2 + R2_G);
    float* BON = (float*)(P.ws + OFF_BONUS);
    LAS bf16_t* Xs = (LAS bf16_t*)lds;
    const float* mu = P.in[13] + l * 1024;
    const int tok0 = tile * 64;
    {
        const int t = tid >> 3, seg = tid & 7, tok = tok0 + t; const bool first = (tok & (SEQL - 1)) == 0;
        const float* p = PR + (size_t)tok * 1024 + 768 + seg * 32;
        const float c1 = seg < 2 ? 2.f : 1.f, c2 = seg < 2 ? 2.f : 1.f, c3 = seg < 2 ? -1.f : 0.f; const bool ident = (seg == 2 || seg == 3);
#pragma unroll
        for (int i = 0; i < 4; ++i) {
            float xo[8];
#pragma unroll
            for (int hh = 0; hh < 2; ++hh) {
                const f32x4 a = ((const f32x4*)p)[2 * i + hh];
                const f32x4 pv = first ? (f32x4){0.f, 0.f, 0.f, 0.f} : ((const f32x4*)(p - 1024))[2 * i + hh];
                const f32x4 m = ((const f32x4*)(mu + 768 + seg * 32))[2 * i + hh];
                const f32x4 x = a + m * (pv - a);
#pragma unroll
                for (int j = 0; j < 4; ++j) { const float sg = sigmoid_f(c1 * x[j]) * c2 + c3; xo[hh * 4 + j] = ident ? x[j] : sg; }
            }
            *(LAS bf16x8*)(Xs + t * 264 + seg * 32 + i * 8) = pack8(xo);
        }
    }
    __syncthreads();
    const int fr = lane & 15, fq = lane >> 4, hh = wid & 3;
    const bf16_t* WTw = (const bf16_t*)(P.ws + OFF_LORA); const bf16_t* WTa = WTw + 16384; const bf16_t* WTg = WTw + 32768;
    const float* w0 = P.in[14] + l * 256; const float* a0 = P.in[16] + l * 256; const float* k_k = P.in[19] + l * 256;
    const float* k_a = P.in[20] + l * 256; const float* r_k = P.in[21] + l * 256;
    for (int ti = 0; ti < 2; ++ti) {
        const int tq = (wid >> 2) * 2 + ti;
        bf16x8 xb[8];
#pragma unroll
        for (int ks = 0; ks < 8; ++ks) xb[ks] = *(const LAS bf16x8*)(Xs + (tq * 16 + fr) * 264 + ks * 32 + fq * 8);
        f32x4 aw[4], aa[4], ag[4];
#pragma unroll
        for (int ct = 0; ct < 4; ++ct) {
            const int col = hh * 64 + ct * 16 + fr;
            f32x4 z = (f32x4){0.f, 0.f, 0.f, 0.f};
#pragma unroll
            for (int ks = 0; ks < 2; ++ks) z = __builtin_amdgcn_mfma_f32_16x16x32_bf16(*(const bf16x8*)(WTw + col * 64 + ks * 32 + fq * 8), xb[ks], z, 0, 0, 0);
            aw[ct] = z; z = (f32x4){0.f, 0.f, 0.f, 0.f};
#pragma unroll
            for (int ks = 0; ks < 2; ++ks) z = __builtin_amdgcn_mfma_f32_16x16x32_bf16(*(const bf16x8*)(WTa + col * 64 + ks * 32 + fq * 8), xb[2 + ks], z, 0, 0, 0);
            aa[ct] = z; z = (f32x4){0.f, 0.f, 0.f, 0.f};
#pragma unroll
            for (int ks = 0; ks < 4; ++ks) z = __builtin_amdgcn_mfma_f32_16x16x32_bf16(*(const bf16x8*)(WTg + col * 128 + ks * 32 + fq * 8), xb[4 + ks], z, 0, 0, 0);
            ag[ct] = z;
        }
        const int tok = tok0 + tq * 16 + fr; const bool first = (tok & (SEQL - 1)) == 0;
        const float* pr = PR + (size_t)tok * 1024;
        float* rec = REC + ((size_t)tok * 4 + hh) * 384;
        f32x4 kkv[4], av[4]; float ss = 0.f, bon = 0.f;
#pragma unroll
        for (int ct = 0; ct < 4; ++ct) {
            const int c4 = hh * 64 + ct * 16 + fq * 4, lo = ct * 16 + fq * 4;
            f32x4 x3[3];
#pragma unroll
            for (int q = 0; q < 3; ++q) {
                const f32x4 a = *(const f32x4*)(pr + q * 256 + c4);
                const f32x4 pv = first ? (f32x4){0.f, 0.f, 0.f, 0.f} : *(const f32x4*)(pr - 1024 + q * 256 + c4);
                const f32x4 m = *(const f32x4*)(mu + q * 256 + c4);
                x3[q] = a + m * (pv - a);
            }
            const f32x4 r4 = x3[0], k4 = x3[1], v4 = x3[2];
            const f32x4 w0v = *(const f32x4*)(w0 + c4), a0v = *(const f32x4*)(a0 + c4), kkw = *(const f32x4*)(k_k + c4), kaw = *(const f32x4*)(k_a + c4), rkw = *(const f32x4*)(r_k + c4);
            f32x4 dec, a4, kp;
#pragma unroll
            for (int j = 0; j < 4; ++j) {
                const float w = w0v[j] + aw[ct][j];
                const float z = -w;
                const float sp = fmaxf(z, 0.f) + log1pf(__expf(-fabsf(z)));
                dec[j] = __expf(-__expf(-sp - 0.5f));
                a4[j] = sigmoid_f(a0v[j] + aa[ct][j]);
            }
            kkv[ct] = k4 * kkw; av[ct] = a4;
            kp = k4 * ((a4 - 1.0f) * kaw + 1.0f);
#pragma unroll
            for (int j = 0; j < 4; ++j) { ss += kkv[ct][j] * kkv[ct][j]; bon += r4[j] * kp[j] * rkw[j]; }
            *(f32x4*)(rec + 0 * 64 + lo) = r4; *(f32x4*)(rec + 1 * 64 + lo) = dec; *(f32x4*)(rec + 2 * 64 + lo) = kp; *(f32x4*)(rec + 3 * 64 + lo) = v4;
            uint2 go; go.x = cvt_pk_bf16(ag[ct][0], ag[ct][1]); go.y = cvt_pk_bf16(ag[ct][2], ag[ct][3]);
            *(uint2*)(G + (size_t)tok * 256 + c4) = go;
        }
        ss += __shfl_xor(ss, 16); ss += __shfl_xor(ss, 32); bon += __shfl_xor(bon, 16); bon += __shfl_xor(bon, 32);
        const float rn = 1.f / fmaxf(sqrtf(ss), 1e-12f);
#pragma unroll
        for (int ct = 0; ct < 4; ++ct) { const int lo = ct * 16 + fq * 4; const f32x4 kk = kkv[ct] * rn; *(f32x4*)(rec + 4 * 64 + lo) = kk; *(f32x4*)(rec + 5 * 64 + lo) = kk * av[ct]; }
        if (fq == 0) BON[(size_t)tok * 4 + hh] = bon;
    }
    __syncthreads();
}

__device__ __forceinline__ void phase_scan(const Params& P, LAS unsigned char* lds, int tid, int wid, int lane, int bid, int nblk) {
    const float* REC = (const float*)(P.ws + OFF_R2);
    float* YS = (float*)(P.ws + OFF_R1 + R1_RWKV);
    for (int item = bid; item < 256; item += nblk) {
        const int bh = (item & 7) * 4 + ((item >> 3) & 3), rg = item >> 5, b = bh >> 2, h = bh & 3;
        const float* src0 = REC + ((size_t)(b * SEQL) * 4 + h) * 384;
        f32x4 st[6];
#pragma unroll
        for (int i = 0; i < 6; ++i) { const int idx = tid + 512 * i, s = idx / 96, o = idx % 96; st[i] = *(const f32x4*)(src0 + (size_t)s * 1536 + o * 4); }
#pragma unroll
        for (int i = 0; i < 6; ++i) ((LAS f32x4*)lds)[tid + 512 * i] = st[i];
        __syncthreads();
        float S0 = 0.f, S1 = 0.f, S2 = 0.f, S3 = 0.f;
        const int rl = lane >> 4, kq = lane & 15, row = rg * 8 + (wid & 1) * 4 + rl;
        for (int ch = 0; ch < 128; ++ch) {
            if (ch + 1 < 128) {
#pragma unroll
                for (int i = 0; i < 6; ++i) { const int idx = tid + 512 * i, s = idx / 96, o = idx % 96; st[i] = *(const f32x4*)(src0 + (size_t)((ch + 1) * 32 + s) * 1536 + o * 4); }
            }
            if (wid < 2) {
                const LAS float* buf = (const LAS float*)(lds + (ch & 1) * 49152);
                float* yp = YS + (size_t)(b * SEQL + ch * 32) * 256 + h * 64 + row;
#pragma unroll 4
                for (int s = 0; s < 32; ++s) {
                    const LAS float* rc = buf + s * 384;
                    const f32x4 r4 = *(const LAS f32x4*)(rc + kq * 4), w4 = *(const LAS f32x4*)(rc + 64 + kq * 4), k4 = *(const LAS f32x4*)(rc + 128 + kq * 4);
                    const f32x4 kk4 = *(const LAS f32x4*)(rc + 256 + kq * 4), ka4 = *(const LAS f32x4*)(rc + 320 + kq * 4);
                    const float v = rc[192 + row];
                    float d = (S0 * kk4[0] + S1 * kk4[1]) + (S2 * kk4[2] + S3 * kk4[3]);
                    d = rowsum16(d);
                    S0 = fmaf(-d, ka4[0], fmaf(v, k4[0], S0 * w4[0])); S1 = fmaf(-d, ka4[1], fmaf(v, k4[1], S1 * w4[1]));
                    S2 = fmaf(-d, ka4[2], fmaf(v, k4[2], S2 * w4[2])); S3 = fmaf(-d, ka4[3], fmaf(v, k4[3], S3 * w4[3]));
                    float o = (S0 * r4[0] + S1 * r4[1]) + (S2 * r4[2] + S3 * r4[3]);
                    o = rowsum16(o);
                    if (kq == 0) yp[(size_t)s * 256] = o;
                }
            }
            if (ch + 1 < 128) {
#pragma unroll
                for (int i = 0; i < 6; ++i) ((LAS f32x4*)(lds + ((ch + 1) & 1) * 49152))[tid + 512 * i] = st[i];
            }
            __syncthreads();
        }
    }
}

__device__ __forceinline__ void phase_post(const Params& P, int l, int tid, int bid, int nblk) {
    const float* YS = (const float*)(P.ws + OFF_R1 + R1_RWKV);
    const float* REC = (const float*)(P.ws + OFF_R2);
    const bf16_t* G = (const bf16_t*)(P.ws + OFF_R2 + R2_G);
    const float* BON = (const float*)(P.ws + OFF_BONUS);
    bf16_t* Y = (bf16_t*)(P.ws + OFF_HN);
    const float* gw = P.in[22] + l * 256; const float* gb = P.in[23] + l * 256;
    for (int idx = bid * 512 + tid; idx < NTOK * 64; idx += nblk * 512) {
        const int l16 = idx & 15, th = idx >> 4, tok = th >> 2, h = th & 3, c = h * 64 + l16 * 4;
        const f32x4 y = *(const f32x4*)(YS + (size_t)tok * 256 + c);
        const float mean = rowsum16((y[0] + y[1]) + (y[2] + y[3])) * (1.f / 64.f);
        const f32x4 d = y - mean;
        const float var = rowsum16((d[0] * d[0] + d[1] * d[1]) + (d[2] * d[2] + d[3] * d[3])) * (1.f / 64.f);
        const float rs = rsqrtf(var + 64e-5f);
        const f32x4 v4 = *(const f32x4*)(REC + ((size_t)tok * 4 + h) * 384 + 192 + l16 * 4);
        const uint2 gg = *(const uint2*)(G + (size_t)tok * 256 + c);
        const f32x4 g4 = (f32x4){bflo(gg.x), bfhi(gg.x), bflo(gg.y), bfhi(gg.y)};
        const float bon = BON[(size_t)tok * 4 + h];
        const f32x4 o = ((d * rs) * *(const f32x4*)(gw + c) + *(const f32x4*)(gb + c) + v4 * bon) * g4;
        uint2 ov; ov.x = cvt_pk_bf16(o[0], o[1]); ov.y = cvt_pk_bf16(o[2], o[3]);
        *(uint2*)(Y + (size_t)tok * 1024 + 512 + c) = ov;
    }
}

__global__ __launch_bounds__(512, 2) void mega(Params P) {
    extern __shared__ __attribute__((aligned(16))) unsigned char shm[];
    LAS unsigned char* lds = (LAS unsigned char*)shm;
    const int nblk = gridDim.x;
    float* MOD = (float*)(P.ws + OFF_MOD);
    bf16_t* WB = (bf16_t*)(P.ws + OFF_WB);
    bf16_t* HN = (bf16_t*)(P.ws + OFF_HN);
    bf16_t* ACT = (bf16_t*)(P.ws + OFF_R1);
    for (int ph = P.ph_lo; ph < P.ph_hi; ++ph) {
        int tid = threadIdx.x, bid = blockIdx.x;
        asm volatile("" : "+v"(tid)); asm volatile("" : "+s"(bid));
        const int wid = __builtin_amdgcn_readfirstlane(tid >> 6), lane = tid & 63;
        if (ph == 0) {
#ifndef NO_MOD
            phase_mod(P, lds, tid, wid, lane, bid, nblk);
#endif
#ifdef DIAG_POISON
            { u32x4* w = (u32x4*)(P.ws + OFF_LORA); const size_t n16 = (WS_END - OFF_LORA) / 16;
              for (size_t i = (size_t)bid * 512 + tid; i < n16; i += (size_t)nblk * 512) w[i] = (u32x4){0xAAAAAAAAu, 0xAAAAAAAAu, 0xAAAAAAAAu, 0xAAAAAAAAu}; }
#endif
        } else {
            const int l = (ph - 1) / PPL, s = (ph - 1) % PPL;
            const float* hin = (l == 0 && s < 3) ? P.in[0] : P.out;
            const float* modl = MOD + (size_t)l * 8 * 9216;
            pg8::Gemm g{HN, WB, NTOK, 1024, 1024}; pg8::EpiAny E{}; bool is_gemm = true;
            switch (s) {
            case 0:
#ifndef NO_CONV
                phase_convert(P, l, lds, wid, lane, bid, nblk);
#endif
#ifndef NO_NORM
                phase_norm(P, hin, P.in[4] + l * 1024, modl, wid, lane, bid, nblk);
#endif
                is_gemm = false; break;
            case 1: g.Bt = WB + WB_FFN1IN; g.N = 2 * DFF; E.kind = 0; E.perm = true; E.sw.O = ACT; break;
            case 2: g.A = ACT; g.Bt = WB + WB_FFN1OUT; g.K = DFF; E.kind = 1; E.rs = pg8::EpiResid{hin, P.out, modl + 2 * 1024, 0.5f}; break;
            case 3: phase_norm(P, hin, P.in[7] + l * 1024, modl + 3 * 1024, wid, lane, bid, nblk); is_gemm = false; break;
            case 4: g.Bt = WB + WB_MIXIN; g.N = 2560; E.kind = 2; E.pj = pg8::EpiProj{(bf16_t*)(P.ws + OFF_R1), (float*)(P.ws + OFF_R1 + R1_RWKV), (bf16_t*)(P.ws + OFF_R1 + R1_CONV)}; break;
            case 5:
#ifndef NO_ATTN
                for (int it = bid; it < 512; it += nblk) attn_item(P, l, it, lds, tid, wid, lane, P.ph_lo < 0 ? 0 : ATTN_VAR(l));
#endif
                is_gemm = false; break;
            case 6:
#ifndef NO_PREP
                for (int it = bid; it < 512; it += nblk) prep_tile(P, l, it, lds, tid, wid, lane);
#endif
                is_gemm = false; break;
            case 7: conv_part(P, l, tid, bid, nblk); is_gemm = false; break;
            case 8:
#ifndef NO_SCAN
                phase_scan(P, lds, tid, wid, lane, bid, nblk);
#endif
                is_gemm = false; break;
            case 9: phase_post(P, l, tid, bid, nblk); is_gemm = false; break;
            case 10: g.Bt = WB + WB_MIXOUT; E.kind = 1; E.rs = pg8::EpiResid{hin, P.out, modl + 5 * 1024, 1.0f}; break;
            case 11: phase_norm(P, hin, P.in[25] + l * 1024, modl + 6 * 1024, wid, lane, bid, nblk); is_gemm = false; break;
            case 12: g.Bt = WB + WB_FFN2IN; g.N = 2 * DFF; E.kind = 0; E.perm = true; E.sw.O = ACT; break;
            default: g.A = ACT; g.Bt = WB + WB_FFN2OUT; g.K = DFF; E.kind = 1; E.rs = pg8::EpiResid{hin, P.out, modl + 8 * 1024, 0.5f}; break;
            }
            if (is_gemm) { pg8::StaticOrder S; S.init(NTOK, g.N, nblk, bid); pg8::gemm_phase(lds, g, S, E, tid); }
        }
        if (ph + 1 < P.ph_hi) { cg::this_grid().sync(); }
    }
}


#ifdef DIAG_SELFTEST
__global__ void diag_checksum(const unsigned* p, size_t nwords, unsigned long long* slot) {
    unsigned long long acc = 0;
    for (size_t i = (size_t)blockIdx.x * blockDim.x + threadIdx.x; i < nwords; i += (size_t)gridDim.x * blockDim.x) acc += (unsigned long long)p[i] * (unsigned long long)(2 * i + 1);
    for (int o = 1; o < 64; o <<= 1) acc += __shfl_xor(acc, o);
    if ((threadIdx.x & 63) == 0) atomicAdd(slot, acc);
}
__global__ void diag_report(const unsigned long long* slots, int nitems, int nrep, float* out, size_t n) {
    int code = 0;
    for (int k = 0; k < nitems; ++k) for (int r = 1; r < nrep; ++r) if (slots[k * nrep + r] != slots[k * nrep]) { code |= 1 << k; break; }
    if (code == 0) return;
    const float c = 4.0f * exp2f((float)code);
    for (size_t i = (size_t)blockIdx.x * blockDim.x + threadIdx.x; i < n; i += (size_t)gridDim.x * blockDim.x) out[i] = c;
}
#endif
extern "C" void kernel_launch(void* const* d_in, const int* in_sizes, int n_in, void* d_out, int out_size, void* d_ws, size_t ws_size, hipStream_t stream) {
    static int grid = 0;
    if (grid == 0) {
        if (n_in != 28 || out_size != NTOK * DM || ws_size < WS_END) { fprintf(stderr, "kernel_launch: unexpected shapes (n_in %d out %d ws %zu need %zu)\n", n_in, out_size, ws_size, (size_t)WS_END); grid = -1; return; }
        int dev = 0, cus = 0, per_cu = 0;
        hipGetDevice(&dev); hipDeviceGetAttribute(&cus, hipDeviceAttributeMultiprocessorCount, dev);
        if (hipFuncSetAttribute((const void*)mega, hipFuncAttributeMaxDynamicSharedMemorySize, LDS_BYTES) != hipSuccess) { fprintf(stderr, "kernel_launch: hipFuncSetAttribute failed\n"); grid = -1; return; }
        if (hipOccupancyMaxActiveBlocksPerMultiprocessor(&per_cu, (const void*)mega, 512, LDS_BYTES) != hipSuccess || per_cu < 1) { fprintf(stderr, "kernel_launch: occupancy query failed (%d)\n", per_cu); per_cu = 1; (void)hipGetLastError(); }
        grid = cus * per_cu;
    }
    if (grid < 0) return;
    Params p{};
    for (int i = 0; i < 28; ++i) p.in[i] = (const float*)d_in[i];
    p.out = (float*)d_out; p.ws = (unsigned char*)d_ws;
#if MK_LAUNCHES == 1
    p.ph_lo = 0; p.ph_hi = NPH;
    void* args[] = {&p};
    hipError_t e = hipLaunchCooperativeKernel((const void*)mega, dim3(grid), dim3(512), args, LDS_BYTES, stream);
    if (e != hipSuccess) fprintf(stderr, "cooperative launch failed: %s (grid %d)\n", hipGetErrorString(e), grid);
#else
#ifdef DIAG_SELFTEST
    {
        constexpr int NREP = 4;
        unsigned long long* slots = (unsigned long long*)((unsigned char*)d_ws + WS_END);
        hipMemsetAsync(slots, 0, 64 * NREP * 8, stream);
        int item = 0;
        for (int ph = 0; ph < NPH; ++ph) {
            p.ph_lo = ph; p.ph_hi = ph + 1; hipLaunchKernelGGL(mega, dim3(grid), dim3(512), LDS_BYTES, stream, p);
            if (ph == 0) continue;
            const int l = (ph - 1) / PPL, s = (ph - 1) % PPL;
            size_t off = 0, len = 0; bool test = (s == 5);
            switch (s) {
            case 0: off = OFF_LORA; len = OFF_R1 - OFF_LORA; break;
            case 1: case 12: off = OFF_R1; len = (size_t)NTOK * DFF * 2; break;
            case 2: test = false; break;
            case 3: case 5: case 7: case 9: case 11: off = OFF_HN; len = (size_t)NTOK * 1024 * 2; break;
            case 4: off = OFF_R1; len = R1_BYTES; break;
            case 6: off = OFF_R2; len = WS_END - OFF_R2; break;
            case 8: off = OFF_R1 + R1_RWKV; len = (size_t)NTOK * 256 * 4; break;
            default: test = false; break;
            }
            if (!test) continue;
            const unsigned* base = (s == 2) ? (const unsigned*)d_out : (const unsigned*)((unsigned char*)d_ws + off);
            const size_t nw = (s == 2) ? (size_t)NTOK * 1024 : len / 4;
            for (int r = 0; r < NREP; ++r) {
                if (r > 0) hipLaunchKernelGGL(mega, dim3(grid), dim3(512), LDS_BYTES, stream, p);
                hipLaunchKernelGGL(diag_checksum, dim3(2048), dim3(256), 0, stream, base, nw, slots + item * NREP + r);
            }
            ++item;
        }
        hipLaunchKernelGGL(diag_report, dim3(2048), dim3(256), 0, stream, (const unsigned long long*)slots, item, NREP, (float*)d_out, (size_t)NTOK * 1024);
    }
#else
    for (int ph = 0; ph < NPH; ++ph) { p.ph_lo = ph; p.ph_hi = ph + 1; hipLaunchKernelGGL(mega, dim3(grid), dim3(512), LDS_BYTES, stream, p); }
#endif
#endif
}
```

```cpp
#define ATTN_VAR(l) (P.ph_hi > 100000 ? (l) + 1 : 0)
#define GEMM_ALIGN true
#define GEMM_SP2 true
#include <hip/hip_runtime.h>
#include <hip/hip_cooperative_groups.h>
#include <cstdio>
#include <cstdint>
namespace cg = cooperative_groups;

#ifndef MK_LAUNCHES
#define MK_LAUNCHES 1
#endif

namespace pg8 {
#define PG8_LAS __attribute__((address_space(3)))
typedef unsigned short bf16_t;
typedef short bf16x8 __attribute__((ext_vector_type(8)));
typedef float f32x4 __attribute__((ext_vector_type(4)));
typedef unsigned u32x4 __attribute__((ext_vector_type(4)));
constexpr int BM = 256, BK = 64, HALF = 128, HTB = HALF * BK * 2  , STAGE_BYTES = 8 * HTB, NXCD = 8, WGM = 8;

__host__ __device__ __forceinline__ int lds_byte(int r, int c) { const int st = (r >> 4) * 2 + (c >> 5), rr = r & 15, cc = c & 31, ob = rr * 64 + cc * 2; return st * 1024 + (ob ^ (((ob >> 9) & 1) << 5)); }
__host__ __device__ __forceinline__ void stage_rc(int b, int& R, int& C) { const int st = b / 1024, sb = b % 1024, swz = sb ^ (((sb >> 9) & 1) << 5); R = (st >> 1) * 16 + swz / 64; C = (st & 1) * 32 + (swz % 64) / 2; }
__host__ __device__ __forceinline__ int perm32(int rho) { const int n = rho >> 4, i = rho & 15; return 8 * (i >> 2) + 4 * n + (i & 3); }

struct Unit { int pm, pn; };
struct Gemm { const bf16_t* A; const bf16_t* Bt; int M, N, K; };

struct StaticOrder {
    int nM, nN, nwg, G, c;
    __host__ __device__ void init(int M, int N, int G_, int c_) { nM = M / BM; nN = N / BM; nwg = nM * nN; G = G_; c = c_; }
    __host__ __device__ bool next(int i, Unit& u) const {
        const long L = (long)i * G + c; if (L >= nwg) return false;
        int wgid = (int)L; { const int q = nwg / NXCD, r = nwg % NXCD, xcd = wgid % NXCD, off = wgid / NXCD; wgid = (xcd < r ? xcd * (q + 1) : r * (q + 1) + (xcd - r) * q) + off; }
        const int nig = WGM * nN, gid = wgid / nig, fm = gid * WGM, gsz = (nM - fm) < WGM ? (nM - fm) : WGM;
        u.pm = fm + ((wgid % nig) % gsz); u.pn = (wgid % nig) / gsz; return true;
    }
    __device__ __forceinline__ void a_ready(const Unit&) const {}
    __device__ __forceinline__ void done(const Unit&) const {}
};
typedef __bf16 bf16v2_t __attribute__((ext_vector_type(2)));
typedef float f32x2_t __attribute__((ext_vector_type(2)));
__device__ __forceinline__ unsigned cvt_pk_bf16(float lo, float hi) { const f32x2_t v = {lo, hi}; const bf16v2_t b = __builtin_convertvector(v, bf16v2_t); return __builtin_bit_cast(unsigned, b); }

typedef _Float16 h16x2_t __attribute__((ext_vector_type(2)));
__device__ __forceinline__ unsigned cvt_pk_f16(float lo, float hi) { const f32x2_t v = {lo, hi}; const h16x2_t h = __builtin_convertvector(v, h16x2_t); return __builtin_bit_cast(unsigned, h); }
__device__ __forceinline__ f32x2_t f16x2_to_f32(unsigned u) { const h16x2_t h = __builtin_bit_cast(h16x2_t, u); return __builtin_convertvector(h, f32x2_t); }
template <class Epi, class Sched, bool ALIGN_EPI = false, bool SP2 = false>
__device__ __forceinline__ void gemm_phase(PG8_LAS unsigned char* lds, const Gemm g, const Sched& S, const Epi& E, const int tid) {
    const int wid = __builtin_amdgcn_readfirstlane(tid >> 6), lane = tid & 63, wr = wid >> 2, wc = wid & 3, fr = lane & 15, fq = lane >> 4;
    const int K = g.K, nt = K / BK;
    unsigned voffA[2], voffB[2];
#pragma unroll
    for (int i = 0; i < 2; ++i) { int R, C; stage_rc(tid * 16 + i * 8192, R, C); const int Rb = E.perm ? ((R & ~31) + perm32(R & 31)) : R;
        voffA[i] = (unsigned)(R * K + C) * 2u; voffB[i] = (unsigned)(Rb * K + C) * 2u; }
    const size_t kstep = (size_t)(BK * 2);
    const size_t hstep = (size_t)HALF * K * 2;
    const size_t tstep = 2 * hstep;
    const unsigned ldsw = (unsigned)wid * 1024u;
    const int aoff = lds_byte(wr * 64 + fr, fq * 8), boff = lds_byte(wc * 32 + fr, fq * 8);
#define PG8_SA(b, h) (((b) * 2 + (h)) * HTB)
#define PG8_SB(b, h) ((4 + (b) * 2 + (h)) * HTB)
#define PG8_STAGE(bufoff, gbase, voff) do { _Pragma("unroll") for (int _i = 0; _i < 2; ++_i) \
        __builtin_amdgcn_global_load_lds((const unsigned*)((const char*)(gbase) + (voff)[_i]), (PG8_LAS unsigned*)(lds + (bufoff) + ldsw + _i * 8192), 16, 0, 0); } while (0)
#define PG8_LDA(dst, b, h) do { _Pragma("unroll") for (int m = 0; m < 4; ++m) _Pragma("unroll") for (int k = 0; k < 2; ++k) dst[m][k] = *(const PG8_LAS bf16x8*)(lds + PG8_SA(b, h) + aoff + m * 2048 + k * 1024); } while (0)
#define PG8_LDB(dst, b, h) do { _Pragma("unroll") for (int n = 0; n < 2; ++n) _Pragma("unroll") for (int k = 0; k < 2; ++k) dst[n][k] = *(const PG8_LAS bf16x8*)(lds + PG8_SB(b, h) + boff + n * 2048 + k * 1024); } while (0)
#define PG8_MMA(ai, bj, At, Bt) do { __builtin_amdgcn_s_setprio(1); _Pragma("unroll") for (int m = 0; m < 4; ++m) _Pragma("unroll") for (int n = 0; n < 2; ++n) _Pragma("unroll") for (int k = 0; k < 2; ++k) \
        acc[ai][bj][m][n] = __builtin_amdgcn_mfma_f32_16x16x32_bf16(Bt[n][k], At[m][k], acc[ai][bj][m][n], 0, 0, 0); __builtin_amdgcn_s_setprio(0); } while (0)
#define PG8_WAIT_V(n) asm volatile("s_waitcnt vmcnt(" #n ")" ::: "memory")
#define PG8_WAIT_L(n) asm volatile("s_waitcnt lgkmcnt(" #n ")" ::: "memory")
#define PG8_BAR __builtin_amdgcn_s_barrier()
#define PG8_SCHED __builtin_amdgcn_sched_barrier(0)
    Unit cur, nxt; int ui = 0;
    if (!S.next(0, cur)) return;
    f32x4 acc[2][2][4][2];
#pragma unroll
    for (int a = 0; a < 2; ++a)
#pragma unroll
        for (int b = 0; b < 2; ++b)
#pragma unroll
            for (int m = 0; m < 4; ++m)
#pragma unroll
                for (int n = 0; n < 2; ++n) acc[a][b][m][n] = (f32x4){0.f, 0.f, 0.f, 0.f};
    bf16x8 At[4][2], B0[2][2], B1[2][2];
    const char* cA = (const char*)g.A + (size_t)cur.pm * tstep; const char* cB = (const char*)g.Bt + (size_t)cur.pn * tstep;
    S.a_ready(cur);
    if constexpr (SP2) {
        PG8_STAGE(PG8_SB(0, 0), cB, voffB); PG8_STAGE(PG8_SB(0, 1), cB + hstep, voffB); PG8_STAGE(PG8_SA(0, 0), cA, voffA); PG8_STAGE(PG8_SA(0, 1), cA + hstep, voffA);
        if (wr == 1) PG8_BAR;
        PG8_WAIT_V(2); PG8_BAR;
        PG8_STAGE(PG8_SB(1, 0), cB + kstep, voffB); PG8_STAGE(PG8_SA(1, 0), cA + kstep, voffA); PG8_STAGE(PG8_SB(1, 1), cB + hstep + kstep, voffB);
        PG8_WAIT_V(6); PG8_BAR;
    } else {
        PG8_STAGE(PG8_SB(0, 0), cB, voffB); PG8_STAGE(PG8_SA(0, 0), cA, voffA); PG8_STAGE(PG8_SB(0, 1), cB + hstep, voffB); PG8_STAGE(PG8_SA(0, 1), cA + hstep, voffA);
        if (wr == 1) PG8_BAR;
        PG8_WAIT_V(4); PG8_BAR;
        PG8_STAGE(PG8_SB(1, 0), cB + kstep, voffB); PG8_STAGE(PG8_SA(1, 0), cA + kstep, voffA); PG8_STAGE(PG8_SB(1, 1), cB + hstep + kstep, voffB);
        PG8_WAIT_V(6); PG8_BAR;
    }
    for (;;) {
        const bool has_next = S.next(ui + 1, nxt);
        const char* nA = has_next ? (const char*)g.A + (size_t)nxt.pm * tstep : cA; const char* nB = has_next ? (const char*)g.Bt + (size_t)nxt.pn * tstep : cB;
        for (int t = 0; t < nt; t += 2) {
            const bool last = (t == nt - 2);
            const char* a1 = cA + (size_t)(t + 1) * kstep;
            const char* a2 = last ? nA : cA + (size_t)(t + 2) * kstep; const char* b2 = last ? nB : cB + (size_t)(t + 2) * kstep;
            const char* a3 = a2 + kstep; const char* b3 = b2 + kstep;
            if (last && has_next) S.a_ready(nxt);
            if constexpr (SP2) {
            PG8_LDB(B0, 0, 0); PG8_LDB(B1, 0, 1); PG8_SCHED; PG8_LDA(At, 0, 0); PG8_STAGE(PG8_SA(1, 1), a1 + hstep, voffA);
            PG8_WAIT_V(8); PG8_WAIT_L(0); PG8_BAR; PG8_MMA(0, 0, At, B0); PG8_MMA(0, 1, At, B1); PG8_BAR; PG8_SCHED;
            PG8_LDA(At, 0, 1); PG8_STAGE(PG8_SB(0, 0), b2, voffB); PG8_STAGE(PG8_SB(0, 1), b2 + hstep, voffB); PG8_STAGE(PG8_SA(0, 0), a2, voffA);
            PG8_WAIT_V(8); PG8_WAIT_L(0); PG8_BAR; PG8_MMA(1, 0, At, B0); PG8_MMA(1, 1, At, B1); PG8_BAR; PG8_SCHED;
            PG8_LDB(B0, 1, 0); PG8_LDB(B1, 1, 1); PG8_SCHED; PG8_LDA(At, 1, 0); PG8_STAGE(PG8_SA(0, 1), a2 + hstep, voffA);
            PG8_WAIT_V(8); PG8_WAIT_L(0); PG8_BAR; PG8_MMA(0, 0, At, B0); PG8_MMA(0, 1, At, B1); PG8_BAR; PG8_SCHED;
            PG8_LDA(At, 1, 1); PG8_STAGE(PG8_SB(1, 0), b3, voffB); PG8_STAGE(PG8_SB(1, 1), b3 + hstep, voffB); PG8_STAGE(PG8_SA(1, 0), a3, voffA);
            PG8_WAIT_V(8); PG8_WAIT_L(0); PG8_BAR; PG8_MMA(1, 0, At, B0); PG8_MMA(1, 1, At, B1); PG8_BAR; PG8_SCHED;
            } else {
            PG8_LDB(B0, 0, 0); PG8_SCHED; PG8_LDA(At, 0, 0); PG8_STAGE(PG8_SA(1, 1), a1 + hstep, voffA);
            PG8_WAIT_L(8); PG8_BAR; PG8_WAIT_L(0); PG8_MMA(0, 0, At, B0); PG8_BAR; PG8_SCHED;
            PG8_LDB(B1, 0, 1); PG8_STAGE(PG8_SB(0, 0), b2, voffB);
            PG8_BAR; PG8_WAIT_L(0); PG8_MMA(0, 1, At, B1); PG8_BAR;
            PG8_LDA(At, 0, 1); PG8_STAGE(PG8_SA(0, 0), a2, voffA);
            PG8_BAR; PG8_WAIT_L(0); PG8_MMA(1, 0, At, B0); PG8_BAR; PG8_SCHED;
            PG8_STAGE(PG8_SB(0, 1), b2 + hstep, voffB);
            PG8_WAIT_V(6); PG8_BAR; PG8_MMA(1, 1, At, B1); PG8_BAR;
            PG8_LDB(B0, 1, 0); PG8_SCHED; PG8_LDA(At, 1, 0); PG8_STAGE(PG8_SA(0, 1), a2 + hstep, voffA);
            PG8_WAIT_L(8); PG8_BAR; PG8_WAIT_L(0); PG8_MMA(0, 0, At, B0); PG8_BAR; PG8_SCHED;
            PG8_LDB(B1, 1, 1); PG8_STAGE(PG8_SB(1, 0), b3, voffB);
            PG8_BAR; PG8_WAIT_L(0); PG8_MMA(0, 1, At, B1); PG8_BAR;
            PG8_LDA(At, 1, 1); PG8_STAGE(PG8_SA(1, 0), a3, voffA);
            PG8_BAR; PG8_WAIT_L(0); PG8_MMA(1, 0, At, B0); PG8_BAR; PG8_SCHED;
            PG8_STAGE(PG8_SB(1, 1), b3 + hstep, voffB);
            PG8_WAIT_V(6); PG8_BAR; PG8_MMA(1, 1, At, B1); PG8_BAR;
            }
        }
        if constexpr (ALIGN_EPI) { if (wr == 0) PG8_BAR; }
        if constexpr (!Epi::AFTER_DRAIN) { E(acc, cur, wr, wc, fr, fq); S.done(cur); }
        if (!has_next) break;
#pragma unroll
        for (int a = 0; a < 2; ++a)
#pragma unroll
            for (int b = 0; b < 2; ++b)
#pragma unroll
                for (int m = 0; m < 4; ++m)
#pragma unroll
                    for (int n = 0; n < 2; ++n) acc[a][b][m][n] = (f32x4){0.f, 0.f, 0.f, 0.f};
        cur = nxt; cA = nA; cB = nB; ++ui;
        if constexpr (ALIGN_EPI) { if (wr == 1) PG8_BAR; }
    }
    PG8_WAIT_V(0);
    if constexpr (!ALIGN_EPI) { if (wr == 0) PG8_BAR; }
    PG8_BAR;
    if constexpr (Epi::AFTER_DRAIN) { E.fused(acc, cur, wr, wc, fr, fq, lds, wid, lane); S.done(cur); }
#undef PG8_SA
#undef PG8_SB
#undef PG8_STAGE
#undef PG8_LDA
#undef PG8_LDB
#undef PG8_MMA
#undef PG8_WAIT_V
#undef PG8_WAIT_L
#undef PG8_BAR
#undef PG8_SCHED
}

__device__ __forceinline__ float silu_f(float x) { return x * __builtin_amdgcn_rcpf(1.f + __builtin_amdgcn_exp2f(-1.44269504089f * x)); }

struct EpiSwiglu {
    static constexpr bool PERM = true, AFTER_DRAIN = false;
    bf16_t* O;
    __device__ __forceinline__ void operator()(const f32x4 (&acc)[2][2][4][2], const Unit& u, int wr, int wc, int fr, int fq) const {
        const int row0 = u.pm * BM + wr * 64 + fr, col0 = u.pn * 128 + wc * 32 + 8 * fq;
#pragma unroll
        for (int ai = 0; ai < 2; ++ai)
#pragma unroll
            for (int m = 0; m < 4; ++m) {
                bf16_t* rowp = O + (size_t)(row0 + ai * HALF + m * 16) * 2816 + col0;
                const f32x4 g0 = acc[ai][0][m][0], g1 = acc[ai][0][m][1], u0 = acc[ai][1][m][0], u1 = acc[ai][1][m][1];
                u32x4 o;
                o.x = cvt_pk_bf16(silu_f(g0[0]) * u0[0], silu_f(g0[1]) * u0[1]); o.y = cvt_pk_bf16(silu_f(g0[2]) * u0[2], silu_f(g0[3]) * u0[3]);
                o.z = cvt_pk_bf16(silu_f(g1[0]) * u1[0], silu_f(g1[1]) * u1[1]); o.w = cvt_pk_bf16(silu_f(g1[2]) * u1[2], silu_f(g1[3]) * u1[3]);
                *(u32x4*)rowp = o;
            }
    }
};
struct EpiResid {
    static constexpr bool PERM = false, AFTER_DRAIN = false;
    const void* hin; void* hout; const float* gt; float scale; int in_f32, out_f32;
    template <bool INF, bool OUTF> __device__ __forceinline__ void run(const f32x4 (&acc)[2][2][4][2], const f32x4 (&gv)[2][2], int row0, int col0) const {
#pragma unroll
        for (int ai = 0; ai < 2; ++ai)
#pragma unroll
            for (int m = 0; m < 4; ++m) {
                const size_t off = (size_t)(row0 + ai * HALF + m * 16) * 1024 + col0;
#pragma unroll
                for (int bj = 0; bj < 2; ++bj)
#pragma unroll
                    for (int n = 0; n < 2; ++n) {
                        const size_t o = off + bj * HALF + n * 16;
                        f32x4 hv;
                        if (INF) hv = *(const f32x4*)((const float*)hin + o);
                        else { const uint2 u = *(const uint2*)((const bf16_t*)hin + o); const f32x2_t a = f16x2_to_f32(u.x), c = f16x2_to_f32(u.y); hv = (f32x4){a[0], a[1], c[0], c[1]}; }
                        const f32x4 r = hv + gv[bj][n] * acc[ai][bj][m][n];
                        if (OUTF) *(f32x4*)((float*)hout + o) = r;
                        else { uint2 w; w.x = cvt_pk_f16(r[0], r[1]); w.y = cvt_pk_f16(r[2], r[3]); *(uint2*)((bf16_t*)hout + o) = w; }
                    }
            }
    }
    __device__ __forceinline__ void operator()(const f32x4 (&acc)[2][2][4][2], const Unit& u, int wr, int wc, int fr, int fq) const {
        const int row0 = u.pm * BM + wr * 64 + fr, col0 = u.pn * BM + wc * 32 + 4 * fq;
        const float* gp = gt + (size_t)(u.pm >> 4) * 9216 + col0;
        f32x4 gv[2][2];
#pragma unroll
        for (int bj = 0; bj < 2; ++bj)
#pragma unroll
            for (int n = 0; n < 2; ++n) { const f32x4 t = *(const f32x4*)(gp + bj * HALF + n * 16); gv[bj][n] = (t + 1.0f) * scale; }
        if (in_f32) run<true, false>(acc, gv, row0, col0); else if (out_f32) run<false, true>(acc, gv, row0, col0); else run<false, false>(acc, gv, row0, col0);
    }
};
struct EpiProj {
    static constexpr bool PERM = false, AFTER_DRAIN = false;
    bf16_t* att; bf16_t* rw; bf16_t* cv;
    template <int LD, bool F16> __device__ __forceinline__ void put(const f32x4 (&acc)[2][2][4][2], bf16_t* base, int row0, int col0) const {
#pragma unroll
        for (int ai = 0; ai < 2; ++ai)
#pragma unroll
            for (int m = 0; m < 4; ++m) { bf16_t* rowp = base + (size_t)(row0 + ai * HALF + m * 16) * LD + col0;
#pragma unroll
                for (int bj = 0; bj < 2; ++bj)
#pragma unroll
                    for (int n = 0; n < 2; ++n) { const f32x4 v = acc[ai][bj][m][n]; uint2 o; o.x = F16 ? cvt_pk_f16(v[0], v[1]) : cvt_pk_bf16(v[0], v[1]); o.y = F16 ? cvt_pk_f16(v[2], v[3]) : cvt_pk_bf16(v[2], v[3]); *(uint2*)(rowp + bj * HALF + n * 16) = o; } }
    }
    __device__ __forceinline__ void operator()(const f32x4 (&acc)[2][2][4][2], const Unit& u, int wr, int wc, int fr, int fq) const {
        const int row0 = u.pm * BM + wr * 64 + fr, cl = wc * 32 + 4 * fq;
        if (u.pn >= 3 && u.pn < 7) put<1024, true>(acc, rw, row0, (u.pn - 3) * BM + cl);
        else put<768, false>(acc, u.pn < 3 ? att : cv, row0, (u.pn < 3 ? u.pn : u.pn - 7) * BM + cl);
    }
};
struct EpiAny {
    int kind; bool perm;
    EpiSwiglu sw; EpiResid rs; EpiProj pj;
    static constexpr bool AFTER_DRAIN = false;
    __device__ __forceinline__ void operator()(const f32x4 (&acc)[2][2][4][2], const Unit& u, int wr, int wc, int fr, int fq) const {
        if (kind == 0) sw(acc, u, wr, wc, fr, fq); else if (kind == 1) rs(acc, u, wr, wc, fr, fq); else pj(acc, u, wr, wc, fr, fq);
    }
};
}

#define LAS __attribute__((address_space(3)))
using pg8::bf16_t; using pg8::bf16x8; using pg8::f32x4; using pg8::u32x4; using pg8::cvt_pk_bf16; using pg8::cvt_pk_f16; using pg8::f16x2_to_f32; using pg8::f32x2_t;
constexpr int NTOK = 32768, SEQL = 4096, DM = 1024, DFF = 2816, DEPTH = 4;
constexpr int LDS_BYTES = 131072 + 64;
constexpr int PPL = 12;
constexpr int NPH = 1 + DEPTH * PPL;

constexpr size_t OFF_MOD = 0;
constexpr size_t OFF_LORA = OFF_MOD + 1179648;
constexpr size_t OFF_BONUS = OFF_LORA + 131072;
constexpr size_t OFF_WB = OFF_BONUS + 524288;
constexpr size_t WB_FFN1IN = 0, WB_FFN1OUT = 5767168, WB_MIXIN = WB_FFN1OUT + 2883584, WB_MIXOUT = WB_MIXIN + 2621440,
                 WB_FFN2IN = WB_MIXOUT + 1048576, WB_FFN2OUT = WB_FFN2IN + 5767168, WB_ELEMS = WB_FFN2OUT + 2883584;
constexpr size_t OFF_HN = OFF_WB + WB_ELEMS * 2;
constexpr size_t OFF_R1 = OFF_HN + (size_t)NTOK * 1024 * 2;
constexpr size_t R1_CONV = (size_t)NTOK * 768 * 2, R1_RWKV = 2 * R1_CONV, R1_BYTES = (size_t)NTOK * 2816 * 2;
constexpr size_t OFF_R2 = OFF_R1 + R1_BYTES;
constexpr int REC_B = 896;
constexpr size_t R2_G = (size_t)NTOK * 4 * REC_B;
constexpr size_t WS_BAR = OFF_R2 + R2_G + (size_t)NTOK * 256 * 2;
constexpr size_t OFF_WB2 = WS_BAR + 16384;
constexpr size_t OFF_LORA2 = OFF_WB2 + WB_ELEMS * 2;
constexpr size_t OFF_YS = OFF_LORA2 + 131072;
constexpr size_t OFF_HB = OFF_YS + (size_t)NTOK * 256 * 4;
constexpr size_t WS_END = OFF_HB + (size_t)NTOK * 1024 * 2;

struct Params { const float* in[28]; float* out; unsigned char* ws; int ph_lo, ph_hi; };

__device__ __forceinline__ float wave_sum(float v) {
#pragma unroll
    for (int o = 1; o < 64; o <<= 1) v += __shfl_xor(v, o);
    return v;
}
template <int CTRL> __device__ __forceinline__ float dpp_f(float x) { return __int_as_float(__builtin_amdgcn_update_dpp(0, __float_as_int(x), CTRL, 0xf, 0xf, true)); }
__device__ __forceinline__ float rowsum16(float x) {
    x += dpp_f<0x128>(x); x += dpp_f<0x124>(x); x += dpp_f<0x122>(x); x += dpp_f<0x121>(x); return x;
}
__device__ __forceinline__ float bflo(unsigned u) { return __uint_as_float(u << 16); }
__device__ __forceinline__ float bfhi(unsigned u) { return __uint_as_float(u & 0xffff0000u); }
__device__ __forceinline__ float sigmoid_f(float x) { return __builtin_amdgcn_rcpf(1.f + __builtin_amdgcn_exp2f(-1.44269504089f * x)); }

__device__ __forceinline__ void phase_mod(const Params& P, LAS unsigned char* lds, int tid, int wid, int lane, int bid, int nblk) {
    LAS float* cact = (LAS float*)lds;
    LAS float* red = (LAS float*)(lds + 32768);
    const float* c = P.in[1];
    float* MOD = (float*)(P.ws + OFF_MOD);
    for (int i = tid; i < 8192; i += 512) { const float v = c[i]; cact[i] = v / (1.f + __expf(-v)); }
    __syncthreads();
    for (int item = bid; item < 288; item += nblk) {
        const int l = item / 72, j0 = (item % 72) * 128, k0 = wid * 128;
        const float* W = P.in[2] + (size_t)l * 1024 * 9216 + j0 + 2 * lane;
        float a0[8], a1[8];
#pragma unroll
        for (int b = 0; b < 8; ++b) { a0[b] = 0.f; a1[b] = 0.f; }
#pragma unroll 8
        for (int k = 0; k < 128; ++k) {
            const float2 w = *(const float2*)(W + (size_t)(k0 + k) * 9216);
#pragma unroll
            for (int b = 0; b < 8; ++b) { const float ca = cact[b * 1024 + k0 + k]; a0[b] += ca * w.x; a1[b] += ca * w.y; }
        }
#pragma unroll
        for (int b = 0; b < 8; ++b) { red[(wid * 8 + b) * 128 + 2 * lane] = a0[b]; red[(wid * 8 + b) * 128 + 2 * lane + 1] = a1[b]; }
        __syncthreads();
        for (int o = tid; o < 1024; o += 512) {
            const int b = o >> 7, ci = o & 127; float s = 0.f;
#pragma unroll
            for (int w = 0; w < 8; ++w) s += red[(w * 8 + b) * 128 + ci];
            MOD[(size_t)(l * 8 + b) * 9216 + j0 + ci] = s + P.in[3][l * 9216 + j0 + ci];
        }
        __syncthreads();
    }
}

__device__ __forceinline__ void transpose_item(const float* W, int K, int N, bf16_t* WT, int k0, int n0, int drow0, LAS float* scr, int lane) {
#pragma unroll 8
    for (int i = 0; i < 32; ++i) { const int kk = 2 * i + (lane >> 5); scr[kk * 33 + (lane & 31)] = W[(size_t)(k0 + kk) * N + n0 + (lane & 31)]; }
    asm volatile("s_waitcnt lgkmcnt(0)" ::: "memory");
    const int c = lane & 7;
#pragma unroll
    for (int j = 0; j < 4; ++j) { const int n = (lane >> 3) + 8 * j; const LAS float* s = scr + (8 * c) * 33 + n;
        u32x4 o; o.x = cvt_pk_bf16(s[0 * 33], s[1 * 33]); o.y = cvt_pk_bf16(s[2 * 33], s[3 * 33]); o.z = cvt_pk_bf16(s[4 * 33], s[5 * 33]); o.w = cvt_pk_bf16(s[6 * 33], s[7 * 33]);
        *(u32x4*)(WT + (size_t)(drow0 + n) * K + k0 + 8 * c) = o; }
    asm volatile("s_waitcnt lgkmcnt(0)" ::: "memory");
}
__device__ __forceinline__ int swiglu_row(int n0) { return n0 < DFF ? ((n0 >> 7) * 256 + (n0 & 127)) : (((n0 - DFF) >> 7) * 256 + 128 + ((n0 - DFF) & 127)); }
__device__ __forceinline__ void phase_convert(const Params& P, int l, LAS unsigned char* lds, int wid, int lane, int bid, int nblk) {
    LAS float* scr = (LAS float*)(lds + wid * 8448);
    bf16_t* WB = (bf16_t*)(P.ws + ((l & 1) ? OFF_WB2 : OFF_WB));
    bf16_t* LT = (bf16_t*)(P.ws + ((l & 1) ? OFF_LORA2 : OFF_LORA));
    const int gw = bid * 8 + wid, NGW = nblk * 8;
    constexpr int I_IN = 16 * 176, I_OUT = 44 * 32, I_MI = 16 * 80, I_MO = 16 * 32;
    constexpr int NIT = 2 * I_IN + 2 * I_OUT + I_MI + I_MO + 32;
    for (int it = gw; it < NIT; it += NGW) {
        int r = it;
        if (r < I_IN) { const int kb = r / 176, nb = r % 176; transpose_item(P.in[5] + (size_t)l * 1024 * 5632, 1024, 5632, WB + WB_FFN1IN, kb * 64, nb * 32, swiglu_row(nb * 32), scr, lane); continue; } r -= I_IN;
        if (r < I_OUT) { const int kb = r / 32, nb = r % 32; transpose_item(P.in[6] + (size_t)l * 2816 * 1024, 2816, 1024, WB + WB_FFN1OUT, kb * 64, nb * 32, nb * 32, scr, lane); continue; } r -= I_OUT;
        if (r < I_MI) { const int kb = r / 80, nb = r % 80; transpose_item(P.in[8] + (size_t)l * 1024 * 2560, 1024, 2560, WB + WB_MIXIN, kb * 64, nb * 32, nb * 32, scr, lane); continue; } r -= I_MI;
        if (r < I_MO) { const int kb = r / 32, nb = r % 32; transpose_item(P.in[9] + (size_t)l * 1024 * 1024, 1024, 1024, WB + WB_MIXOUT, kb * 64, nb * 32, nb * 32, scr, lane); continue; } r -= I_MO;
        if (r < I_IN) { const int kb = r / 176, nb = r % 176; transpose_item(P.in[26] + (size_t)l * 1024 * 5632, 1024, 5632, WB + WB_FFN2IN, kb * 64, nb * 32, swiglu_row(nb * 32), scr, lane); continue; } r -= I_IN;
        if (r < I_OUT) { const int kb = r / 32, nb = r % 32; transpose_item(P.in[27] + (size_t)l * 2816 * 1024, 2816, 1024, WB + WB_FFN2OUT, kb * 64, nb * 32, nb * 32, scr, lane); continue; } r -= I_OUT;
        if (r < 8) { transpose_item(P.in[15] + (size_t)l * 64 * 256, 64, 256, LT, 0, r * 32, r * 32, scr, lane); continue; } r -= 8;
        if (r < 8) { transpose_item(P.in[17] + (size_t)l * 64 * 256, 64, 256, LT + 16384, 0, r * 32, r * 32, scr, lane); continue; } r -= 8;
        { const int kb = r / 8, nb = r % 8; transpose_item(P.in[18] + (size_t)l * 128 * 256, 128, 256, LT + 32768, kb * 64, nb * 32, nb * 32, scr, lane); }
    }
}

template <bool INF>
__device__ __forceinline__ void phase_norm(const Params& P, const void* hin, const float* gain, const float* modl  , int wid, int lane, int bid, int nblk) {
    bf16_t* HN = (bf16_t*)(P.ws + OFF_HN);
    for (int row0 = (bid * 8 + wid) * 4; row0 < NTOK; row0 += nblk * 32) {
        f32x4 v[4][4]; float ss[4];
#pragma unroll
        for (int r = 0; r < 4; ++r) {
            if (INF) { const f32x4* xr = (const f32x4*)((const float*)hin + (size_t)(row0 + r) * 1024) + lane;
#pragma unroll
                for (int j = 0; j < 4; ++j) v[r][j] = xr[64 * j]; }
            else { const uint2* xr = (const uint2*)((const bf16_t*)hin + (size_t)(row0 + r) * 1024) + lane;
#pragma unroll
                for (int j = 0; j < 4; ++j) { const uint2 u = xr[64 * j]; const pg8::f32x2_t a = pg8::f16x2_to_f32(u.x), c = pg8::f16x2_to_f32(u.y); v[r][j] = (f32x4){a[0], a[1], c[0], c[1]}; } }
        }
#pragma unroll
        for (int r = 0; r < 4; ++r) { float a = 0.f;
#pragma unroll
            for (int j = 0; j < 4; ++j) a += (v[r][j][0] * v[r][j][0] + v[r][j][1] * v[r][j][1]) + (v[r][j][2] * v[r][j][2] + v[r][j][3] * v[r][j][3]);
            ss[r] = a; }
#pragma unroll
        for (int o = 1; o < 64; o <<= 1) {
#pragma unroll
            for (int r = 0; r < 4; ++r) ss[r] += __shfl_xor(ss[r], o);
        }
        const float* sh = modl + (size_t)(row0 >> 12) * 9216; const float* sc = sh + 1024;
#pragma unroll
        for (int j = 0; j < 4; ++j) {
            const int col = lane * 4 + 256 * j;
            const f32x4 g = *(const f32x4*)(gain + col), s1 = *(const f32x4*)(sc + col), s0 = *(const f32x4*)(sh + col);
            const f32x4 gs = g * (s1 + 1.0f);
#pragma unroll
            for (int r = 0; r < 4; ++r) {
                const float rstd = rsqrtf(ss[r] * (1.f / 1024.f) + 1e-6f);
                const f32x4 y = v[r][j] * rstd * gs + s0;
                uint2 o; o.x = cvt_pk_bf16(y[0], y[1]); o.y = cvt_pk_bf16(y[2], y[3]);
                ((uint2*)(HN + (size_t)(row0 + r) * 1024) + lane)[64 * j] = o;
            }
        }
    }
}

__device__ __forceinline__ void phase_norm16(const Params& P, const void* hin, const float* gain, const float* modl, int wid, int lane, int bid, int nblk) {
    bf16_t* HN = (bf16_t*)(P.ws + OFF_HN);
    for (int row0 = (bid * 8 + wid) * 8; row0 < NTOK; row0 += nblk * 64) {
        uint2 pk[8][4]; float ss[8];
#pragma unroll
        for (int r = 0; r < 8; ++r) { const uint2* xr = (const uint2*)((const bf16_t*)hin + (size_t)(row0 + r) * 1024) + lane;
#pragma unroll
            for (int j = 0; j < 4; ++j) pk[r][j] = xr[64 * j]; }
#pragma unroll
        for (int r = 0; r < 8; ++r) { float a = 0.f;
#pragma unroll
            for (int j = 0; j < 4; ++j) { const f32x2_t x01 = f16x2_to_f32(pk[r][j].x), x23 = f16x2_to_f32(pk[r][j].y); a += (x01[0] * x01[0] + x01[1] * x01[1]) + (x23[0] * x23[0] + x23[1] * x23[1]); }
            ss[r] = a; }
#pragma unroll
        for (int o = 1; o < 64; o <<= 1) {
#pragma unroll
            for (int r = 0; r < 8; ++r) ss[r] += __shfl_xor(ss[r], o);
        }
        const float* sh = modl + (size_t)(row0 >> 12) * 9216; const float* sc = sh + 1024;
#pragma unroll
        for (int j = 0; j < 4; ++j) {
            const int col = lane * 4 + 256 * j;
            const f32x4 g = *(const f32x4*)(gain + col), s1 = *(const f32x4*)(sc + col), s0 = *(const f32x4*)(sh + col);
            const f32x4 gs = g * (s1 + 1.0f);
#pragma unroll
            for (int r = 0; r < 8; ++r) {
                const float rstd = rsqrtf(ss[r] * (1.f / 1024.f) + 1e-6f);
                const f32x2_t x01 = f16x2_to_f32(pk[r][j].x), x23 = f16x2_to_f32(pk[r][j].y);
                const f32x4 y = (f32x4){x01[0], x01[1], x23[0], x23[1]} * rstd * gs + s0;
                uint2 o; o.x = cvt_pk_bf16(y[0], y[1]); o.y = cvt_pk_bf16(y[2], y[3]);
                ((uint2*)(HN + (size_t)(row0 + r) * 1024) + lane)[64 * j] = o;
            }
        }
    }
}

__device__ __forceinline__ bf16x8 pack8(const float* f) {
    u32x4 o; o.x = cvt_pk_bf16(f[0], f[1]); o.y = cvt_pk_bf16(f[2], f[3]); o.z = cvt_pk_bf16(f[4], f[5]); o.w = cvt_pk_bf16(f[6], f[7]);
    return __builtin_bit_cast(bf16x8, o);
}
__device__ __forceinline__ void attn_item(const Params& P, int l, int item, LAS unsigned char* lds, int tid, int wid, int lane, int var) {
    const bf16_t* PA = (const bf16_t*)(P.ws + OFF_R1);
    bf16_t* Y = (bf16_t*)(P.ws + OFF_HN);
    const int b = item >> 6, n = (item >> 1) & 31, hk = item & 1;
    LAS bf16_t* Ks = (LAS bf16_t*)lds;
    LAS bf16_t* Vt = (LAS bf16_t*)(lds + 36864);
    const float* kg = P.in[11] + l * 64; const float* qg = P.in[10] + l * 64;
    {
        const int row = tid >> 1, half = tid & 1, kt = n * 128 - 128 + row;
        u32x4 kv[4], vv[4];
        if (kt >= 0) {
            const bf16_t* src = PA + (size_t)(b * SEQL + kt) * 768 + 512 + hk * 64 + half * 32;
#pragma unroll
            for (int i = 0; i < 4; ++i) { kv[i] = ((const u32x4*)src)[i]; vv[i] = ((const u32x4*)(src + 128))[i]; }
        } else {
#pragma unroll
            for (int i = 0; i < 4; ++i) { kv[i] = (u32x4){0u, 0u, 0u, 0u}; vv[i] = (u32x4){0u, 0u, 0u, 0u}; }
        }
        float kf[32]; float ss = 0.f;
#pragma unroll
        for (int i = 0; i < 4; ++i)
#pragma unroll
            for (int j = 0; j < 4; ++j) { const float a = bflo(kv[i][j]), c = bfhi(kv[i][j]); kf[i * 8 + 2 * j] = a; kf[i * 8 + 2 * j + 1] = c; ss += a * a + c * c; }
        ss += __shfl_xor(ss, 1);
        const float rstd = rsqrtf(ss * (1.f / 64.f) + 1e-6f);
#pragma unroll
        for (int i = 0; i < 32; ++i) kf[i] *= rstd * kg[half * 32 + i];
#pragma unroll
        for (int i = 0; i < 4; ++i) *(LAS bf16x8*)(Ks + row * 72 + half * 32 + i * 8) = pack8(kf + i * 8);
        const int r32 = row & 31, kp = (row & ~31) + ((r32 & 15) >> 2) * 8 + (r32 >> 4) * 4 + (r32 & 3);
#pragma unroll
        for (int i = 0; i < 4; ++i)
#pragma unroll
            for (int j = 0; j < 4; ++j) { const unsigned w = vv[i][j]; Vt[(half * 32 + i * 8 + 2 * j) * 264 + kp] = (bf16_t)(w & 0xffffu); Vt[(half * 32 + i * 8 + 2 * j + 1) * 264 + kp] = (bf16_t)(w >> 16); }
    }
    __syncthreads();
    const int fr = lane & 15, fq = lane >> 4, hq = hk * 4 + (wid >> 1);
    const float sink = P.in[12][l * 8 + hq];
    for (int i = 0; i < 4; ++i) {
        if (var == 1) { asm volatile("s_waitcnt vmcnt(0) lgkmcnt(0)" ::: "memory"); __syncthreads(); }
        const int q0 = ((wid & 1) * 4 + i) * 16, kb0 = q0 >> 5;
        const bf16_t* qp = PA + (size_t)(b * SEQL + n * 128 + q0 + fr) * 768 + hq * 64 + fq * 8;
        const u32x4 qa = *(const u32x4*)qp, qb = *(const u32x4*)(qp + 32);
        float qf[16]; float ss = 0.f;
#pragma unroll
        for (int j = 0; j < 4; ++j) { qf[2 * j] = bflo(qa[j]); qf[2 * j + 1] = bfhi(qa[j]); qf[8 + 2 * j] = bflo(qb[j]); qf[8 + 2 * j + 1] = bfhi(qb[j]); }
#pragma unroll
        for (int j = 0; j < 16; ++j) ss += qf[j] * qf[j];
        ss += __shfl_xor(ss, 16); ss += __shfl_xor(ss, 32);
        const float rstd = rsqrtf(ss * (1.f / 64.f) + 1e-6f) * 0.125f;
#pragma unroll
        for (int j = 0; j < 8; ++j) { qf[j] *= rstd * qg[fq * 8 + j]; qf[8 + j] *= rstd * qg[32 + fq * 8 + j]; }
        const bf16x8 Q0 = pack8(qf), Q1 = pack8(qf + 8);
        f32x4 s[10];
#pragma unroll
        for (int tt = 0; tt < 10; ++tt) {
            const LAS bf16_t* kr = Ks + ((2 * kb0 + tt) * 16 + fr) * 72 + fq * 8;
            const bf16x8 K0 = *(const LAS bf16x8*)kr, K1 = *(const LAS bf16x8*)(kr + 32);
            f32x4 z = (f32x4){0.f, 0.f, 0.f, 0.f};
            z = __builtin_amdgcn_mfma_f32_16x16x32_bf16(K0, Q0, z, 0, 0, 0);
            s[tt] = __builtin_amdgcn_mfma_f32_16x16x32_bf16(K1, Q1, z, 0, 0, 0);
        }
        if (var == 3) {
#pragma unroll
            for (int tt = 0; tt < 10; ++tt) s[tt] = (f32x4){0.25f, 0.5f, 0.125f, 0.375f};
        }
        const int qi = q0 + fr;
        float m = sink;
#pragma unroll
        for (int tt = 0; tt < 10; ++tt)
#pragma unroll
            for (int j = 0; j < 4; ++j) {
                const int kidx = (2 * kb0 + tt) * 16 + fq * 4 + j;
                const bool vis = (kidx > qi) && (kidx <= qi + 128) && (n > 0 || kidx >= 128);
                const float sv = vis ? s[tt][j] : -INFINITY; s[tt][j] = sv; m = fmaxf(m, sv);
            }
        m = fmaxf(m, __shfl_xor(m, 16)); m = fmaxf(m, __shfl_xor(m, 32));
        float sum = 0.f;
#pragma unroll
        for (int tt = 0; tt < 10; ++tt)
#pragma unroll
            for (int j = 0; j < 4; ++j) { const float p = __expf(s[tt][j] - m); s[tt][j] = p; sum += p; }
        sum += __shfl_xor(sum, 16); sum += __shfl_xor(sum, 32);
        sum += __expf(sink - m);
        const float inv = 1.f / sum;
        f32x4 o[4];
#pragma unroll
        for (int dt = 0; dt < 4; ++dt) o[dt] = (f32x4){0.f, 0.f, 0.f, 0.f};
        if (var == 2) {
#pragma unroll
            for (int dt = 0; dt < 4; ++dt) o[dt] = s[dt] + s[4 + dt] + s[(8 + dt) > 9 ? 9 : 8 + dt];
        } else
        {
#pragma unroll
        for (int kb = 0; kb < 5; ++kb) {
            float pf[8];
#pragma unroll
            for (int j = 0; j < 4; ++j) { pf[j] = s[2 * kb][j] * inv; pf[4 + j] = s[2 * kb + 1][j] * inv; }
            const bf16x8 Pf = pack8(pf);
#pragma unroll
            for (int dt = 0; dt < 4; ++dt) {
                const bf16x8 Vf = *(const LAS bf16x8*)(Vt + (dt * 16 + fr) * 264 + (kb0 + kb) * 32 + fq * 8);
                o[dt] = __builtin_amdgcn_mfma_f32_16x16x32_bf16(Pf, Vf, o[dt], 0, 0, 0);
            }
        }
        }
#pragma unroll
        for (int dt = 0; dt < 4; ++dt)
#pragma unroll
            for (int j = 0; j < 4; ++j)
                Y[(size_t)(b * SEQL + n * 128 + q0 + fq * 4 + j) * 1024 + hq * 64 + dt * 16 + fr] = (bf16_t)(cvt_pk_bf16(o[dt][j], 0.f) & 0xffffu);
    }
    __syncthreads();
}

__device__ __forceinline__ void conv_part(const Params& P, int l, int tid, int bid, int nblk) {
    const bf16_t* PC = (const bf16_t*)(P.ws + OFF_R1 + R1_CONV);
    bf16_t* Y = (bf16_t*)(P.ws + OFF_HN);
    const float* cw = P.in[24] + l * 768;
    for (int idx = bid * 512 + tid; idx < NTOK * 32; idx += nblk * 512) {
        const int tok = idx >> 5, c = (idx & 31) * 8, t = tok & (SEQL - 1);
        const bf16_t* p = PC + (size_t)tok * 768 + c;
        const u32x4 bg = *(const u32x4*)p;
        float u[3][8];
#pragma unroll
        for (int d = 0; d < 3; ++d) {
            if (t >= d) { const u32x4 cg4 = *(const u32x4*)(p - d * 768 + 256), hg = *(const u32x4*)(p - d * 768 + 512);
#pragma unroll
                for (int j = 0; j < 4; ++j) { u[d][2 * j] = bflo(cg4[j]) * bflo(hg[j]); u[d][2 * j + 1] = bfhi(cg4[j]) * bfhi(hg[j]); }
            } else {
#pragma unroll
                for (int j = 0; j < 8; ++j) u[d][j] = 0.f;
            }
        }
        float y[8];
#pragma unroll
        for (int j = 0; j < 8; ++j) {
            const float bgv = (j & 1) ? bfhi(bg[j >> 1]) : bflo(bg[j >> 1]);
            y[j] = bgv * (cw[c + j] * u[2][j] + cw[256 + c + j] * u[1][j] + cw[512 + c + j] * u[0][j]);
        }
        *(bf16x8*)(Y + (size_t)tok * 1024 + 768 + c) = pack8(y);
    }
}

template <int MODE>
__device__ __forceinline__ void prep_tile(const Params& P, int l, int tile, LAS unsigned char* lds, int tid, int wid, int lane) {
    const bf16_t* PR = (const bf16_t*)(P.ws + OFF_R1 + R1_RWKV);
    unsigned char* REC = P.ws + OFF_R2;
    bf16_t* G = (bf16_t*)(P.ws + OFF_R2 + R2_G);
    float* BON = (float*)(P.ws + OFF_BONUS);
    LAS bf16_t* Xs = (LAS bf16_t*)lds;
    const float* mu = P.in[13] + l * 1024;
    const int tok0 = tile * 64;
    {
        const int t = tid >> 3, seg = tid & 7, tok = tok0 + t; const bool first = (tok & (SEQL - 1)) == 0;
        const bf16_t* p = PR + (size_t)tok * 1024 + 768 + seg * 32;
        const float c1 = seg < 2 ? 2.f : 1.f, c2 = seg < 2 ? 2.f : 1.f, c3 = seg < 2 ? -1.f : 0.f; const bool ident = (seg == 2 || seg == 3);
        if ((MODE == 0) == (seg < 4)) {
#pragma unroll
        for (int i = 0; i < 4; ++i) {
            float xo[8];
            const u32x4 ca = ((const u32x4*)p)[i], cp = first ? (u32x4){0u, 0u, 0u, 0u} : ((const u32x4*)(p - 1024))[i];
#pragma unroll
            for (int hh = 0; hh < 2; ++hh) {
                const f32x2_t a01 = f16x2_to_f32(ca[2 * hh]), a23 = f16x2_to_f32(ca[2 * hh + 1]), p01 = f16x2_to_f32(cp[2 * hh]), p23 = f16x2_to_f32(cp[2 * hh + 1]);
                const f32x4 a = (f32x4){a01[0], a01[1], a23[0], a23[1]};
                const f32x4 pv = (f32x4){p01[0], p01[1], p23[0], p23[1]};
                const f32x4 m = ((const f32x4*)(mu + 768 + seg * 32))[2 * i + hh];
                const f32x4 x = a + m * (pv - a);
#pragma unroll
                for (int j = 0; j < 4; ++j) { const float sg = sigmoid_f(c1 * x[j]) * c2 + c3; xo[hh * 4 + j] = ident ? x[j] : sg; }
            }
            *(LAS bf16x8*)(Xs + t * 264 + seg * 32 + i * 8) = pack8(xo);
        }
        }
    }
    __syncthreads();
    const int fr = lane & 15, fq = lane >> 4, hh = wid & 3;
    const bf16_t* WTw = (const bf16_t*)(P.ws + ((l & 1) ? OFF_LORA2 : OFF_LORA)); const bf16_t* WTa = WTw + 16384; const bf16_t* WTg = WTw + 32768;
    const float* w0 = P.in[14] + l * 256; const float* a0 = P.in[16] + l * 256; const float* k_k = P.in[19] + l * 256;
    const float* k_a = P.in[20] + l * 256; const float* r_k = P.in[21] + l * 256;
#pragma unroll
    for (int ti = 0; ti < 2; ++ti) {
        const int tq = (wid >> 2) * 2 + ti;
        bf16x8 xb[8];
#pragma unroll
        for (int ks = (MODE == 0 ? 0 : 4); ks < (MODE == 0 ? 4 : 8); ++ks) xb[ks] = *(const LAS bf16x8*)(Xs + (tq * 16 + fr) * 264 + ks * 32 + fq * 8);
        f32x4 aw[4], aa[4], ag[4];
#pragma unroll
        for (int ct = 0; ct < 4; ++ct) {
            const int col = hh * 64 + ct * 16 + fr;
            f32x4 z = (f32x4){0.f, 0.f, 0.f, 0.f};
            if (MODE == 0) {
#pragma unroll
            for (int ks = 0; ks < 2; ++ks) z = __builtin_amdgcn_mfma_f32_16x16x32_bf16(*(const bf16x8*)(WTw + col * 64 + ks * 32 + fq * 8), xb[ks], z, 0, 0, 0);
            aw[ct] = z; z = (f32x4){0.f, 0.f, 0.f, 0.f};
#pragma unroll
            for (int ks = 0; ks < 2; ++ks) z = __builtin_amdgcn_mfma_f32_16x16x32_bf16(*(const bf16x8*)(WTa + col * 64 + ks * 32 + fq * 8), xb[2 + ks], z, 0, 0, 0);
            aa[ct] = z; z = (f32x4){0.f, 0.f, 0.f, 0.f};
            } else {
#pragma unroll
            for (int ks = 0; ks < 4; ++ks) z = __builtin_amdgcn_mfma_f32_16x16x32_bf16(*(const bf16x8*)(WTg + col * 128 + ks * 32 + fq * 8), xb[4 + ks], z, 0, 0, 0);
            ag[ct] = z;
            }
        }
        const int tok = tok0 + tq * 16 + fr; const bool first = (tok & (SEQL - 1)) == 0;
        if (MODE == 1) {
#pragma unroll
            for (int ct = 0; ct < 4; ++ct) { const int c4 = hh * 64 + ct * 16 + fq * 4; uint2 go; go.x = cvt_pk_f16(ag[ct][0], ag[ct][1]); go.y = cvt_pk_f16(ag[ct][2], ag[ct][3]);
                *(uint2*)(G + (size_t)tok * 256 + c4) = go; }
            continue;
        }
        const bf16_t* pr = PR + (size_t)tok * 1024;
        unsigned char* rec = REC + ((size_t)tok * 4 + hh) * REC_B;
        f32x4 kkv[4], av[4]; float ss = 0.f, bon = 0.f;
        uint2 cur[4][3], prv[4][3];
#pragma unroll
        for (int ct = 0; ct < 4; ++ct)
#pragma unroll
            for (int q = 0; q < 3; ++q) {
                const int c4 = hh * 64 + ct * 16 + fq * 4;
                cur[ct][q] = *(const uint2*)(pr + q * 256 + c4);
                prv[ct][q] = first ? (uint2){0u, 0u} : *(const uint2*)(pr - 1024 + q * 256 + c4);
            }
#pragma unroll
        for (int ct = 0; ct < 4; ++ct) {
            const int c4 = hh * 64 + ct * 16 + fq * 4, lo = ct * 16 + fq * 4;
            f32x4 x3[3];
#pragma unroll
            for (int q = 0; q < 3; ++q) {
                const f32x4 m = *(const f32x4*)(mu + q * 256 + c4);
                const uint2 cu = cur[ct][q], pu = prv[ct][q];
                const f32x2_t c01 = f16x2_to_f32(cu.x), c23 = f16x2_to_f32(cu.y), q01 = f16x2_to_f32(pu.x), q23 = f16x2_to_f32(pu.y);
                const f32x4 cf = (f32x4){c01[0], c01[1], c23[0], c23[1]}, pf = (f32x4){q01[0], q01[1], q23[0], q23[1]};
                x3[q] = cf + m * (pf - cf);
            }
            const f32x4 r4 = x3[0], k4 = x3[1], v4 = x3[2];
            const f32x4 w0v = *(const f32x4*)(w0 + c4), a0v = *(const f32x4*)(a0 + c4), kkw = *(const f32x4*)(k_k + c4), kaw = *(const f32x4*)(k_a + c4), rkw = *(const f32x4*)(r_k + c4);
            f32x4 dec, a4, kp;
#pragma unroll
            for (int j = 0; j < 4; ++j) {
                const float w = w0v[j] + aw[ct][j];
                dec[j] = __builtin_amdgcn_exp2f((-0.6065306597126334f * 1.4426950408889634f) * sigmoid_f(w));
                a4[j] = sigmoid_f(a0v[j] + aa[ct][j]);
            }
            kkv[ct] = k4 * kkw; av[ct] = a4;
            kp = k4 * ((a4 - 1.0f) * kaw + 1.0f);
#pragma unroll
            for (int j = 0; j < 4; ++j) { ss += kkv[ct][j] * kkv[ct][j]; bon += r4[j] * kp[j] * rkw[j]; }
            *(f32x4*)(rec + lo * 4) = dec;
            { uint2 t; t.x = cvt_pk_f16(r4[0], r4[1]); t.y = cvt_pk_f16(r4[2], r4[3]); *(uint2*)(rec + 256 + 0 * 128 + lo * 2) = t;
              t.x = cvt_pk_f16(kp[0], kp[1]); t.y = cvt_pk_f16(kp[2], kp[3]); *(uint2*)(rec + 256 + 1 * 128 + lo * 2) = t;
              t.x = cvt_pk_f16(v4[0], v4[1]); t.y = cvt_pk_f16(v4[2], v4[3]); *(uint2*)(rec + 256 + 2 * 128 + lo * 2) = t; }
        }
        ss += __shfl_xor(ss, 16); ss += __shfl_xor(ss, 32); bon += __shfl_xor(bon, 16); bon += __shfl_xor(bon, 32);
        const float rn = ss > 1e-24f ? __builtin_amdgcn_rsqf(ss) : 1e12f;
#pragma unroll
        for (int ct = 0; ct < 4; ++ct) { const int lo = ct * 16 + fq * 4; const f32x4 kk = kkv[ct] * rn, ka = kk * av[ct]; uint2 t;
            t.x = cvt_pk_f16(kk[0], kk[1]); t.y = cvt_pk_f16(kk[2], kk[3]); *(uint2*)(rec + 256 + 3 * 128 + lo * 2) = t;
            t.x = cvt_pk_f16(ka[0], ka[1]); t.y = cvt_pk_f16(ka[2], ka[3]); *(uint2*)(rec + 256 + 4 * 128 + lo * 2) = t; }
        if (fq == 0) BON[(size_t)tok * 4 + hh] = bon;
    }
    __syncthreads();
}

__device__ __forceinline__ void scan_stage_piece(LAS float* buf, int idx, u32x4 w) {
    const int s = idx / 56, o = idx % 56;
    if (o < 16) { *(LAS u32x4*)(buf + s * 384 + 64 + o * 4) = w; }
    else {
        const int p = o - 16, q = p >> 3, j = p & 7, dq = q == 0 ? 0 : q + 1;
        LAS float* d = buf + s * 384 + dq * 64 + j * 8;
        const f32x2_t e0 = f16x2_to_f32(w[0]), e1 = f16x2_to_f32(w[1]), e2 = f16x2_to_f32(w[2]), e3 = f16x2_to_f32(w[3]);
        *(LAS f32x4*)d = (f32x4){e0[0], e0[1], e1[0], e1[1]};
        *(LAS f32x4*)(d + 4) = (f32x4){e2[0], e2[1], e3[0], e3[1]};
    }
}
__device__ __forceinline__ void phase_scan(const Params& P, LAS unsigned char* lds, int tid, int wid, int lane, int bid, int nblk) {
    const unsigned char* REC = P.ws + OFF_R2;
    float* YS = (float*)(P.ws + OFF_YS);
    for (int item = bid; item < 128; item += nblk) {
        const int bh = (item & 7) * 4 + ((item >> 3) & 3), rg = item >> 5, b = bh >> 2, h = bh & 3;
        const unsigned char* src0 = REC + ((size_t)(b * SEQL) * 4 + h) * REC_B;
        u32x4 st[7]; const int ltid = tid - 256;
        if (wid >= 4) {
#pragma unroll
            for (int i = 0; i < 7; ++i) { const int idx = ltid + 256 * i, s = idx / 56, o = idx % 56; st[i] = *(const u32x4*)(src0 + (size_t)s * (4 * REC_B) + o * 16); }
#pragma unroll
            for (int i = 0; i < 7; ++i) scan_stage_piece((LAS float*)lds, ltid + 256 * i, st[i]);
        }
        __syncthreads();
        typedef float f32x2v __attribute__((ext_vector_type(2)));
        f32x2v Sa = {0.f, 0.f}, Sb = {0.f, 0.f};
        const int rl = lane >> 4, kq = lane & 15, row = rg * 16 + (wid & 3) * 4 + rl;
        for (int ch = 0; ch < 128; ++ch) {
            if (wid >= 4 && ch + 1 < 128) {
#pragma unroll
                for (int i = 0; i < 7; ++i) { const int idx = ltid + 256 * i, s = idx / 56, o = idx % 56; st[i] = *(const u32x4*)(src0 + (size_t)((ch + 1) * 32 + s) * (4 * REC_B) + o * 16); }
            }
            if (wid < 4) {
                const LAS float* buf = (const LAS float*)(lds + (ch & 1) * 49152);
                float* yp = YS + (size_t)(b * SEQL + ch * 32 + kq) * 256 + h * 64 + row;
                const LAS float* rc = buf + kq * 4;
                const LAS float* rv = buf + 192 + row;
                f32x4 r4 = *(const LAS f32x4*)(rc), w4 = *(const LAS f32x4*)(rc + 64), k4 = *(const LAS f32x4*)(rc + 128), kk4 = *(const LAS f32x4*)(rc + 256), ka4 = *(const LAS f32x4*)(rc + 320);
                float v = rv[0];
                float oacc = 0.f;
#define LO2(x) __builtin_shufflevector(x, x, 0, 1)
#define HI2(x) __builtin_shufflevector(x, x, 2, 3)
#pragma unroll
                for (int s = 0; s < 32; ++s) {
                    f32x4 nr4 = r4, nw4 = w4, nk4 = k4, nkk4 = kk4, nka4 = ka4; float nv = v;
                    if (s + 1 < 32) {
                        const LAS float* rn = rc + (s + 1) * 384;
                        nr4 = *(const LAS f32x4*)(rn); nw4 = *(const LAS f32x4*)(rn + 64); nk4 = *(const LAS f32x4*)(rn + 128); nkk4 = *(const LAS f32x4*)(rn + 256); nka4 = *(const LAS f32x4*)(rn + 320);
                        nv = rv[(s + 1) * 384];
                    }
                    f32x2v d2 = Sa * LO2(kk4); d2 = Sb * HI2(kk4) + d2;
                    const float d = rowsum16(d2[0] + d2[1]);
                    const f32x2v vv = {v, v}, dd = {d, d};
                    f32x2v ta = Sa * LO2(w4), tb = Sb * HI2(w4);
                    ta = vv * LO2(k4) + ta; tb = vv * HI2(k4) + tb;
                    Sa = ta - dd * LO2(ka4); Sb = tb - dd * HI2(ka4);
                    f32x2v o2 = Sa * LO2(r4); o2 = Sb * HI2(r4) + o2;
                    const float o = rowsum16(o2[0] + o2[1]);
                    oacc = (kq == (s & 15)) ? o : oacc;
                    if ((s & 15) == 15) yp[(size_t)(s - 15) * 256] = oacc;
                    r4 = nr4; w4 = nw4; k4 = nk4; kk4 = nkk4; ka4 = nka4; v = nv;
                }
#undef LO2
#undef HI2
            }
            if (wid >= 4 && ch + 1 < 128) {
#pragma unroll
                for (int i = 0; i < 7; ++i) scan_stage_piece((LAS float*)(lds + ((ch + 1) & 1) * 49152), ltid + 256 * i, st[i]);
            }
            __syncthreads();
        }
    }
}

__device__ __forceinline__ void phase_post(const Params& P, int l, int tid, int bid, int nblk) {
    const float* YS = (const float*)(P.ws + OFF_YS);
    const unsigned char* REC = P.ws + OFF_R2;
    const bf16_t* G = (const bf16_t*)(P.ws + OFF_R2 + R2_G);
    const float* BON = (const float*)(P.ws + OFF_BONUS);
    bf16_t* Y = (bf16_t*)(P.ws + OFF_HN);
    const float* gw = P.in[22] + l * 256; const float* gb = P.in[23] + l * 256;
    const int stride = nblk * 512;
    for (int base = bid * 512 + tid; base < NTOK * 64; base += 4 * stride) {
        f32x4 y[4]; uint2 vu[4], gg[4]; float bon[4];
#pragma unroll
        for (int j = 0; j < 4; ++j) {
            const int idx = base + j * stride;
            if (idx < NTOK * 64) {
                const int l16 = idx & 15, th = idx >> 4, tok = th >> 2, h = th & 3, c = h * 64 + l16 * 4;
                y[j] = *(const f32x4*)(YS + (size_t)tok * 256 + c);
                vu[j] = *(const uint2*)(REC + ((size_t)tok * 4 + h) * REC_B + 256 + 2 * 128 + l16 * 8);
                gg[j] = *(const uint2*)(G + (size_t)tok * 256 + c);
                bon[j] = BON[(size_t)tok * 4 + h];
            }
        }
#pragma unroll
        for (int j = 0; j < 4; ++j) {
            const int idx = base + j * stride;
            if (idx < NTOK * 64) {
                const int l16 = idx & 15, th = idx >> 4, tok = th >> 2, h = th & 3, c = h * 64 + l16 * 4;
                const float mean = rowsum16((y[j][0] + y[j][1]) + (y[j][2] + y[j][3])) * (1.f / 64.f);
                const f32x4 d = y[j] - mean;
                const float var = rowsum16((d[0] * d[0] + d[1] * d[1]) + (d[2] * d[2] + d[3] * d[3])) * (1.f / 64.f);
                const float rs = rsqrtf(var + 64e-5f);
                const f32x2_t v01 = f16x2_to_f32(vu[j].x), v23 = f16x2_to_f32(vu[j].y), g01 = f16x2_to_f32(gg[j].x), g23 = f16x2_to_f32(gg[j].y);
                const f32x4 v4 = (f32x4){v01[0], v01[1], v23[0], v23[1]}, g4 = (f32x4){g01[0], g01[1], g23[0], g23[1]};
                const f32x4 o = ((d * rs) * *(const f32x4*)(gw + c) + *(const f32x4*)(gb + c) + v4 * bon[j]) * g4;
                uint2 ov; ov.x = cvt_pk_bf16(o[0], o[1]); ov.y = cvt_pk_bf16(o[2], o[3]);
                *(uint2*)(Y + (size_t)tok * 1024 + 512 + c) = ov;
            }
        }
    }
}

#define XB_TMO      128
#define XB_XCNT(j)  (256  + 64 * (j))
#define XB_XSUB(j)  (1280 + 64 * (j))
#define XB_XGEN(j)  (2304 + 64 * (j))
#define XB_TOP      3328
#define XB_TOPGEN   3392
#define XCD_BAR_WORDS 3456
#define XB_SPIN_CAP (1u << 18)

__device__ __forceinline__ unsigned xb_ld(unsigned* p)              { return __hip_atomic_load(p, __ATOMIC_RELAXED, __HIP_MEMORY_SCOPE_AGENT); }
__device__ __forceinline__ unsigned xb_add(unsigned* p, unsigned v) { return __hip_atomic_fetch_add(p, v, __ATOMIC_RELAXED, __HIP_MEMORY_SCOPE_AGENT); }
__device__ __forceinline__ unsigned xb_xcc_id() { return (unsigned)__builtin_amdgcn_s_getreg((3 << 11) | 20) & 0xFu; }
#define XB_SPIN(cond, bar) do { unsigned _sp = 0; while (cond) { __builtin_amdgcn_s_sleep(1); \
    if ((++_sp & 255u) == 0u) { if (xb_ld(&(bar)[XB_TMO])) break; if (_sp > XB_SPIN_CAP) { atomicAdd(&(bar)[XB_TMO], 1u); break; } } } } while (0)

struct XcdBarrier {
    unsigned* bar; unsigned x;
    volatile LAS unsigned* st;
};

__device__ __forceinline__ XcdBarrier xcd_barrier_post(unsigned* bar, volatile LAS unsigned* st) {
    XcdBarrier b; b.bar = bar; b.x = xb_xcc_id(); b.st = st;
    if (threadIdx.x == 0) (void)xb_add(&bar[XB_XCNT(b.x)], 1u);
    return b;
}
__device__ __forceinline__ void xcd_barrier_complete(unsigned* bar, unsigned x, unsigned& nloc, unsigned& nx) {
    const unsigned G = gridDim.x * gridDim.y * gridDim.z;
    unsigned sum, cnt, mine, sp = 0u;
    for (;;) {
        sum = 0u; cnt = 0u; mine = 0u;
#pragma unroll
        for (unsigned j = 0; j < 16; ++j) { const unsigned c = xb_ld(&bar[XB_XCNT(j)]); sum += c; cnt += (c > 0u) ? 1u : 0u; mine = (j == x) ? c : mine; }
        if (sum == G) break;
        __builtin_amdgcn_s_sleep(1);
        if ((++sp & 255u) == 0u) { if (xb_ld(&bar[XB_TMO])) break; if (sp > XB_SPIN_CAP) { atomicAdd(&bar[XB_TMO], 1u); break; } }
    }
    nloc = mine > 0u ? mine : 1u; nx = cnt > 0u ? cnt : 1u;
}

__device__ __forceinline__ void xcd_barrier(const XcdBarrier& b) {
    asm volatile("s_waitcnt vmcnt(0)" ::: "memory");
    __syncthreads();
    if (threadIdx.x == 0) {
        unsigned* bar = b.bar;
        __builtin_amdgcn_s_waitcnt(0);
        unsigned nloc = b.st[0], nx = b.st[1];
        if (nloc == 0u) { xcd_barrier_complete(bar, b.x, nloc, nx); b.st[0] = nloc; b.st[1] = nx; }
        const unsigned old = xb_add(&bar[XB_XSUB(b.x)], 1u);
        const unsigned gen = old / nloc;
        if (old + 1u == (gen + 1u) * nloc) {
            __builtin_amdgcn_fence(__ATOMIC_RELEASE, "agent");
            asm volatile("s_waitcnt vmcnt(0)" ::: "memory");
            const unsigned og = xb_add(&bar[XB_TOP], 1u);
            const unsigned tg = og / nx;
            if (og + 1u == (tg + 1u) * nx) xb_add(&bar[XB_TOPGEN], 1u);
            else XB_SPIN(xb_ld(&bar[XB_TOPGEN]) == tg, bar);
            __builtin_amdgcn_fence(__ATOMIC_ACQUIRE, "agent");
            xb_add(&bar[XB_XGEN(b.x)], 1u);
            asm volatile("s_waitcnt vmcnt(0)" ::: "memory");
        } else {
            XB_SPIN(xb_ld(&bar[XB_XGEN(b.x)]) == gen, bar);
            __builtin_amdgcn_fence(__ATOMIC_ACQUIRE, "agent");
            asm volatile("s_waitcnt vmcnt(0)" ::: "memory");
        }
    }
    __syncthreads();
}


__global__ __launch_bounds__(512, 2) void mega(Params P) {
    extern __shared__ __attribute__((aligned(16))) unsigned char shm[];
    LAS unsigned char* lds = (LAS unsigned char*)shm;
    const int nblk = gridDim.x;
    volatile LAS unsigned* bst = (volatile LAS unsigned*)(lds + 131072);
    if (threadIdx.x < 2) bst[threadIdx.x] = 0u;
    __syncthreads();
    const XcdBarrier xbar = xcd_barrier_post((unsigned*)(P.ws + WS_BAR), bst);
    float* MOD = (float*)(P.ws + OFF_MOD);
    bf16_t* HN = (bf16_t*)(P.ws + OFF_HN);
    bf16_t* ACT = (bf16_t*)(P.ws + OFF_R1);
#ifdef DIAG_TIME
    unsigned long long tA = 0, tB = 0, tprev = __builtin_amdgcn_s_memrealtime();
#endif
    for (int ph = P.ph_lo; ph < P.ph_hi; ++ph) {
#ifdef DBL_PHASE
      for (int rep = (ph > 0 && DBL_PHASE((ph - 1) % PPL)) ? 0 : 1; rep < 2; ++rep) {
#endif
        int tid = threadIdx.x, bid = blockIdx.x;
        asm volatile("" : "+v"(tid)); asm volatile("" : "+s"(bid));
        const int wid = __builtin_amdgcn_readfirstlane(tid >> 6), lane = tid & 63;
        if (ph == 0) {
#ifndef NO_MOD
            phase_mod(P, lds, tid, wid, lane, bid, nblk);
#endif
            phase_convert(P, 0, lds, wid, lane, bid, nblk);
#ifdef DIAG_POISON
            { u32x4* w = (u32x4*)(P.ws + OFF_LORA); const size_t n16 = (WS_END - OFF_LORA) / 16;
              for (size_t i = (size_t)bid * 512 + tid; i < n16; i += (size_t)nblk * 512) w[i] = (u32x4){0xAAAAAAAAu, 0xAAAAAAAAu, 0xAAAAAAAAu, 0xAAAAAAAAu}; }
#endif
        } else {
            const int l = (ph - 1) / PPL, s = (ph - 1) % PPL;
            bf16_t* HB = (bf16_t*)(P.ws + OFF_HB);
            const bool first_h = (l == 0 && s < 3), last_h = (l == DEPTH - 1 && s == PPL - 1);
            const void* hin = first_h ? (const void*)P.in[0] : (const void*)HB;
            void* hout = last_h ? (void*)P.out : (void*)HB;
            const float* modl = MOD + (size_t)l * 8 * 9216;
            bf16_t* WB = (bf16_t*)(P.ws + ((l & 1) ? OFF_WB2 : OFF_WB));
            pg8::Gemm g{HN, WB, NTOK, 1024, 1024}; pg8::EpiAny E{}; bool is_gemm = true;
            switch (s) {
            case 0:
#ifndef NO_NORM
                if (first_h) phase_norm<true>(P, hin, P.in[4] + l * 1024, modl, wid, lane, bid, nblk); else phase_norm16(P, hin, P.in[4] + l * 1024, modl, wid, lane, bid, nblk);
#endif
                is_gemm = false; break;
            case 1: g.Bt = WB + WB_FFN1IN; g.N = 2 * DFF; E.kind = 0; E.perm = true; E.sw.O = ACT; break;
            case 2: g.A = ACT; g.Bt = WB + WB_FFN1OUT; g.K = DFF; E.kind = 1; E.rs = pg8::EpiResid{hin, hout, modl + 2 * 1024, 0.5f, first_h ? 1 : 0, last_h ? 1 : 0}; break;
            case 3: phase_norm16(P, hin, P.in[7] + l * 1024, modl + 3 * 1024, wid, lane, bid, nblk); is_gemm = false; break;
            case 4: g.Bt = WB + WB_MIXIN; g.N = 2560; E.kind = 2; E.pj = pg8::EpiProj{(bf16_t*)(P.ws + OFF_R1), (bf16_t*)(P.ws + OFF_R1 + R1_RWKV), (bf16_t*)(P.ws + OFF_R1 + R1_CONV)}; break;
            case 5:
                for (int it = bid; it < 512; it += nblk) prep_tile<0>(P, l, it, lds, tid, wid, lane);
                is_gemm = false; break;
            case 6: {
                const int nscan = nblk >> 1;
                if (bid < nscan) phase_scan(P, lds, tid, wid, lane, bid, nscan);
                else {
                    const int vb = bid - nscan, vn = nblk - nscan;
                    for (int it = vb; it < 512; it += vn) attn_item(P, l, it, lds, tid, wid, lane, P.ph_lo < 0 ? 0 : ATTN_VAR(l));
                    conv_part(P, l, tid, vb, vn);
                    for (int it = vb; it < 512; it += vn) prep_tile<1>(P, l, it, lds, tid, wid, lane);
                    if (l + 1 < DEPTH) phase_convert(P, l + 1, lds, wid, lane, vb, vn);
                }
                is_gemm = false; } break;
            case 7: phase_post(P, l, tid, bid, nblk); is_gemm = false; break;
            case 8: g.Bt = WB + WB_MIXOUT; E.kind = 1; E.rs = pg8::EpiResid{hin, hout, modl + 5 * 1024, 1.0f, first_h ? 1 : 0, last_h ? 1 : 0}; break;
            case 9: phase_norm16(P, hin, P.in[25] + l * 1024, modl + 6 * 1024, wid, lane, bid, nblk); is_gemm = false; break;
            case 10: g.Bt = WB + WB_FFN2IN; g.N = 2 * DFF; E.kind = 0; E.perm = true; E.sw.O = ACT; break;
            default: g.A = ACT; g.Bt = WB + WB_FFN2OUT; g.K = DFF; E.kind = 1; E.rs = pg8::EpiResid{hin, hout, modl + 8 * 1024, 0.5f, first_h ? 1 : 0, last_h ? 1 : 0}; break;
            }
            if (is_gemm) { pg8::StaticOrder S; S.init(NTOK, g.N, nblk, bid); pg8::gemm_phase<pg8::EpiAny, pg8::StaticOrder, GEMM_ALIGN, GEMM_SP2>(lds, g, S, E, tid); }
        }
#ifdef DIAG_TIME
        const unsigned long long twork = __builtin_amdgcn_s_memrealtime();
        cg::this_grid().sync();
        { const unsigned long long tnow = __builtin_amdgcn_s_memrealtime(); const int sx = ph == 0 ? -1 : (ph - 1) % PPL;
          if (TSEL_A(sx)) tA += (TWAIT_A ? tnow - twork : tnow - tprev);
          if (TSEL_B(sx)) tB += (TWAIT_B ? tnow - twork : tnow - tprev);
          tprev = tnow; }
#else
#ifdef DBL_PHASE
        cg::this_grid().sync();
      }
#else
        if (ph + 1 < P.ph_hi) { if (P.ph_hi > 100000) cg::this_grid().sync(); else xcd_barrier(xbar); }
#ifdef EXTRA_SYNC
        if (ph + 1 < P.ph_hi) { cg::this_grid().sync(); }
#endif
#endif
#endif
    }
#ifdef DIAG_TIME
    {
        unsigned long long* tw = (unsigned long long*)(P.ws + WS_END);
        if (blockIdx.x == 0 && threadIdx.x == 0) { tw[0] = tA; tw[1] = tB; __threadfence(); }
        cg::this_grid().sync();
        const float fa = (float)__hip_atomic_load(tw, __ATOMIC_RELAXED, __HIP_MEMORY_SCOPE_AGENT) * 0.01f * 100.0f, fb = (float)__hip_atomic_load(tw + 1, __ATOMIC_RELAXED, __HIP_MEMORY_SCOPE_AGENT) * 0.01f;
        for (size_t i = (size_t)blockIdx.x * 512 + threadIdx.x; i < (size_t)NTOK * 1024; i += (size_t)gridDim.x * 512) P.out[i] = (i == 0) ? fa : fb;
    }
#endif
}


#ifdef DIAG_SELFTEST
__global__ void diag_checksum(const unsigned* p, size_t nwords, unsigned long long* slot) {
    unsigned long long acc = 0;
    for (size_t i = (size_t)blockIdx.x * blockDim.x + threadIdx.x; i < nwords; i += (size_t)gridDim.x * blockDim.x) acc += (unsigned long long)p[i] * (unsigned long long)(2 * i + 1);
    for (int o = 1; o < 64; o <<= 1) acc += __shfl_xor(acc, o);
    if ((threadIdx.x & 63) == 0) atomicAdd(slot, acc);
}
__global__ void diag_report(const unsigned long long* slots, int nitems, int nrep, float* out, size_t n) {
    int code = 0;
    for (int k = 0; k < nitems; ++k) for (int r = 1; r < nrep; ++r) if (slots[k * nrep + r] != slots[k * nrep]) { code |= 1 << k; break; }
    if (code == 0) return;
    const float c = 4.0f * exp2f((float)code);
    for (size_t i = (size_t)blockIdx.x * blockDim.x + threadIdx.x; i < n; i += (size_t)gridDim.x * blockDim.x) out[i] = c;
}
#endif
extern "C" void kernel_launch(void* const* d_in, const int* in_sizes, int n_in, void* d_out, int out_size, void* d_ws, size_t ws_size, hipStream_t stream) {
    static int grid = 0;
    if (grid == 0) {
        if (n_in != 28 || out_size != NTOK * DM || ws_size < WS_END) { fprintf(stderr, "kernel_launch: unexpected shapes (n_in %d out %d ws %zu need %zu)\n", n_in, out_size, ws_size, (size_t)WS_END); grid = -1; return; }
        int dev = 0, cus = 0, per_cu = 0;
        hipGetDevice(&dev); hipDeviceGetAttribute(&cus, hipDeviceAttributeMultiprocessorCount, dev);
        if (hipFuncSetAttribute((const void*)mega, hipFuncAttributeMaxDynamicSharedMemorySize, LDS_BYTES) != hipSuccess) { fprintf(stderr, "kernel_launch: hipFuncSetAttribute failed\n"); grid = -1; return; }
        if (hipOccupancyMaxActiveBlocksPerMultiprocessor(&per_cu, (const void*)mega, 512, LDS_BYTES) != hipSuccess || per_cu < 1) { fprintf(stderr, "kernel_launch: occupancy query failed (%d)\n", per_cu); per_cu = 1; (void)hipGetLastError(); }
        grid = cus * per_cu;
    }
    if (grid < 0) return;
    Params p{};
    for (int i = 0; i < 28; ++i) p.in[i] = (const float*)d_in[i];
    p.out = (float*)d_out; p.ws = (unsigned char*)d_ws;
#if MK_LAUNCHES == 1
    if (hipMemsetAsync((unsigned char*)d_ws + WS_BAR, 0, 16384, stream) != hipSuccess) { fprintf(stderr, "kernel_launch: memset of barrier words failed\n"); return; }
    p.ph_lo = 0; p.ph_hi = NPH;
    void* args[] = {&p};
    hipError_t e = hipLaunchCooperativeKernel((const void*)mega, dim3(grid), dim3(512), args, LDS_BYTES, stream);
    if (e != hipSuccess) fprintf(stderr, "cooperative launch failed: %s (grid %d)\n", hipGetErrorString(e), grid);
#else
#ifdef DIAG_SELFTEST
    {
        constexpr int NREP = 4;
        unsigned long long* slots = (unsigned long long*)((unsigned char*)d_ws + WS_END);
        hipMemsetAsync(slots, 0, 64 * NREP * 8, stream);
        int item = 0;
        for (int ph = 0; ph < NPH; ++ph) {
            p.ph_lo = ph; p.ph_hi = ph + 1; hipLaunchKernelGGL(mega, dim3(grid), dim3(512), LDS_BYTES, stream, p);
            if (ph == 0) continue;
            const int l = (ph - 1) / PPL, s = (ph - 1) % PPL;
            size_t off = 0, len = 0; bool test = (s == 5);
            switch (s) {
            case 0: off = OFF_LORA; len = OFF_R1 - OFF_LORA; break;
            case 1: case 12: off = OFF_R1; len = (size_t)NTOK * DFF * 2; break;
            case 2: test = false; break;
            case 3: case 5: case 7: case 9: case 11: off = OFF_HN; len = (size_t)NTOK * 1024 * 2; break;
            case 4: off = OFF_R1; len = R1_BYTES; break;
            case 6: off = OFF_R2; len = WS_END - OFF_R2; break;
            case 8: off = OFF_R1 + R1_RWKV; len = (size_t)NTOK * 256 * 4; break;
            default: test = false; break;
            }
            if (!test) continue;
            const unsigned* base = (s == 2) ? (const unsigned*)d_out : (const unsigned*)((unsigned char*)d_ws + off);
            const size_t nw = (s == 2) ? (size_t)NTOK * 1024 : len / 4;
            for (int r = 0; r < NREP; ++r) {
                if (r > 0) hipLaunchKernelGGL(mega, dim3(grid), dim3(512), LDS_BYTES, stream, p);
                hipLaunchKernelGGL(diag_checksum, dim3(2048), dim3(256), 0, stream, base, nw, slots + item * NREP + r);
            }
            ++item;
        }
        hipLaunchKernelGGL(diag_report, dim3(2048), dim3(256), 0, stream, (const unsigned long long*)slots, item, NREP, (float*)d_out, (size_t)NTOK * 1024);
    }
#else
    for (int ph = 0; ph < NPH; ++ph) { p.ph_lo = ph; p.ph_hi = ph + 1; hipLaunchKernelGGL(mega, dim3(grid), dim3(512), LDS_BYTES, stream, p); }
#endif
#endif
}
```

```cpp
#define ATTN_VAR(l) (P.ph_hi > 100000 ? (l) + 1 : 0)
#define GEMM_ALIGN true
#define GEMM_SP2 true
#include <hip/hip_runtime.h>
#include <hip/hip_cooperative_groups.h>
#include <cstdio>
#include <cstdint>
namespace cg = cooperative_groups;

#ifndef MK_LAUNCHES
#define MK_LAUNCHES 1
#endif

namespace pg8 {
#define PG8_LAS __attribute__((address_space(3)))
typedef unsigned short bf16_t;
typedef short bf16x8 __attribute__((ext_vector_type(8)));
typedef float f32x4 __attribute__((ext_vector_type(4)));
typedef unsigned u32x4 __attribute__((ext_vector_type(4)));
constexpr int BM = 256, BK = 64, HALF = 128, HTB = HALF * BK * 2  , STAGE_BYTES = 8 * HTB, NXCD = 8, WGM = 8;

__host__ __device__ __forceinline__ int lds_byte(int r, int c) { const int st = (r >> 4) * 2 + (c >> 5), rr = r & 15, cc = c & 31, ob = rr * 64 + cc * 2; return st * 1024 + (ob ^ (((ob >> 9) & 1) << 5)); }
__host__ __device__ __forceinline__ void stage_rc(int b, int& R, int& C) { const int st = b / 1024, sb = b % 1024, swz = sb ^ (((sb >> 9) & 1) << 5); R = (st >> 1) * 16 + swz / 64; C = (st & 1) * 32 + (swz % 64) / 2; }
__host__ __device__ __forceinline__ int perm32(int rho) { const int n = rho >> 4, i = rho & 15; return 8 * (i >> 2) + 4 * n + (i & 3); }

struct Unit { int pm, pn; };
struct Gemm { const bf16_t* A; const bf16_t* Bt; int M, N, K; };

struct StaticOrder {
    int nM, nN, nwg, G, c;
    __host__ __device__ void init(int M, int N, int G_, int c_) { nM = M / BM; nN = N / BM; nwg = nM * nN; G = G_; c = c_; }
    __host__ __device__ bool next(int i, Unit& u) const {
        const long L = (long)i * G + c; if (L >= nwg) return false;
        int wgid = (int)L; { const int q = nwg / NXCD, r = nwg % NXCD, xcd = wgid % NXCD, off = wgid / NXCD; wgid = (xcd < r ? xcd * (q + 1) : r * (q + 1) + (xcd - r) * q) + off; }
        const int nig = WGM * nN, gid = wgid / nig, fm = gid * WGM, gsz = (nM - fm) < WGM ? (nM - fm) : WGM;
        u.pm = fm + ((wgid % nig) % gsz); u.pn = (wgid % nig) / gsz; return true;
    }
    __device__ __forceinline__ void a_ready(const Unit&) const {}
    __device__ __forceinline__ void done(const Unit&) const {}
};
typedef __bf16 bf16v2_t __attribute__((ext_vector_type(2)));
typedef float f32x2_t __attribute__((ext_vector_type(2)));
__device__ __forceinline__ unsigned cvt_pk_bf16(float lo, float hi) { const f32x2_t v = {lo, hi}; const bf16v2_t b = __builtin_convertvector(v, bf16v2_t); return __builtin_bit_cast(unsigned, b); }

typedef _Float16 h16x2_t __attribute__((ext_vector_type(2)));
__device__ __forceinline__ unsigned cvt_pk_f16(float lo, float hi) { const f32x2_t v = {lo, hi}; const h16x2_t h = __builtin_convertvector(v, h16x2_t); return __builtin_bit_cast(unsigned, h); }
__device__ __forceinline__ f32x2_t f16x2_to_f32(unsigned u) { const h16x2_t h = __builtin_bit_cast(h16x2_t, u); return __builtin_convertvector(h, f32x2_t); }
template <class Epi, class Sched, bool ALIGN_EPI = false, bool SP2 = false>
__device__ __forceinline__ void gemm_phase(PG8_LAS unsigned char* lds, const Gemm g, const Sched& S, const Epi& E, const int tid) {
    const int wid = __builtin_amdgcn_readfirstlane(tid >> 6), lane = tid & 63, wr = wid >> 2, wc = wid & 3, fr = lane & 15, fq = lane >> 4;
    const int K = g.K, nt = K / BK;
    unsigned voffA[2], voffB[2];
#pragma unroll
    for (int i = 0; i < 2; ++i) { int R, C; stage_rc(tid * 16 + i * 8192, R, C); const int Rb = E.perm ? ((R & ~31) + perm32(R & 31)) : R;
        voffA[i] = (unsigned)(R * K + C) * 2u; voffB[i] = (unsigned)(Rb * K + C) * 2u; }
    const size_t kstep = (size_t)(BK * 2);
    const size_t hstep = (size_t)HALF * K * 2;
    const size_t tstep = 2 * hstep;
    const unsigned ldsw = (unsigned)wid * 1024u;
    const int aoff = lds_byte(wr * 64 + fr, fq * 8), boff = lds_byte(wc * 32 + fr, fq * 8);
#define PG8_SA(b, h) (((b) * 2 + (h)) * HTB)
#define PG8_SB(b, h) ((4 + (b) * 2 + (h)) * HTB)
#define PG8_STAGE(bufoff, gbase, voff) do { _Pragma("unroll") for (int _i = 0; _i < 2; ++_i) \
        __builtin_amdgcn_global_load_lds((const unsigned*)((const char*)(gbase) + (voff)[_i]), (PG8_LAS unsigned*)(lds + (bufoff) + ldsw + _i * 8192), 16, 0, 0); } while (0)
#define PG8_LDA(dst, b, h) do { _Pragma("unroll") for (int m = 0; m < 4; ++m) _Pragma("unroll") for (int k = 0; k < 2; ++k) dst[m][k] = *(const PG8_LAS bf16x8*)(lds + PG8_SA(b, h) + aoff + m * 2048 + k * 1024); } while (0)
#define PG8_LDB(dst, b, h) do { _Pragma("unroll") for (int n = 0; n < 2; ++n) _Pragma("unroll") for (int k = 0; k < 2; ++k) dst[n][k] = *(const PG8_LAS bf16x8*)(lds + PG8_SB(b, h) + boff + n * 2048 + k * 1024); } while (0)
#define PG8_MMA(ai, bj, At, Bt) do { __builtin_amdgcn_s_setprio(1); _Pragma("unroll") for (int m = 0; m < 4; ++m) _Pragma("unroll") for (int n = 0; n < 2; ++n) _Pragma("unroll") for (int k = 0; k < 2; ++k) \
        acc[ai][bj][m][n] = __builtin_amdgcn_mfma_f32_16x16x32_bf16(Bt[n][k], At[m][k], acc[ai][bj][m][n], 0, 0, 0); __builtin_amdgcn_s_setprio(0); } while (0)
#define PG8_WAIT_V(n) asm volatile("s_waitcnt vmcnt(" #n ")" ::: "memory")
#define PG8_WAIT_L(n) asm volatile("s_waitcnt lgkmcnt(" #n ")" ::: "memory")
#define PG8_BAR __builtin_amdgcn_s_barrier()
#define PG8_SCHED __builtin_amdgcn_sched_barrier(0)
    Unit cur, nxt; int ui = 0;
    if (!S.next(0, cur)) return;
    f32x4 acc[2][2][4][2];
#pragma unroll
    for (int a = 0; a < 2; ++a)
#pragma unroll
        for (int b = 0; b < 2; ++b)
#pragma unroll
            for (int m = 0; m < 4; ++m)
#pragma unroll
                for (int n = 0; n < 2; ++n) acc[a][b][m][n] = (f32x4){0.f, 0.f, 0.f, 0.f};
    bf16x8 At[4][2], B0[2][2], B1[2][2];
    const char* cA = (const char*)g.A + (size_t)cur.pm * tstep; const char* cB = (const char*)g.Bt + (size_t)cur.pn * tstep;
    S.a_ready(cur);
    if constexpr (SP2) {
        PG8_STAGE(PG8_SB(0, 0), cB, voffB); PG8_STAGE(PG8_SB(0, 1), cB + hstep, voffB); PG8_STAGE(PG8_SA(0, 0), cA, voffA); PG8_STAGE(PG8_SA(0, 1), cA + hstep, voffA);
        if (wr == 1) PG8_BAR;
        PG8_WAIT_V(2); PG8_BAR;
        PG8_STAGE(PG8_SB(1, 0), cB + kstep, voffB); PG8_STAGE(PG8_SA(1, 0), cA + kstep, voffA); PG8_STAGE(PG8_SB(1, 1), cB + hstep + kstep, voffB);
        PG8_WAIT_V(6); PG8_BAR;
    } else {
        PG8_STAGE(PG8_SB(0, 0), cB, voffB); PG8_STAGE(PG8_SA(0, 0), cA, voffA); PG8_STAGE(PG8_SB(0, 1), cB + hstep, voffB); PG8_STAGE(PG8_SA(0, 1), cA + hstep, voffA);
        if (wr == 1) PG8_BAR;
        PG8_WAIT_V(4); PG8_BAR;
        PG8_STAGE(PG8_SB(1, 0), cB + kstep, voffB); PG8_STAGE(PG8_SA(1, 0), cA + kstep, voffA); PG8_STAGE(PG8_SB(1, 1), cB + hstep + kstep, voffB);
        PG8_WAIT_V(6); PG8_BAR;
    }
    for (;;) {
        const bool has_next = S.next(ui + 1, nxt);
        const char* nA = has_next ? (const char*)g.A + (size_t)nxt.pm * tstep : cA; const char* nB = has_next ? (const char*)g.Bt + (size_t)nxt.pn * tstep : cB;
        for (int t = 0; t < nt; t += 2) {
            const bool last = (t == nt - 2);
            const char* a1 = cA + (size_t)(t + 1) * kstep;
            const char* a2 = last ? nA : cA + (size_t)(t + 2) * kstep; const char* b2 = last ? nB : cB + (size_t)(t + 2) * kstep;
            const char* a3 = a2 + kstep; const char* b3 = b2 + kstep;
            if (last && has_next) S.a_ready(nxt);
            if constexpr (SP2) {
            PG8_LDB(B0, 0, 0); PG8_LDB(B1, 0, 1); PG8_SCHED; PG8_LDA(At, 0, 0); PG8_STAGE(PG8_SA(1, 1), a1 + hstep, voffA);
            PG8_WAIT_V(8); PG8_WAIT_L(0); PG8_BAR; PG8_MMA(0, 0, At, B0); PG8_MMA(0, 1, At, B1); PG8_BAR; PG8_SCHED;
            PG8_LDA(At, 0, 1); PG8_STAGE(PG8_SB(0, 0), b2, voffB); PG8_STAGE(PG8_SB(0, 1), b2 + hstep, voffB); PG8_STAGE(PG8_SA(0, 0), a2, voffA);
            PG8_WAIT_V(8); PG8_WAIT_L(0); PG8_BAR; PG8_MMA(1, 0, At, B0); PG8_MMA(1, 1, At, B1); PG8_BAR; PG8_SCHED;
            PG8_LDB(B0, 1, 0); PG8_LDB(B1, 1, 1); PG8_SCHED; PG8_LDA(At, 1, 0); PG8_STAGE(PG8_SA(0, 1), a2 + hstep, voffA);
            PG8_WAIT_V(8); PG8_WAIT_L(0); PG8_BAR; PG8_MMA(0, 0, At, B0); PG8_MMA(0, 1, At, B1); PG8_BAR; PG8_SCHED;
            PG8_LDA(At, 1, 1); PG8_STAGE(PG8_SB(1, 0), b3, voffB); PG8_STAGE(PG8_SB(1, 1), b3 + hstep, voffB); PG8_STAGE(PG8_SA(1, 0), a3, voffA);
            PG8_WAIT_V(8); PG8_WAIT_L(0); PG8_BAR; PG8_MMA(1, 0, At, B0); PG8_MMA(1, 1, At, B1); PG8_BAR; PG8_SCHED;
            } else {
            PG8_LDB(B0, 0, 0); PG8_SCHED; PG8_LDA(At, 0, 0); PG8_STAGE(PG8_SA(1, 1), a1 + hstep, voffA);
            PG8_WAIT_L(8); PG8_BAR; PG8_WAIT_L(0); PG8_MMA(0, 0, At, B0); PG8_BAR; PG8_SCHED;
            PG8_LDB(B1, 0, 1); PG8_STAGE(PG8_SB(0, 0), b2, voffB);
            PG8_BAR; PG8_WAIT_L(0); PG8_MMA(0, 1, At, B1); PG8_BAR;
            PG8_LDA(At, 0, 1); PG8_STAGE(PG8_SA(0, 0), a2, voffA);
            PG8_BAR; PG8_WAIT_L(0); PG8_MMA(1, 0, At, B0); PG8_BAR; PG8_SCHED;
            PG8_STAGE(PG8_SB(0, 1), b2 + hstep, voffB);
            PG8_WAIT_V(6); PG8_BAR; PG8_MMA(1, 1, At, B1); PG8_BAR;
            PG8_LDB(B0, 1, 0); PG8_SCHED; PG8_LDA(At, 1, 0); PG8_STAGE(PG8_SA(0, 1), a2 + hstep, voffA);
            PG8_WAIT_L(8); PG8_BAR; PG8_WAIT_L(0); PG8_MMA(0, 0, At, B0); PG8_BAR; PG8_SCHED;
            PG8_LDB(B1, 1, 1); PG8_STAGE(PG8_SB(1, 0), b3, voffB);
            PG8_BAR; PG8_WAIT_L(0); PG8_MMA(0, 1, At, B1); PG8_BAR;
            PG8_LDA(At, 1, 1); PG8_STAGE(PG8_SA(1, 0), a3, voffA);
            PG8_BAR; PG8_WAIT_L(0); PG8_MMA(1, 0, At, B0); PG8_BAR; PG8_SCHED;
            PG8_STAGE(PG8_SB(1, 1), b3 + hstep, voffB);
            PG8_WAIT_V(6); PG8_BAR; PG8_MMA(1, 1, At, B1); PG8_BAR;
            }
        }
        if constexpr (ALIGN_EPI) { if (wr == 0) PG8_BAR; }
        if constexpr (!Epi::AFTER_DRAIN) { E(acc, cur, wr, wc, fr, fq); S.done(cur); }
        if (!has_next) break;
#pragma unroll
        for (int a = 0; a < 2; ++a)
#pragma unroll
            for (int b = 0; b < 2; ++b)
#pragma unroll
                for (int m = 0; m < 4; ++m)
#pragma unroll
                    for (int n = 0; n < 2; ++n) acc[a][b][m][n] = (f32x4){0.f, 0.f, 0.f, 0.f};
        cur = nxt; cA = nA; cB = nB; ++ui;
        if constexpr (ALIGN_EPI) { if (wr == 1) PG8_BAR; }
    }
    PG8_WAIT_V(0);
    if constexpr (!ALIGN_EPI) { if (wr == 0) PG8_BAR; }
    PG8_BAR;
    if constexpr (Epi::AFTER_DRAIN) { E.fused(acc, cur, wr, wc, fr, fq, lds, wid, lane); S.done(cur); }
#undef PG8_SA
#undef PG8_SB
#undef PG8_STAGE
#undef PG8_LDA
#undef PG8_LDB
#undef PG8_MMA
#undef PG8_WAIT_V
#undef PG8_WAIT_L
#undef PG8_BAR
#undef PG8_SCHED
}

__device__ __forceinline__ float silu_f(float x) { return x * __builtin_amdgcn_rcpf(1.f + __builtin_amdgcn_exp2f(-1.44269504089f * x)); }

struct EpiSwiglu {
    static constexpr bool PERM = true, AFTER_DRAIN = false;
    bf16_t* O;
    __device__ __forceinline__ void operator()(const f32x4 (&acc)[2][2][4][2], const Unit& u, int wr, int wc, int fr, int fq) const {
        const int row0 = u.pm * BM + wr * 64 + fr, col0 = u.pn * 128 + wc * 32 + 8 * fq;
#pragma unroll
        for (int ai = 0; ai < 2; ++ai)
#pragma unroll
            for (int m = 0; m < 4; ++m) {
                bf16_t* rowp = O + (size_t)(row0 + ai * HALF + m * 16) * 2816 + col0;
                const f32x4 g0 = acc[ai][0][m][0], g1 = acc[ai][0][m][1], u0 = acc[ai][1][m][0], u1 = acc[ai][1][m][1];
                u32x4 o;
                o.x = cvt_pk_bf16(silu_f(g0[0]) * u0[0], silu_f(g0[1]) * u0[1]); o.y = cvt_pk_bf16(silu_f(g0[2]) * u0[2], silu_f(g0[3]) * u0[3]);
                o.z = cvt_pk_bf16(silu_f(g1[0]) * u1[0], silu_f(g1[1]) * u1[1]); o.w = cvt_pk_bf16(silu_f(g1[2]) * u1[2], silu_f(g1[3]) * u1[3]);
                *(u32x4*)rowp = o;
            }
    }
};
struct EpiResid {
    static constexpr bool PERM = false, AFTER_DRAIN = false;
    const void* hin; void* hout; const float* gt; float scale; int in_f32, out_f32;
    template <bool INF, bool OUTF> __device__ __forceinline__ void run(const f32x4 (&acc)[2][2][4][2], const f32x4 (&gv)[2][2], int row0, int col0) const {
#pragma unroll
        for (int ai = 0; ai < 2; ++ai)
#pragma unroll
            for (int m = 0; m < 4; ++m) {
                const size_t off = (size_t)(row0 + ai * HALF + m * 16) * 1024 + col0;
#pragma unroll
                for (int bj = 0; bj < 2; ++bj)
#pragma unroll
                    for (int n = 0; n < 2; ++n) {
                        const size_t o = off + bj * HALF + n * 16;
                        f32x4 hv;
                        if (INF) hv = *(const f32x4*)((const float*)hin + o);
                        else { const uint2 u = *(const uint2*)((const bf16_t*)hin + o); const f32x2_t a = f16x2_to_f32(u.x), c = f16x2_to_f32(u.y); hv = (f32x4){a[0], a[1], c[0], c[1]}; }
                        const f32x4 r = hv + gv[bj][n] * acc[ai][bj][m][n];
                        if (OUTF) *(f32x4*)((float*)hout + o) = r;
                        else { uint2 w; w.x = cvt_pk_f16(r[0], r[1]); w.y = cvt_pk_f16(r[2], r[3]); *(uint2*)((bf16_t*)hout + o) = w; }
                    }
            }
    }
    __device__ __forceinline__ void operator()(const f32x4 (&acc)[2][2][4][2], const Unit& u, int wr, int wc, int fr, int fq) const {
        const int row0 = u.pm * BM + wr * 64 + fr, col0 = u.pn * BM + wc * 32 + 4 * fq;
        const float* gp = gt + (size_t)(u.pm >> 4) * 9216 + col0;
        f32x4 gv[2][2];
#pragma unroll
        for (int bj = 0; bj < 2; ++bj)
#pragma unroll
            for (int n = 0; n < 2; ++n) { const f32x4 t = *(const f32x4*)(gp + bj * HALF + n * 16); gv[bj][n] = (t + 1.0f) * scale; }
        if (in_f32) run<true, false>(acc, gv, row0, col0); else if (out_f32) run<false, true>(acc, gv, row0, col0); else run<false, false>(acc, gv, row0, col0);
    }
};
struct EpiProj {
    static constexpr bool PERM = false, AFTER_DRAIN = false;
    bf16_t* att; bf16_t* rw; bf16_t* cv;
    template <int LD, bool F16> __device__ __forceinline__ void put(const f32x4 (&acc)[2][2][4][2], bf16_t* base, int row0, int col0) const {
#pragma unroll
        for (int ai = 0; ai < 2; ++ai)
#pragma unroll
            for (int m = 0; m < 4; ++m) { bf16_t* rowp = base + (size_t)(row0 + ai * HALF + m * 16) * LD + col0;
#pragma unroll
                for (int bj = 0; bj < 2; ++bj)
#pragma unroll
                    for (int n = 0; n < 2; ++n) { const f32x4 v = acc[ai][bj][m][n]; uint2 o; o.x = F16 ? cvt_pk_f16(v[0], v[1]) : cvt_pk_bf16(v[0], v[1]); o.y = F16 ? cvt_pk_f16(v[2], v[3]) : cvt_pk_bf16(v[2], v[3]); *(uint2*)(rowp + bj * HALF + n * 16) = o; } }
    }
    __device__ __forceinline__ void operator()(const f32x4 (&acc)[2][2][4][2], const Unit& u, int wr, int wc, int fr, int fq) const {
        const int row0 = u.pm * BM + wr * 64 + fr, cl = wc * 32 + 4 * fq;
        if (u.pn >= 3 && u.pn < 7) put<1024, true>(acc, rw, row0, (u.pn - 3) * BM + cl);
        else put<768, false>(acc, u.pn < 3 ? att : cv, row0, (u.pn < 3 ? u.pn : u.pn - 7) * BM + cl);
    }
};
struct EpiAny {
    int kind; bool perm;
    EpiSwiglu sw; EpiResid rs; EpiProj pj;
    static constexpr bool AFTER_DRAIN = false;
    __device__ __forceinline__ void operator()(const f32x4 (&acc)[2][2][4][2], const Unit& u, int wr, int wc, int fr, int fq) const {
        if (kind == 0) sw(acc, u, wr, wc, fr, fq); else if (kind == 1) rs(acc, u, wr, wc, fr, fq); else pj(acc, u, wr, wc, fr, fq);
    }
};
}

#define LAS __attribute__((address_space(3)))
using pg8::bf16_t; using pg8::bf16x8; using pg8::f32x4; using pg8::u32x4; using pg8::cvt_pk_bf16; using pg8::cvt_pk_f16; using pg8::f16x2_to_f32; using pg8::f32x2_t;
constexpr int NTOK = 32768, SEQL = 4096, DM = 1024, DFF = 2816, DEPTH = 4;
constexpr int LDS_BYTES = 131072 + 64;
constexpr int PPL = 12;
constexpr int NPH = 1 + DEPTH * PPL;

constexpr size_t OFF_MOD = 0;
constexpr size_t OFF_LORA = OFF_MOD + 1179648;
constexpr size_t OFF_BONUS = OFF_LORA + 131072;
constexpr size_t OFF_WB = OFF_BONUS + 524288;
constexpr size_t WB_FFN1IN = 0, WB_FFN1OUT = 5767168, WB_MIXIN = WB_FFN1OUT + 2883584, WB_MIXOUT = WB_MIXIN + 2621440,
                 WB_FFN2IN = WB_MIXOUT + 1048576, WB_FFN2OUT = WB_FFN2IN + 5767168, WB_ELEMS = WB_FFN2OUT + 2883584;
constexpr size_t OFF_HN = OFF_WB + WB_ELEMS * 2;
constexpr size_t OFF_R1 = OFF_HN + (size_t)NTOK * 1024 * 2;
constexpr size_t R1_CONV = (size_t)NTOK * 768 * 2, R1_RWKV = 2 * R1_CONV, R1_BYTES = (size_t)NTOK * 2816 * 2;
constexpr size_t OFF_R2 = OFF_R1 + R1_BYTES;
constexpr int REC_B = 896;
constexpr size_t R2_G = (size_t)NTOK * 4 * REC_B;
constexpr size_t WS_BAR = OFF_R2 + R2_G + (size_t)NTOK * 256 * 2;
constexpr size_t OFF_WB2 = WS_BAR + 16384;
constexpr size_t OFF_LORA2 = OFF_WB2 + WB_ELEMS * 2;
constexpr size_t OFF_YS = OFF_LORA2 + 131072;
constexpr size_t OFF_HB = OFF_YS + (size_t)NTOK * 256 * 4;
constexpr size_t WS_END = OFF_HB + (size_t)NTOK * 1024 * 2;

struct Params { const float* in[28]; float* out; unsigned char* ws; int ph_lo, ph_hi; };

__device__ __forceinline__ float wave_sum(float v) {
#pragma unroll
    for (int o = 1; o < 64; o <<= 1) v += __shfl_xor(v, o);
    return v;
}
template <int CTRL> __device__ __forceinline__ float dpp_f(float x) { return __int_as_float(__builtin_amdgcn_update_dpp(0, __float_as_int(x), CTRL, 0xf, 0xf, true)); }
__device__ __forceinline__ float rowsum16(float x) {
    x += dpp_f<0x128>(x); x += dpp_f<0x124>(x); x += dpp_f<0x122>(x); x += dpp_f<0x121>(x); return x;
}
__device__ __forceinline__ float bflo(unsigned u) { return __uint_as_float(u << 16); }
__device__ __forceinline__ float bfhi(unsigned u) { return __uint_as_float(u & 0xffff0000u); }
__device__ __forceinline__ float sigmoid_f(float x) { return __builtin_amdgcn_rcpf(1.f + __builtin_amdgcn_exp2f(-1.44269504089f * x)); }

__device__ __forceinline__ void phase_mod(const Params& P, LAS unsigned char* lds, int tid, int wid, int lane, int bid, int nblk) {
    LAS float* cact = (LAS float*)lds;
    LAS float* red = (LAS float*)(lds + 32768);
    const float* c = P.in[1];
    float* MOD = (float*)(P.ws + OFF_MOD);
    for (int i = tid; i < 8192; i += 512) { const float v = c[i]; cact[i] = v / (1.f + __expf(-v)); }
    __syncthreads();
    for (int item = bid; item < 288; item += nblk) {
        const int l = item / 72, j0 = (item % 72) * 128, k0 = wid * 128;
        const float* W = P.in[2] + (size_t)l * 1024 * 9216 + j0 + 2 * lane;
        float a0[8], a1[8];
#pragma unroll
        for (int b = 0; b < 8; ++b) { a0[b] = 0.f; a1[b] = 0.f; }
#pragma unroll 8
        for (int k = 0; k < 128; ++k) {
            const float2 w = *(const float2*)(W + (size_t)(k0 + k) * 9216);
#pragma unroll
            for (int b = 0; b < 8; ++b) { const float ca = cact[b * 1024 + k0 + k]; a0[b] += ca * w.x; a1[b] += ca * w.y; }
        }
#pragma unroll
        for (int b = 0; b < 8; ++b) { red[(wid * 8 + b) * 128 + 2 * lane] = a0[b]; red[(wid * 8 + b) * 128 + 2 * lane + 1] = a1[b]; }
        __syncthreads();
        for (int o = tid; o < 1024; o += 512) {
            const int b = o >> 7, ci = o & 127; float s = 0.f;
#pragma unroll
            for (int w = 0; w < 8; ++w) s += red[(w * 8 + b) * 128 + ci];
            MOD[(size_t)(l * 8 + b) * 9216 + j0 + ci] = s + P.in[3][l * 9216 + j0 + ci];
        }
        __syncthreads();
    }
}

__device__ __forceinline__ void transpose_item(const float* W, int K, int N, bf16_t* WT, int k0, int n0, int drow0, LAS float* scr, int lane) {
#pragma unroll 8
    for (int i = 0; i < 32; ++i) { const int kk = 2 * i + (lane >> 5); scr[kk * 33 + (lane & 31)] = W[(size_t)(k0 + kk) * N + n0 + (lane & 31)]; }
    asm volatile("s_waitcnt lgkmcnt(0)" ::: "memory");
    const int c = lane & 7;
#pragma unroll
    for (int j = 0; j < 4; ++j) { const int n = (lane >> 3) + 8 * j; const LAS float* s = scr + (8 * c) * 33 + n;
        u32x4 o; o.x = cvt_pk_bf16(s[0 * 33], s[1 * 33]); o.y = cvt_pk_bf16(s[2 * 33], s[3 * 33]); o.z = cvt_pk_bf16(s[4 * 33], s[5 * 33]); o.w = cvt_pk_bf16(s[6 * 33], s[7 * 33]);
        *(u32x4*)(WT + (size_t)(drow0 + n) * K + k0 + 8 * c) = o; }
    asm volatile("s_waitcnt lgkmcnt(0)" ::: "memory");
}
__device__ __forceinline__ int swiglu_row(int n0) { return n0 < DFF ? ((n0 >> 7) * 256 + (n0 & 127)) : (((n0 - DFF) >> 7) * 256 + 128 + ((n0 - DFF) & 127)); }
__device__ __forceinline__ void phase_convert(const Params& P, int l, LAS unsigned char* lds, int wid, int lane, int bid, int nblk) {
    LAS float* scr = (LAS float*)(lds + wid * 8448);
    bf16_t* WB = (bf16_t*)(P.ws + ((l & 1) ? OFF_WB2 : OFF_WB));
    bf16_t* LT = (bf16_t*)(P.ws + ((l & 1) ? OFF_LORA2 : OFF_LORA));
    const int gw = bid * 8 + wid, NGW = nblk * 8;
    constexpr int I_IN = 16 * 176, I_OUT = 44 * 32, I_MI = 16 * 80, I_MO = 16 * 32;
    constexpr int NIT = 2 * I_IN + 2 * I_OUT + I_MI + I_MO + 32;
    for (int it = gw; it < NIT; it += NGW) {
        int r = it;
        if (r < I_IN) { const int kb = r / 176, nb = r % 176; transpose_item(P.in[5] + (size_t)l * 1024 * 5632, 1024, 5632, WB + WB_FFN1IN, kb * 64, nb * 32, swiglu_row(nb * 32), scr, lane); continue; } r -= I_IN;
        if (r < I_OUT) { const int kb = r / 32, nb = r % 32; transpose_item(P.in[6] + (size_t)l * 2816 * 1024, 2816, 1024, WB + WB_FFN1OUT, kb * 64, nb * 32, nb * 32, scr, lane); continue; } r -= I_OUT;
        if (r < I_MI) { const int kb = r / 80, nb = r % 80; transpose_item(P.in[8] + (size_t)l * 1024 * 2560, 1024, 2560, WB + WB_MIXIN, kb * 64, nb * 32, nb * 32, scr, lane); continue; } r -= I_MI;
        if (r < I_MO) { const int kb = r / 32, nb = r % 32; transpose_item(P.in[9] + (size_t)l * 1024 * 1024, 1024, 1024, WB + WB_MIXOUT, kb * 64, nb * 32, nb * 32, scr, lane); continue; } r -= I_MO;
        if (r < I_IN) { const int kb = r / 176, nb = r % 176; transpose_item(P.in[26] + (size_t)l * 1024 * 5632, 1024, 5632, WB + WB_FFN2IN, kb * 64, nb * 32, swiglu_row(nb * 32), scr, lane); continue; } r -= I_IN;
        if (r < I_OUT) { const int kb = r / 32, nb = r % 32; transpose_item(P.in[27] + (size_t)l * 2816 * 1024, 2816, 1024, WB + WB_FFN2OUT, kb * 64, nb * 32, nb * 32, scr, lane); continue; } r -= I_OUT;
        if (r < 8) { transpose_item(P.in[15] + (size_t)l * 64 * 256, 64, 256, LT, 0, r * 32, r * 32, scr, lane); continue; } r -= 8;
        if (r < 8) { transpose_item(P.in[17] + (size_t)l * 64 * 256, 64, 256, LT + 16384, 0, r * 32, r * 32, scr, lane); continue; } r -= 8;
        { const int kb = r / 8, nb = r % 8; transpose_item(P.in[18] + (size_t)l * 128 * 256, 128, 256, LT + 32768, kb * 64, nb * 32, nb * 32, scr, lane); }
    }
}

template <bool INF>
__device__ __forceinline__ void phase_norm(const Params& P, const void* hin, const float* gain, const float* modl  , int wid, int lane, int bid, int nblk) {
    bf16_t* HN = (bf16_t*)(P.ws + OFF_HN);
    for (int row0 = (bid * 8 + wid) * 4; row0 < NTOK; row0 += nblk * 32) {
        f32x4 v[4][4]; float ss[4];
#pragma unroll
        for (int r = 0; r < 4; ++r) {
            if (INF) { const f32x4* xr = (const f32x4*)((const float*)hin + (size_t)(row0 + r) * 1024) + lane;
#pragma unroll
                for (int j = 0; j < 4; ++j) v[r][j] = xr[64 * j]; }
            else { const uint2* xr = (const uint2*)((const bf16_t*)hin + (size_t)(row0 + r) * 1024) + lane;
#pragma unroll
                for (int j = 0; j < 4; ++j) { const uint2 u = xr[64 * j]; const pg8::f32x2_t a = pg8::f16x2_to_f32(u.x), c = pg8::f16x2_to_f32(u.y); v[r][j] = (f32x4){a[0], a[1], c[0], c[1]}; } }
        }
#pragma unroll
        for (int r = 0; r < 4; ++r) { float a = 0.f;
#pragma unroll
            for (int j = 0; j < 4; ++j) a += (v[r][j][0] * v[r][j][0] + v[r][j][1] * v[r][j][1]) + (v[r][j][2] * v[r][j][2] + v[r][j][3] * v[r][j][3]);
            ss[r] = a; }
#pragma unroll
        for (int o = 1; o < 64; o <<= 1) {
#pragma unroll
            for (int r = 0; r < 4; ++r) ss[r] += __shfl_xor(ss[r], o);
        }
        const float* sh = modl + (size_t)(row0 >> 12) * 9216; const float* sc = sh + 1024;
#pragma unroll
        for (int j = 0; j < 4; ++j) {
            const int col = lane * 4 + 256 * j;
            const f32x4 g = *(const f32x4*)(gain + col), s1 = *(const f32x4*)(sc + col), s0 = *(const f32x4*)(sh + col);
            const f32x4 gs = g * (s1 + 1.0f);
#pragma unroll
            for (int r = 0; r < 4; ++r) {
                const float rstd = rsqrtf(ss[r] * (1.f / 1024.f) + 1e-6f);
                const f32x4 y = v[r][j] * rstd * gs + s0;
                uint2 o; o.x = cvt_pk_bf16(y[0], y[1]); o.y = cvt_pk_bf16(y[2], y[3]);
                ((uint2*)(HN + (size_t)(row0 + r) * 1024) + lane)[64 * j] = o;
            }
        }
    }
}

__device__ __forceinline__ bf16x8 pack8(const float* f) {
    u32x4 o; o.x = cvt_pk_bf16(f[0], f[1]); o.y = cvt_pk_bf16(f[2], f[3]); o.z = cvt_pk_bf16(f[4], f[5]); o.w = cvt_pk_bf16(f[6], f[7]);
    return __builtin_bit_cast(bf16x8, o);
}
__device__ __forceinline__ void attn_item(const Params& P, int l, int item, LAS unsigned char* lds, int tid, int wid, int lane, int var) {
    const bf16_t* PA = (const bf16_t*)(P.ws + OFF_R1);
    bf16_t* Y = (bf16_t*)(P.ws + OFF_HN);
    const int b = item >> 6, n = (item >> 1) & 31, hk = item & 1;
    LAS bf16_t* Ks = (LAS bf16_t*)lds;
    LAS bf16_t* Vt = (LAS bf16_t*)(lds + 36864);
    const float* kg = P.in[11] + l * 64; const float* qg = P.in[10] + l * 64;
    {
        const int row = tid >> 1, half = tid & 1, kt = n * 128 - 128 + row;
        u32x4 kv[4], vv[4];
        if (kt >= 0) {
            const bf16_t* src = PA + (size_t)(b * SEQL + kt) * 768 + 512 + hk * 64 + half * 32;
#pragma unroll
            for (int i = 0; i < 4; ++i) { kv[i] = ((const u32x4*)src)[i]; vv[i] = ((const u32x4*)(src + 128))[i]; }
        } else {
#pragma unroll
            for (int i = 0; i < 4; ++i) { kv[i] = (u32x4){0u, 0u, 0u, 0u}; vv[i] = (u32x4){0u, 0u, 0u, 0u}; }
        }
        float kf[32]; float ss = 0.f;
#pragma unroll
        for (int i = 0; i < 4; ++i)
#pragma unroll
            for (int j = 0; j < 4; ++j) { const float a = bflo(kv[i][j]), c = bfhi(kv[i][j]); kf[i * 8 + 2 * j] = a; kf[i * 8 + 2 * j + 1] = c; ss += a * a + c * c; }
        ss += __shfl_xor(ss, 1);
        const float rstd = rsqrtf(ss * (1.f / 64.f) + 1e-6f);
#pragma unroll
        for (int i = 0; i < 32; ++i) kf[i] *= rstd * kg[half * 32 + i];
#pragma unroll
        for (int i = 0; i < 4; ++i) *(LAS bf16x8*)(Ks + row * 72 + half * 32 + i * 8) = pack8(kf + i * 8);
        const int r32 = row & 31, kp = (row & ~31) + ((r32 & 15) >> 2) * 8 + (r32 >> 4) * 4 + (r32 & 3);
#pragma unroll
        for (int i = 0; i < 4; ++i)
#pragma unroll
            for (int j = 0; j < 4; ++j) { const unsigned w = vv[i][j]; Vt[(half * 32 + i * 8 + 2 * j) * 264 + kp] = (bf16_t)(w & 0xffffu); Vt[(half * 32 + i * 8 + 2 * j + 1) * 264 + kp] = (bf16_t)(w >> 16); }
    }
    __syncthreads();
    const int fr = lane & 15, fq = lane >> 4, hq = hk * 4 + (wid >> 1);
    const float sink = P.in[12][l * 8 + hq];
    for (int i = 0; i < 4; ++i) {
        if (var == 1) { asm volatile("s_waitcnt vmcnt(0) lgkmcnt(0)" ::: "memory"); __syncthreads(); }
        const int q0 = ((wid & 1) * 4 + i) * 16, kb0 = q0 >> 5;
        const bf16_t* qp = PA + (size_t)(b * SEQL + n * 128 + q0 + fr) * 768 + hq * 64 + fq * 8;
        const u32x4 qa = *(const u32x4*)qp, qb = *(const u32x4*)(qp + 32);
        float qf[16]; float ss = 0.f;
#pragma unroll
        for (int j = 0; j < 4; ++j) { qf[2 * j] = bflo(qa[j]); qf[2 * j + 1] = bfhi(qa[j]); qf[8 + 2 * j] = bflo(qb[j]); qf[8 + 2 * j + 1] = bfhi(qb[j]); }
#pragma unroll
        for (int j = 0; j < 16; ++j) ss += qf[j] * qf[j];
        ss += __shfl_xor(ss, 16); ss += __shfl_xor(ss, 32);
        const float rstd = rsqrtf(ss * (1.f / 64.f) + 1e-6f) * 0.125f;
#pragma unroll
        for (int j = 0; j < 8; ++j) { qf[j] *= rstd * qg[fq * 8 + j]; qf[8 + j] *= rstd * qg[32 + fq * 8 + j]; }
        const bf16x8 Q0 = pack8(qf), Q1 = pack8(qf + 8);
        f32x4 s[10];
#pragma unroll
        for (int tt = 0; tt < 10; ++tt) {
            const LAS bf16_t* kr = Ks + ((2 * kb0 + tt) * 16 + fr) * 72 + fq * 8;
            const bf16x8 K0 = *(const LAS bf16x8*)kr, K1 = *(const LAS bf16x8*)(kr + 32);
            f32x4 z = (f32x4){0.f, 0.f, 0.f, 0.f};
            z = __builtin_amdgcn_mfma_f32_16x16x32_bf16(K0, Q0, z, 0, 0, 0);
            s[tt] = __builtin_amdgcn_mfma_f32_16x16x32_bf16(K1, Q1, z, 0, 0, 0);
        }
        if (var == 3) {
#pragma unroll
            for (int tt = 0; tt < 10; ++tt) s[tt] = (f32x4){0.25f, 0.5f, 0.125f, 0.375f};
        }
        const int qi = q0 + fr;
        float m = sink;
#pragma unroll
        for (int tt = 0; tt < 10; ++tt)
#pragma unroll
            for (int j = 0; j < 4; ++j) {
                const int kidx = (2 * kb0 + tt) * 16 + fq * 4 + j;
                const bool vis = (kidx > qi) && (kidx <= qi + 128) && (n > 0 || kidx >= 128);
                const float sv = vis ? s[tt][j] : -INFINITY; s[tt][j] = sv; m = fmaxf(m, sv);
            }
        m = fmaxf(m, __shfl_xor(m, 16)); m = fmaxf(m, __shfl_xor(m, 32));
        float sum = 0.f;
#pragma unroll
        for (int tt = 0; tt < 10; ++tt)
#pragma unroll
            for (int j = 0; j < 4; ++j) { const float p = __expf(s[tt][j] - m); s[tt][j] = p; sum += p; }
        sum += __shfl_xor(sum, 16); sum += __shfl_xor(sum, 32);
        sum += __expf(sink - m);
        const float inv = 1.f / sum;
        f32x4 o[4];
#pragma unroll
        for (int dt = 0; dt < 4; ++dt) o[dt] = (f32x4){0.f, 0.f, 0.f, 0.f};
        if (var == 2) {
#pragma unroll
            for (int dt = 0; dt < 4; ++dt) o[dt] = s[dt] + s[4 + dt] + s[(8 + dt) > 9 ? 9 : 8 + dt];
        } else
        {
#pragma unroll
        for (int kb = 0; kb < 5; ++kb) {
            float pf[8];
#pragma unroll
            for (int j = 0; j < 4; ++j) { pf[j] = s[2 * kb][j] * inv; pf[4 + j] = s[2 * kb + 1][j] * inv; }
            const bf16x8 Pf = pack8(pf);
#pragma unroll
            for (int dt = 0; dt < 4; ++dt) {
                const bf16x8 Vf = *(const LAS bf16x8*)(Vt + (dt * 16 + fr) * 264 + (kb0 + kb) * 32 + fq * 8);
                o[dt] = __builtin_amdgcn_mfma_f32_16x16x32_bf16(Pf, Vf, o[dt], 0, 0, 0);
            }
        }
        }
#pragma unroll
        for (int dt = 0; dt < 4; ++dt)
#pragma unroll
            for (int j = 0; j < 4; ++j)
                Y[(size_t)(b * SEQL + n * 128 + q0 + fq * 4 + j) * 1024 + hq * 64 + dt * 16 + fr] = (bf16_t)(cvt_pk_bf16(o[dt][j], 0.f) & 0xffffu);
    }
    __syncthreads();
}

__device__ __forceinline__ void conv_part(const Params& P, int l, int tid, int bid, int nblk) {
    const bf16_t* PC = (const bf16_t*)(P.ws + OFF_R1 + R1_CONV);
    bf16_t* Y = (bf16_t*)(P.ws + OFF_HN);
    const float* cw = P.in[24] + l * 768;
    for (int idx = bid * 512 + tid; idx < NTOK * 32; idx += nblk * 512) {
        const int tok = idx >> 5, c = (idx & 31) * 8, t = tok & (SEQL - 1);
        const bf16_t* p = PC + (size_t)tok * 768 + c;
        const u32x4 bg = *(const u32x4*)p;
        float u[3][8];
#pragma unroll
        for (int d = 0; d < 3; ++d) {
            if (t >= d) { const u32x4 cg4 = *(const u32x4*)(p - d * 768 + 256), hg = *(const u32x4*)(p - d * 768 + 512);
#pragma unroll
                for (int j = 0; j < 4; ++j) { u[d][2 * j] = bflo(cg4[j]) * bflo(hg[j]); u[d][2 * j + 1] = bfhi(cg4[j]) * bfhi(hg[j]); }
            } else {
#pragma unroll
                for (int j = 0; j < 8; ++j) u[d][j] = 0.f;
            }
        }
        float y[8];
#pragma unroll
        for (int j = 0; j < 8; ++j) {
            const float bgv = (j & 1) ? bfhi(bg[j >> 1]) : bflo(bg[j >> 1]);
            y[j] = bgv * (cw[c + j] * u[2][j] + cw[256 + c + j] * u[1][j] + cw[512 + c + j] * u[0][j]);
        }
        *(bf16x8*)(Y + (size_t)tok * 1024 + 768 + c) = pack8(y);
    }
}

template <int MODE>
__device__ __forceinline__ void prep_tile(const Params& P, int l, int tile, LAS unsigned char* lds, int tid, int wid, int lane) {
    const bf16_t* PR = (const bf16_t*)(P.ws + OFF_R1 + R1_RWKV);
    unsigned char* REC = P.ws + OFF_R2;
    bf16_t* G = (bf16_t*)(P.ws + OFF_R2 + R2_G);
    float* BON = (float*)(P.ws + OFF_BONUS);
    LAS bf16_t* Xs = (LAS bf16_t*)lds;
    const float* mu = P.in[13] + l * 1024;
    const int tok0 = tile * 64;
    {
        const int t = tid >> 3, seg = tid & 7, tok = tok0 + t; const bool first = (tok & (SEQL - 1)) == 0;
        const bf16_t* p = PR + (size_t)tok * 1024 + 768 + seg * 32;
        const float c1 = seg < 2 ? 2.f : 1.f, c2 = seg < 2 ? 2.f : 1.f, c3 = seg < 2 ? -1.f : 0.f; const bool ident = (seg == 2 || seg == 3);
        if ((MODE == 0) == (seg < 4)) {
#pragma unroll
        for (int i = 0; i < 4; ++i) {
            float xo[8];
            const u32x4 ca = ((const u32x4*)p)[i], cp = first ? (u32x4){0u, 0u, 0u, 0u} : ((const u32x4*)(p - 1024))[i];
#pragma unroll
            for (int hh = 0; hh < 2; ++hh) {
                const f32x2_t a01 = f16x2_to_f32(ca[2 * hh]), a23 = f16x2_to_f32(ca[2 * hh + 1]), p01 = f16x2_to_f32(cp[2 * hh]), p23 = f16x2_to_f32(cp[2 * hh + 1]);
                const f32x4 a = (f32x4){a01[0], a01[1], a23[0], a23[1]};
                const f32x4 pv = (f32x4){p01[0], p01[1], p23[0], p23[1]};
                const f32x4 m = ((const f32x4*)(mu + 768 + seg * 32))[2 * i + hh];
                const f32x4 x = a + m * (pv - a);
#pragma unroll
                for (int j = 0; j < 4; ++j) { const float sg = sigmoid_f(c1 * x[j]) * c2 + c3; xo[hh * 4 + j] = ident ? x[j] : sg; }
            }
            *(LAS bf16x8*)(Xs + t * 264 + seg * 32 + i * 8) = pack8(xo);
        }
        }
    }
    __syncthreads();
    const int fr = lane & 15, fq = lane >> 4, hh = wid & 3;
    const bf16_t* WTw = (const bf16_t*)(P.ws + ((l & 1) ? OFF_LORA2 : OFF_LORA)); const bf16_t* WTa = WTw + 16384; const bf16_t* WTg = WTw + 32768;
    const float* w0 = P.in[14] + l * 256; const float* a0 = P.in[16] + l * 256; const float* k_k = P.in[19] + l * 256;
    const float* k_a = P.in[20] + l * 256; const float* r_k = P.in[21] + l * 256;
#pragma unroll
    for (int ti = 0; ti < 2; ++ti) {
        const int tq = (wid >> 2) * 2 + ti;
        bf16x8 xb[8];
#pragma unroll
        for (int ks = (MODE == 0 ? 0 : 4); ks < (MODE == 0 ? 4 : 8); ++ks) xb[ks] = *(const LAS bf16x8*)(Xs + (tq * 16 + fr) * 264 + ks * 32 + fq * 8);
        f32x4 aw[4], aa[4], ag[4];
#pragma unroll
        for (int ct = 0; ct < 4; ++ct) {
            const int col = hh * 64 + ct * 16 + fr;
            f32x4 z = (f32x4){0.f, 0.f, 0.f, 0.f};
            if (MODE == 0) {
#pragma unroll
            for (int ks = 0; ks < 2; ++ks) z = __builtin_amdgcn_mfma_f32_16x16x32_bf16(*(const bf16x8*)(WTw + col * 64 + ks * 32 + fq * 8), xb[ks], z, 0, 0, 0);
            aw[ct] = z; z = (f32x4){0.f, 0.f, 0.f, 0.f};
#pragma unroll
            for (int ks = 0; ks < 2; ++ks) z = __builtin_amdgcn_mfma_f32_16x16x32_bf16(*(const bf16x8*)(WTa + col * 64 + ks * 32 + fq * 8), xb[2 + ks], z, 0, 0, 0);
            aa[ct] = z; z = (f32x4){0.f, 0.f, 0.f, 0.f};
            } else {
#pragma unroll
            for (int ks = 0; ks < 4; ++ks) z = __builtin_amdgcn_mfma_f32_16x16x32_bf16(*(const bf16x8*)(WTg + col * 128 + ks * 32 + fq * 8), xb[4 + ks], z, 0, 0, 0);
            ag[ct] = z;
            }
        }
        const int tok = tok0 + tq * 16 + fr; const bool first = (tok & (SEQL - 1)) == 0;
        if (MODE == 1) {
#pragma unroll
            for (int ct = 0; ct < 4; ++ct) { const int c4 = hh * 64 + ct * 16 + fq * 4; uint2 go; go.x = cvt_pk_f16(ag[ct][0], ag[ct][1]); go.y = cvt_pk_f16(ag[ct][2], ag[ct][3]);
                *(uint2*)(G + (size_t)tok * 256 + c4) = go; }
            continue;
        }
        const bf16_t* pr = PR + (size_t)tok * 1024;
        unsigned char* rec = REC + ((size_t)tok * 4 + hh) * REC_B;
        f32x4 kkv[4], av[4]; float ss = 0.f, bon = 0.f;
        uint2 cur[4][3], prv[4][3];
#pragma unroll
        for (int ct = 0; ct < 4; ++ct)
#pragma unroll
            for (int q = 0; q < 3; ++q) {
                const int c4 = hh * 64 + ct * 16 + fq * 4;
                cur[ct][q] = *(const uint2*)(pr + q * 256 + c4);
                prv[ct][q] = first ? (uint2){0u, 0u} : *(const uint2*)(pr - 1024 + q * 256 + c4);
            }
#pragma unroll
        for (int ct = 0; ct < 4; ++ct) {
            const int c4 = hh * 64 + ct * 16 + fq * 4, lo = ct * 16 + fq * 4;
            f32x4 x3[3];
#pragma unroll
            for (int q = 0; q < 3; ++q) {
                const f32x4 m = *(const f32x4*)(mu + q * 256 + c4);
                const uint2 cu = cur[ct][q], pu = prv[ct][q];
                const f32x2_t c01 = f16x2_to_f32(cu.x), c23 = f16x2_to_f32(cu.y), q01 = f16x2_to_f32(pu.x), q23 = f16x2_to_f32(pu.y);
                const f32x4 cf = (f32x4){c01[0], c01[1], c23[0], c23[1]}, pf = (f32x4){q01[0], q01[1], q23[0], q23[1]};
                x3[q] = cf + m * (pf - cf);
            }
            const f32x4 r4 = x3[0], k4 = x3[1], v4 = x3[2];
            const f32x4 w0v = *(const f32x4*)(w0 + c4), a0v = *(const f32x4*)(a0 + c4), kkw = *(const f32x4*)(k_k + c4), kaw = *(const f32x4*)(k_a + c4), rkw = *(const f32x4*)(r_k + c4);
            f32x4 dec, a4, kp;
#pragma unroll
            for (int j = 0; j < 4; ++j) {
                const float w = w0v[j] + aw[ct][j];
                dec[j] = __builtin_amdgcn_exp2f((-0.6065306597126334f * 1.4426950408889634f) * sigmoid_f(w));
                a4[j] = sigmoid_f(a0v[j] + aa[ct][j]);
            }
            kkv[ct] = k4 * kkw; av[ct] = a4;
            kp = k4 * ((a4 - 1.0f) * kaw + 1.0f);
#pragma unroll
            for (int j = 0; j < 4; ++j) { ss += kkv[ct][j] * kkv[ct][j]; bon += r4[j] * kp[j] * rkw[j]; }
            *(f32x4*)(rec + lo * 4) = dec;
            { uint2 t; t.x = cvt_pk_f16(r4[0], r4[1]); t.y = cvt_pk_f16(r4[2], r4[3]); *(uint2*)(rec + 256 + 0 * 128 + lo * 2) = t;
              t.x = cvt_pk_f16(kp[0], kp[1]); t.y = cvt_pk_f16(kp[2], kp[3]); *(uint2*)(rec + 256 + 1 * 128 + lo * 2) = t;
              t.x = cvt_pk_f16(v4[0], v4[1]); t.y = cvt_pk_f16(v4[2], v4[3]); *(uint2*)(rec + 256 + 2 * 128 + lo * 2) = t; }
        }
        ss += __shfl_xor(ss, 16); ss += __shfl_xor(ss, 32); bon += __shfl_xor(bon, 16); bon += __shfl_xor(bon, 32);
        const float rn = ss > 1e-24f ? __builtin_amdgcn_rsqf(ss) : 1e12f;
#pragma unroll
        for (int ct = 0; ct < 4; ++ct) { const int lo = ct * 16 + fq * 4; const f32x4 kk = kkv[ct] * rn, ka = kk * av[ct]; uint2 t;
            t.x = cvt_pk_f16(kk[0], kk[1]); t.y = cvt_pk_f16(kk[2], kk[3]); *(uint2*)(rec + 256 + 3 * 128 + lo * 2) = t;
            t.x = cvt_pk_f16(ka[0], ka[1]); t.y = cvt_pk_f16(ka[2], ka[3]); *(uint2*)(rec + 256 + 4 * 128 + lo * 2) = t; }
        if (fq == 0) BON[(size_t)tok * 4 + hh] = bon;
    }
    __syncthreads();
}

__device__ __forceinline__ void scan_stage_piece(LAS float* buf, int idx, u32x4 w) {
    const int s = idx / 56, o = idx % 56;
    if (o < 16) { *(LAS u32x4*)(buf + s * 384 + 64 + o * 4) = w; }
    else {
        const int p = o - 16, q = p >> 3, j = p & 7, dq = q == 0 ? 0 : q + 1;
        LAS float* d = buf + s * 384 + dq * 64 + j * 8;
        const f32x2_t e0 = f16x2_to_f32(w[0]), e1 = f16x2_to_f32(w[1]), e2 = f16x2_to_f32(w[2]), e3 = f16x2_to_f32(w[3]);
        *(LAS f32x4*)d = (f32x4){e0[0], e0[1], e1[0], e1[1]};
        *(LAS f32x4*)(d + 4) = (f32x4){e2[0], e2[1], e3[0], e3[1]};
    }
}
__device__ __forceinline__ void phase_scan(const Params& P, LAS unsigned char* lds, int tid, int wid, int lane, int bid, int nblk) {
    const unsigned char* REC = P.ws + OFF_R2;
    float* YS = (float*)(P.ws + OFF_YS);
    for (int item = bid; item < 128; item += nblk) {
        const int bh = (item & 7) * 4 + ((item >> 3) & 3), rg = item >> 5, b = bh >> 2, h = bh & 3;
        const unsigned char* src0 = REC + ((size_t)(b * SEQL) * 4 + h) * REC_B;
        u32x4 st[7]; const int ltid = tid - 256;
        if (wid >= 4) {
#pragma unroll
            for (int i = 0; i < 7; ++i) { const int idx = ltid + 256 * i, s = idx / 56, o = idx % 56; st[i] = *(const u32x4*)(src0 + (size_t)s * (4 * REC_B) + o * 16); }
#pragma unroll
            for (int i = 0; i < 7; ++i) scan_stage_piece((LAS float*)lds, ltid + 256 * i, st[i]);
        }
        __syncthreads();
        typedef float f32x2v __attribute__((ext_vector_type(2)));
        f32x2v Sa = {0.f, 0.f}, Sb = {0.f, 0.f};
        const int rl = lane >> 4, kq = lane & 15, row = rg * 16 + (wid & 3) * 4 + rl;
        for (int ch = 0; ch < 128; ++ch) {
            if (wid >= 4 && ch + 1 < 128) {
#pragma unroll
                for (int i = 0; i < 7; ++i) { const int idx = ltid + 256 * i, s = idx / 56, o = idx % 56; st[i] = *(const u32x4*)(src0 + (size_t)((ch + 1) * 32 + s) * (4 * REC_B) + o * 16); }
            }
            if (wid < 4) {
                const LAS float* buf = (const LAS float*)(lds + (ch & 1) * 49152);
                float* yp = YS + (size_t)(b * SEQL + ch * 32 + kq) * 256 + h * 64 + row;
                const LAS float* rc = buf + kq * 4;
                const LAS float* rv = buf + 192 + row;
                f32x4 r4 = *(const LAS f32x4*)(rc), w4 = *(const LAS f32x4*)(rc + 64), k4 = *(const LAS f32x4*)(rc + 128), kk4 = *(const LAS f32x4*)(rc + 256), ka4 = *(const LAS f32x4*)(rc + 320);
                float v = rv[0];
                float oacc = 0.f;
#define LO2(x) __builtin_shufflevector(x, x, 0, 1)
#define HI2(x) __builtin_shufflevector(x, x, 2, 3)
#pragma unroll
                for (int s = 0; s < 32; ++s) {
                    f32x4 nr4 = r4, nw4 = w4, nk4 = k4, nkk4 = kk4, nka4 = ka4; float nv = v;
                    if (s + 1 < 32) {
                        const LAS float* rn = rc + (s + 1) * 384;
                        nr4 = *(const LAS f32x4*)(rn); nw4 = *(const LAS f32x4*)(rn + 64); nk4 = *(const LAS f32x4*)(rn + 128); nkk4 = *(const LAS f32x4*)(rn + 256); nka4 = *(const LAS f32x4*)(rn + 320);
                        nv = rv[(s + 1) * 384];
                    }
                    f32x2v d2 = Sa * LO2(kk4); d2 = Sb * HI2(kk4) + d2;
                    const float d = rowsum16(d2[0] + d2[1]);
                    const f32x2v vv = {v, v}, dd = {d, d};
                    f32x2v ta = Sa * LO2(w4), tb = Sb * HI2(w4);
                    ta = vv * LO2(k4) + ta; tb = vv * HI2(k4) + tb;
                    Sa = ta - dd * LO2(ka4); Sb = tb - dd * HI2(ka4);
                    f32x2v o2 = Sa * LO2(r4); o2 = Sb * HI2(r4) + o2;
                    const float o = rowsum16(o2[0] + o2[1]);
                    oacc = (kq == (s & 15)) ? o : oacc;
                    if ((s & 15) == 15) yp[(size_t)(s - 15) * 256] = oacc;
                    r4 = nr4; w4 = nw4; k4 = nk4; kk4 = nkk4; ka4 = nka4; v = nv;
                }
#undef LO2
#undef HI2
            }
            if (wid >= 4 && ch + 1 < 128) {
#pragma unroll
                for (int i = 0; i < 7; ++i) scan_stage_piece((LAS float*)(lds + ((ch + 1) & 1) * 49152), ltid + 256 * i, st[i]);
            }
            __syncthreads();
        }
    }
}

__device__ __forceinline__ void phase_post(const Params& P, int l, int tid, int bid, int nblk) {
    const float* YS = (const float*)(P.ws + OFF_YS);
    const unsigned char* REC = P.ws + OFF_R2;
    const bf16_t* G = (const bf16_t*)(P.ws + OFF_R2 + R2_G);
    const float* BON = (const float*)(P.ws + OFF_BONUS);
    bf16_t* Y = (bf16_t*)(P.ws + OFF_HN);
    const float* gw = P.in[22] + l * 256; const float* gb = P.in[23] + l * 256;
    const int stride = nblk * 512;
    for (int base = bid * 512 + tid; base < NTOK * 64; base += 8 * stride) {
        f32x4 y[8]; uint2 vu[8], gg[8]; float bon[8];
#pragma unroll
        for (int j = 0; j < 8; ++j) {
            const int idx = base + j * stride;
            if (idx < NTOK * 64) {
                const int l16 = idx & 15, th = idx >> 4, tok = th >> 2, h = th & 3, c = h * 64 + l16 * 4;
                y[j] = *(const f32x4*)(YS + (size_t)tok * 256 + c);
                vu[j] = *(const uint2*)(REC + ((size_t)tok * 4 + h) * REC_B + 256 + 2 * 128 + l16 * 8);
                gg[j] = *(const uint2*)(G + (size_t)tok * 256 + c);
                bon[j] = BON[(size_t)tok * 4 + h];
            }
        }
#pragma unroll
        for (int j = 0; j < 8; ++j) {
            const int idx = base + j * stride;
            if (idx < NTOK * 64) {
                const int l16 = idx & 15, th = idx >> 4, tok = th >> 2, h = th & 3, c = h * 64 + l16 * 4;
                const float mean = rowsum16((y[j][0] + y[j][1]) + (y[j][2] + y[j][3])) * (1.f / 64.f);
                const f32x4 d = y[j] - mean;
                const float var = rowsum16((d[0] * d[0] + d[1] * d[1]) + (d[2] * d[2] + d[3] * d[3])) * (1.f / 64.f);
                const float rs = rsqrtf(var + 64e-5f);
                const f32x2_t v01 = f16x2_to_f32(vu[j].x), v23 = f16x2_to_f32(vu[j].y), g01 = f16x2_to_f32(gg[j].x), g23 = f16x2_to_f32(gg[j].y);
                const f32x4 v4 = (f32x4){v01[0], v01[1], v23[0], v23[1]}, g4 = (f32x4){g01[0], g01[1], g23[0], g23[1]};
                const f32x4 o = ((d * rs) * *(const f32x4*)(gw + c) + *(const f32x4*)(gb + c) + v4 * bon[j]) * g4;
                uint2 ov; ov.x = cvt_pk_bf16(o[0], o[1]); ov.y = cvt_pk_bf16(o[2], o[3]);
                *(uint2*)(Y + (size_t)tok * 1024 + 512 + c) = ov;
            }
        }
    }
}

#define XB_TMO      128
#define XB_XCNT(j)  (256  + 64 * (j))
#define XB_XSUB(j)  (1280 + 64 * (j))
#define XB_XGEN(j)  (2304 + 64 * (j))
#define XB_TOP      3328
#define XB_TOPGEN   3392
#define XCD_BAR_WORDS 3456
#define XB_SPIN_CAP (1u << 18)

__device__ __forceinline__ unsigned xb_ld(unsigned* p)              { return __hip_atomic_load(p, __ATOMIC_RELAXED, __HIP_MEMORY_SCOPE_AGENT); }
__device__ __forceinline__ unsigned xb_add(unsigned* p, unsigned v) { return __hip_atomic_fetch_add(p, v, __ATOMIC_RELAXED, __HIP_MEMORY_SCOPE_AGENT); }
__device__ __forceinline__ unsigned xb_xcc_id() { return (unsigned)__builtin_amdgcn_s_getreg((3 << 11) | 20) & 0xFu; }
#define XB_SPIN(cond, bar) do { unsigned _sp = 0; while (cond) { __builtin_amdgcn_s_sleep(1); \
    if ((++_sp & 255u) == 0u) { if (xb_ld(&(bar)[XB_TMO])) break; if (_sp > XB_SPIN_CAP) { atomicAdd(&(bar)[XB_TMO], 1u); break; } } } } while (0)

struct XcdBarrier {
    unsigned* bar; unsigned x;
    volatile LAS unsigned* st;
};

__device__ __forceinline__ XcdBarrier xcd_barrier_post(unsigned* bar, volatile LAS unsigned* st) {
    XcdBarrier b; b.bar = bar; b.x = xb_xcc_id(); b.st = st;
    if (threadIdx.x == 0) (void)xb_add(&bar[XB_XCNT(b.x)], 1u);
    return b;
}
__device__ __forceinline__ void xcd_barrier_complete(unsigned* bar, unsigned x, unsigned& nloc, unsigned& nx) {
    const unsigned G = gridDim.x * gridDim.y * gridDim.z;
    unsigned sum, cnt, mine, sp = 0u;
    for (;;) {
        sum = 0u; cnt = 0u; mine = 0u;
#pragma unroll
        for (unsigned j = 0; j < 16; ++j) { const unsigned c = xb_ld(&bar[XB_XCNT(j)]); sum += c; cnt += (c > 0u) ? 1u : 0u; mine = (j == x) ? c : mine; }
        if (sum == G) break;
        __builtin_amdgcn_s_sleep(1);
        if ((++sp & 255u) == 0u) { if (xb_ld(&bar[XB_TMO])) break; if (sp > XB_SPIN_CAP) { atomicAdd(&bar[XB_TMO], 1u); break; } }
    }
    nloc = mine > 0u ? mine : 1u; nx = cnt > 0u ? cnt : 1u;
}

__device__ __forceinline__ void xcd_barrier(const XcdBarrier& b) {
    asm volatile("s_waitcnt vmcnt(0)" ::: "memory");
    __syncthreads();
    if (threadIdx.x == 0) {
        unsigned* bar = b.bar;
        __builtin_amdgcn_s_waitcnt(0);
        unsigned nloc = b.st[0], nx = b.st[1];
        if (nloc == 0u) { xcd_barrier_complete(bar, b.x, nloc, nx); b.st[0] = nloc; b.st[1] = nx; }
        const unsigned old = xb_add(&bar[XB_XSUB(b.x)], 1u);
        const unsigned gen = old / nloc;
        if (old + 1u == (gen + 1u) * nloc) {
            __builtin_amdgcn_fence(__ATOMIC_RELEASE, "agent");
            asm volatile("s_waitcnt vmcnt(0)" ::: "memory");
            const unsigned og = xb_add(&bar[XB_TOP], 1u);
            const unsigned tg = og / nx;
            if (og + 1u == (tg + 1u) * nx) xb_add(&bar[XB_TOPGEN], 1u);
            else XB_SPIN(xb_ld(&bar[XB_TOPGEN]) == tg, bar);
            __builtin_amdgcn_fence(__ATOMIC_ACQUIRE, "agent");
            xb_add(&bar[XB_XGEN(b.x)], 1u);
            asm volatile("s_waitcnt vmcnt(0)" ::: "memory");
        } else {
            XB_SPIN(xb_ld(&bar[XB_XGEN(b.x)]) == gen, bar);
            __builtin_amdgcn_fence(__ATOMIC_ACQUIRE, "agent");
            asm volatile("s_waitcnt vmcnt(0)" ::: "memory");
        }
    }
    __syncthreads();
}


__global__ __launch_bounds__(512, 2) void mega(Params P) {
    extern __shared__ __attribute__((aligned(16))) unsigned char shm[];
    LAS unsigned char* lds = (LAS unsigned char*)shm;
    const int nblk = gridDim.x;
    volatile LAS unsigned* bst = (volatile LAS unsigned*)(lds + 131072);
    if (threadIdx.x < 2) bst[threadIdx.x] = 0u;
    __syncthreads();
    const XcdBarrier xbar = xcd_barrier_post((unsigned*)(P.ws + WS_BAR), bst);
    float* MOD = (float*)(P.ws + OFF_MOD);
    bf16_t* HN = (bf16_t*)(P.ws + OFF_HN);
    bf16_t* ACT = (bf16_t*)(P.ws + OFF_R1);
#ifdef DIAG_TIME
    unsigned long long tA = 0, tB = 0, tprev = __builtin_amdgcn_s_memrealtime();
#endif
    for (int ph = P.ph_lo; ph < P.ph_hi; ++ph) {
#ifdef DBL_PHASE
      for (int rep = (ph > 0 && DBL_PHASE((ph - 1) % PPL)) ? 0 : 1; rep < 2; ++rep) {
#endif
        int tid = threadIdx.x, bid = blockIdx.x;
        asm volatile("" : "+v"(tid)); asm volatile("" : "+s"(bid));
        const int wid = __builtin_amdgcn_readfirstlane(tid >> 6), lane = tid & 63;
        if (ph == 0) {
#ifndef NO_MOD
            phase_mod(P, lds, tid, wid, lane, bid, nblk);
#endif
            phase_convert(P, 0, lds, wid, lane, bid, nblk);
#ifdef DIAG_POISON
            { u32x4* w = (u32x4*)(P.ws + OFF_LORA); const size_t n16 = (WS_END - OFF_LORA) / 16;
              for (size_t i = (size_t)bid * 512 + tid; i < n16; i += (size_t)nblk * 512) w[i] = (u32x4){0xAAAAAAAAu, 0xAAAAAAAAu, 0xAAAAAAAAu, 0xAAAAAAAAu}; }
#endif
        } else {
            const int l = (ph - 1) / PPL, s = (ph - 1) % PPL;
            bf16_t* HB = (bf16_t*)(P.ws + OFF_HB);
            const bool first_h = (l == 0 && s < 3), last_h = (l == DEPTH - 1 && s == PPL - 1);
            const void* hin = first_h ? (const void*)P.in[0] : (const void*)HB;
            void* hout = last_h ? (void*)P.out : (void*)HB;
            const float* modl = MOD + (size_t)l * 8 * 9216;
            bf16_t* WB = (bf16_t*)(P.ws + ((l & 1) ? OFF_WB2 : OFF_WB));
            pg8::Gemm g{HN, WB, NTOK, 1024, 1024}; pg8::EpiAny E{}; bool is_gemm = true;
            switch (s) {
            case 0:
#ifndef NO_NORM
                if (first_h) phase_norm<true>(P, hin, P.in[4] + l * 1024, modl, wid, lane, bid, nblk); else phase_norm<false>(P, hin, P.in[4] + l * 1024, modl, wid, lane, bid, nblk);
#endif
                is_gemm = false; break;
            case 1: g.Bt = WB + WB_FFN1IN; g.N = 2 * DFF; E.kind = 0; E.perm = true; E.sw.O = ACT; break;
            case 2: g.A = ACT; g.Bt = WB + WB_FFN1OUT; g.K = DFF; E.kind = 1; E.rs = pg8::EpiResid{hin, hout, modl + 2 * 1024, 0.5f, first_h ? 1 : 0, last_h ? 1 : 0}; break;
            case 3: phase_norm<false>(P, hin, P.in[7] + l * 1024, modl + 3 * 1024, wid, lane, bid, nblk); is_gemm = false; break;
            case 4: g.Bt = WB + WB_MIXIN; g.N = 2560; E.kind = 2; E.pj = pg8::EpiProj{(bf16_t*)(P.ws + OFF_R1), (bf16_t*)(P.ws + OFF_R1 + R1_RWKV), (bf16_t*)(P.ws + OFF_R1 + R1_CONV)}; break;
            case 5:
                for (int it = bid; it < 512; it += nblk) prep_tile<0>(P, l, it, lds, tid, wid, lane);
                is_gemm = false; break;
            case 6: {
                const int nscan = nblk >> 1;
                if (bid < nscan) phase_scan(P, lds, tid, wid, lane, bid, nscan);
                else {
                    const int vb = bid - nscan, vn = nblk - nscan;
                    for (int it = vb; it < 512; it += vn) attn_item(P, l, it, lds, tid, wid, lane, P.ph_lo < 0 ? 0 : ATTN_VAR(l));
                    conv_part(P, l, tid, vb, vn);
                    for (int it = vb; it < 512; it += vn) prep_tile<1>(P, l, it, lds, tid, wid, lane);
                    if (l + 1 < DEPTH) phase_convert(P, l + 1, lds, wid, lane, vb, vn);
                }
                is_gemm = false; } break;
            case 7: phase_post(P, l, tid, bid, nblk); is_gemm = false; break;
            case 8: g.Bt = WB + WB_MIXOUT; E.kind = 1; E.rs = pg8::EpiResid{hin, hout, modl + 5 * 1024, 1.0f, first_h ? 1 : 0, last_h ? 1 : 0}; break;
            case 9: phase_norm<false>(P, hin, P.in[25] + l * 1024, modl + 6 * 1024, wid, lane, bid, nblk); is_gemm = false; break;
            case 10: g.Bt = WB + WB_FFN2IN; g.N = 2 * DFF; E.kind = 0; E.perm = true; E.sw.O = ACT; break;
            default: g.A = ACT; g.Bt = WB + WB_FFN2OUT; g.K = DFF; E.kind = 1; E.rs = pg8::EpiResid{hin, hout, modl + 8 * 1024, 0.5f, first_h ? 1 : 0, last_h ? 1 : 0}; break;
            }
            if (is_gemm) { pg8::StaticOrder S; S.init(NTOK, g.N, nblk, bid); pg8::gemm_phase<pg8::EpiAny, pg8::StaticOrder, GEMM_ALIGN, GEMM_SP2>(lds, g, S, E, tid); }
        }
#ifdef DIAG_TIME
        const unsigned long long twork = __builtin_amdgcn_s_memrealtime();
        cg::this_grid().sync();
        { const unsigned long long tnow = __builtin_amdgcn_s_memrealtime(); const int sx = ph == 0 ? -1 : (ph - 1) % PPL;
          if (TSEL_A(sx)) tA += (TWAIT_A ? tnow - twork : tnow - tprev);
          if (TSEL_B(sx)) tB += (TWAIT_B ? tnow - twork : tnow - tprev);
          tprev = tnow; }
#else
#ifdef DBL_PHASE
        cg::this_grid().sync();
      }
#else
        if (ph + 1 < P.ph_hi) { if (P.ph_hi > 100000) cg::this_grid().sync(); else xcd_barrier(xbar); }
#ifdef EXTRA_SYNC
        if (ph + 1 < P.ph_hi) { cg::this_grid().sync(); }
#endif
#endif
#endif
    }
#ifdef DIAG_TIME
    {
        unsigned long long* tw = (unsigned long long*)(P.ws + WS_END);
        if (blockIdx.x == 0 && threadIdx.x == 0) { tw[0] = tA; tw[1] = tB; __threadfence(); }
        cg::this_grid().sync();
        const float fa = (float)__hip_atomic_load(tw, __ATOMIC_RELAXED, __HIP_MEMORY_SCOPE_AGENT) * 0.01f * 100.0f, fb = (float)__hip_atomic_load(tw + 1, __ATOMIC_RELAXED, __HIP_MEMORY_SCOPE_AGENT) * 0.01f;
        for (size_t i = (size_t)blockIdx.x * 512 + threadIdx.x; i < (size_t)NTOK * 1024; i += (size_t)gridDim.x * 512) P.out[i] = (i == 0) ? fa : fb;
    }
#endif
}


#ifdef DIAG_SELFTEST
__global__ void diag_checksum(const unsigned* p, size_t nwords, unsigned long long* slot) {
    unsigned long long acc = 0;
    for (size_t i = (size_t)blockIdx.x * blockDim.x + threadIdx.x; i < nwords; i += (size_t)gridDim.x * blockDim.x) acc += (unsigned long long)p[i] * (unsigned long long)(2 * i + 1);
    for (int o = 1; o < 64; o <<= 1) acc += __shfl_xor(acc, o);
    if ((threadIdx.x & 63) == 0) atomicAdd(slot, acc);
}
__global__ void diag_report(const unsigned long long* slots, int nitems, int nrep, float* out, size_t n) {
    int code = 0;
    for (int k = 0; k < nitems; ++k) for (int r = 1; r < nrep; ++r) if (slots[k * nrep + r] != slots[k * nrep]) { code |= 1 << k; break; }
    if (code == 0) return;
    const float c = 4.0f * exp2f((float)code);
    for (size_t i = (size_t)blockIdx.x * blockDim.x + threadIdx.x; i < n; i += (size_t)gridDim.x * blockDim.x) out[i] = c;
}
#endif
extern "C" void kernel_launch(void* const* d_in, const int* in_sizes, int n_in, void* d_out, int out_size, void* d_ws, size_t ws_size, hipStream_t stream) {
    static int grid = 0;
    if (grid == 0) {
        if (n_in != 28 || out_size != NTOK * DM || ws_size < WS_END) { fprintf(stderr, "kernel_launch: unexpected shapes (n_in %d out %d ws %zu need %zu)\n", n_in, out_size, ws_size, (size_t)WS_END); grid = -1; return; }
        int dev = 0, cus = 0, per_cu = 0;
        hipGetDevice(&dev); hipDeviceGetAttribute(&cus, hipDeviceAttributeMultiprocessorCount, dev);
        if (hipFuncSetAttribute((const void*)mega, hipFuncAttributeMaxDynamicSharedMemorySize, LDS_BYTES) != hipSuccess) { fprintf(stderr, "kernel_launch: hipFuncSetAttribute failed\n"); grid = -1; return; }
        if (hipOccupancyMaxActiveBlocksPerMultiprocessor(&per_cu, (const void*)mega, 512, LDS_BYTES) != hipSuccess || per_cu < 1) { fprintf(stderr, "kernel_launch: occupancy query failed (%d)\n", per_cu); per_cu = 1; (void)hipGetLastError(); }
        grid = cus * per_cu;
    }
    if (grid < 0) return;
    Params p{};
    for (int i = 0; i < 28; ++i) p.in[i] = (const float*)d_in[i];
    p.out = (float*)d_out; p.ws = (unsigned char*)d_ws;
#if MK_LAUNCHES == 1
    if (hipMemsetAsync((unsigned char*)d_ws + WS_BAR, 0, 16384, stream) != hipSuccess) { fprintf(stderr, "kernel_launch: memset of barrier words failed\n"); return; }
    p.ph_lo = 0; p.ph_hi = NPH;
    void* args[] = {&p};
    hipError_t e = hipLaunchCooperativeKernel((const void*)mega, dim3(grid), dim3(512), args, LDS_BYTES, stream);
    if (e != hipSuccess) fprintf(stderr, "cooperative launch failed: %s (grid %d)\n", hipGetErrorString(e), grid);
#else
#ifdef DIAG_SELFTEST
    {
        constexpr int NREP = 4;
        unsigned long long* slots = (unsigned long long*)((unsigned char*)d_ws + WS_END);
        hipMemsetAsync(slots, 0, 64 * NREP * 8, stream);
        int item = 0;
        for (int ph = 0; ph < NPH; ++ph) {
            p.ph_lo = ph; p.ph_hi = ph + 1; hipLaunchKernelGGL(mega, dim3(grid), dim3(512), LDS_BYTES, stream, p);
            if (ph == 0) continue;
            const int l = (ph - 1) / PPL, s = (ph - 1) % PPL;
            size_t off = 0, len = 0; bool test = (s == 5);
            switch (s) {
            case 0: off = OFF_LORA; len = OFF_R1 - OFF_LORA; break;
            case 1: case 12: off = OFF_R1; len = (size_t)NTOK * DFF * 2; break;
            case 2: test = false; break;
            case 3: case 5: case 7: case 9: case 11: off = OFF_HN; len = (size_t)NTOK * 1024 * 2; break;
            case 4: off = OFF_R1; len = R1_BYTES; break;
            case 6: off = OFF_R2; len = WS_END - OFF_R2; break;
            case 8: off = OFF_R1 + R1_RWKV; len = (size_t)NTOK * 256 * 4; break;
            default: test = false; break;
            }
            if (!test) continue;
            const unsigned* base = (s == 2) ? (const unsigned*)d_out : (const unsigned*)((unsigned char*)d_ws + off);
            const size_t nw = (s == 2) ? (size_t)NTOK * 1024 : len / 4;
            for (int r = 0; r < NREP; ++r) {
                if (r > 0) hipLaunchKernelGGL(mega, dim3(grid), dim3(512), LDS_BYTES, stream, p);
                hipLaunchKernelGGL(diag_checksum, dim3(2048), dim3(256), 0, stream, base, nw, slots + item * NREP + r);
            }
            ++item;
        }
        hipLaunchKernelGGL(diag_report, dim3(2048), dim3(256), 0, stream, (const unsigned long long*)slots, item, NREP, (float*)d_out, (size_t)NTOK * 1024);
    }
#else
    for (int ph = 0; ph < NPH; ++ph) { p.ph_lo = ph; p.ph_hi = ph + 1; hipLaunchKernelGGL(mega, dim3(grid), dim3(512), LDS_BYTES, stream, p); }
#endif
#endif
}
```

```cpp
#define ATTN_VAR(l) (P.ph_hi > 100000 ? (l) + 1 : 0)
#define GEMM_ALIGN true
#define GEMM_SP2 true
#include <hip/hip_runtime.h>
#include <hip/hip_cooperative_groups.h>
#include <cstdio>
#include <cstdint>
namespace cg = cooperative_groups;

#ifndef MK_LAUNCHES
#define MK_LAUNCHES 1
#endif

namespace pg8 {
#define PG8_LAS __attribute__((address_space(3)))
typedef unsigned short bf16_t;
typedef short bf16x8 __attribute__((ext_vector_type(8)));
typedef float f32x4 __attribute__((ext_vector_type(4)));
typedef unsigned u32x4 __attribute__((ext_vector_type(4)));
constexpr int BM = 256, BK = 64, HALF = 128, HTB = HALF * BK * 2  , STAGE_BYTES = 8 * HTB, NXCD = 8, WGM = 8;

__host__ __device__ __forceinline__ int lds_byte(int r, int c) { const int st = (r >> 4) * 2 + (c >> 5), rr = r & 15, cc = c & 31, ob = rr * 64 + cc * 2; return st * 1024 + (ob ^ (((ob >> 9) & 1) << 5)); }
__host__ __device__ __forceinline__ void stage_rc(int b, int& R, int& C) { const int st = b / 1024, sb = b % 1024, swz = sb ^ (((sb >> 9) & 1) << 5); R = (st >> 1) * 16 + swz / 64; C = (st & 1) * 32 + (swz % 64) / 2; }
__host__ __device__ __forceinline__ int perm32(int rho) { const int n = rho >> 4, i = rho & 15; return 8 * (i >> 2) + 4 * n + (i & 3); }

struct Unit { int pm, pn; };
struct Gemm { const bf16_t* A; const bf16_t* Bt; int M, N, K; };

struct StaticOrder {
    int nM, nN, nwg, G, c;
    __host__ __device__ void init(int M, int N, int G_, int c_) { nM = M / BM; nN = N / BM; nwg = nM * nN; G = G_; c = c_; }
    __host__ __device__ bool next(int i, Unit& u) const {
        const long L = (long)i * G + c; if (L >= nwg) return false;
        int wgid = (int)L; { const int q = nwg / NXCD, r = nwg % NXCD, xcd = wgid % NXCD, off = wgid / NXCD; wgid = (xcd < r ? xcd * (q + 1) : r * (q + 1) + (xcd - r) * q) + off; }
        const int nig = WGM * nN, gid = wgid / nig, fm = gid * WGM, gsz = (nM - fm) < WGM ? (nM - fm) : WGM;
        u.pm = fm + ((wgid % nig) % gsz); u.pn = (wgid % nig) / gsz; return true;
    }
    __device__ __forceinline__ void a_ready(const Unit&) const {}
    __device__ __forceinline__ void done(const Unit&) const {}
};
typedef __bf16 bf16v2_t __attribute__((ext_vector_type(2)));
typedef float f32x2_t __attribute__((ext_vector_type(2)));
__device__ __forceinline__ unsigned cvt_pk_bf16(float lo, float hi) { const f32x2_t v = {lo, hi}; const bf16v2_t b = __builtin_convertvector(v, bf16v2_t); return __builtin_bit_cast(unsigned, b); }

typedef _Float16 h16x2_t __attribute__((ext_vector_type(2)));
__device__ __forceinline__ unsigned cvt_pk_f16(float lo, float hi) { const f32x2_t v = {lo, hi}; const h16x2_t h = __builtin_convertvector(v, h16x2_t); return __builtin_bit_cast(unsigned, h); }
__device__ __forceinline__ f32x2_t f16x2_to_f32(unsigned u) { const h16x2_t h = __builtin_bit_cast(h16x2_t, u); return __builtin_convertvector(h, f32x2_t); }
template <class Epi, class Sched, bool ALIGN_EPI = false, bool SP2 = false>
__device__ __forceinline__ void gemm_phase(PG8_LAS unsigned char* lds, const Gemm g, const Sched& S, const Epi& E, const int tid) {
    const int wid = __builtin_amdgcn_readfirstlane(tid >> 6), lane = tid & 63, wr = wid >> 2, wc = wid & 3, fr = lane & 15, fq = lane >> 4;
    const int K = g.K, nt = K / BK;
    unsigned voffA[2], voffB[2];
#pragma unroll
    for (int i = 0; i < 2; ++i) { int R, C; stage_rc(tid * 16 + i * 8192, R, C); const int Rb = E.perm ? ((R & ~31) + perm32(R & 31)) : R;
        voffA[i] = (unsigned)(R * K + C) * 2u; voffB[i] = (unsigned)(Rb * K + C) * 2u; }
    const size_t kstep = (size_t)(BK * 2);
    const size_t hstep = (size_t)HALF * K * 2;
    const size_t tstep = 2 * hstep;
    const unsigned ldsw = (unsigned)wid * 1024u;
    const int aoff = lds_byte(wr * 64 + fr, fq * 8), boff = lds_byte(wc * 32 + fr, fq * 8);
#define PG8_SA(b, h) (((b) * 2 + (h)) * HTB)
#define PG8_SB(b, h) ((4 + (b) * 2 + (h)) * HTB)
#define PG8_STAGE(bufoff, gbase, voff) do { _Pragma("unroll") for (int _i = 0; _i < 2; ++_i) \
        __builtin_amdgcn_global_load_lds((const unsigned*)((const char*)(gbase) + (voff)[_i]), (PG8_LAS unsigned*)(lds + (bufoff) + ldsw + _i * 8192), 16, 0, 0); } while (0)
#define PG8_LDA(dst, b, h) do { _Pragma("unroll") for (int m = 0; m < 4; ++m) _Pragma("unroll") for (int k = 0; k < 2; ++k) dst[m][k] = *(const PG8_LAS bf16x8*)(lds + PG8_SA(b, h) + aoff + m * 2048 + k * 1024); } while (0)
#define PG8_LDB(dst, b, h) do { _Pragma("unroll") for (int n = 0; n < 2; ++n) _Pragma("unroll") for (int k = 0; k < 2; ++k) dst[n][k] = *(const PG8_LAS bf16x8*)(lds + PG8_SB(b, h) + boff + n * 2048 + k * 1024); } while (0)
#define PG8_MMA(ai, bj, At, Bt) do { __builtin_amdgcn_s_setprio(1); _Pragma("unroll") for (int m = 0; m < 4; ++m) _Pragma("unroll") for (int n = 0; n < 2; ++n) _Pragma("unroll") for (int k = 0; k < 2; ++k) \
        acc[ai][bj][m][n] = __builtin_amdgcn_mfma_f32_16x16x32_bf16(Bt[n][k], At[m][k], acc[ai][bj][m][n], 0, 0, 0); __builtin_amdgcn_s_setprio(0); } while (0)
#define PG8_WAIT_V(n) asm volatile("s_waitcnt vmcnt(" #n ")" ::: "memory")
#define PG8_WAIT_L(n) asm volatile("s_waitcnt lgkmcnt(" #n ")" ::: "memory")
#define PG8_BAR __builtin_amdgcn_s_barrier()
#define PG8_SCHED __builtin_amdgcn_sched_barrier(0)
    Unit cur, nxt; int ui = 0;
    if (!S.next(0, cur)) return;
    f32x4 acc[2][2][4][2];
#pragma unroll
    for (int a = 0; a < 2; ++a)
#pragma unroll
        for (int b = 0; b < 2; ++b)
#pragma unroll
            for (int m = 0; m < 4; ++m)
#pragma unroll
                for (int n = 0; n < 2; ++n) acc[a][b][m][n] = (f32x4){0.f, 0.f, 0.f, 0.f};
    bf16x8 At[4][2], B0[2][2], B1[2][2];
    const char* cA = (const char*)g.A + (size_t)cur.pm * tstep; const char* cB = (const char*)g.Bt + (size_t)cur.pn * tstep;
    S.a_ready(cur);
    if constexpr (SP2) {
        PG8_STAGE(PG8_SB(0, 0), cB, voffB); PG8_STAGE(PG8_SB(0, 1), cB + hstep, voffB); PG8_STAGE(PG8_SA(0, 0), cA, voffA); PG8_STAGE(PG8_SA(0, 1), cA + hstep, voffA);
        if (wr == 1) PG8_BAR;
        PG8_WAIT_V(2); PG8_BAR;
        PG8_STAGE(PG8_SB(1, 0), cB + kstep, voffB); PG8_STAGE(PG8_SA(1, 0), cA + kstep, voffA); PG8_STAGE(PG8_SB(1, 1), cB + hstep + kstep, voffB);
        PG8_WAIT_V(6); PG8_BAR;
    } else {
        PG8_STAGE(PG8_SB(0, 0), cB, voffB); PG8_STAGE(PG8_SA(0, 0), cA, voffA); PG8_STAGE(PG8_SB(0, 1), cB + hstep, voffB); PG8_STAGE(PG8_SA(0, 1), cA + hstep, voffA);
        if (wr == 1) PG8_BAR;
        PG8_WAIT_V(4); PG8_BAR;
        PG8_STAGE(PG8_SB(1, 0), cB + kstep, voffB); PG8_STAGE(PG8_SA(1, 0), cA + kstep, voffA); PG8_STAGE(PG8_SB(1, 1), cB + hstep + kstep, voffB);
        PG8_WAIT_V(6); PG8_BAR;
    }
    for (;;) {
        const bool has_next = S.next(ui + 1, nxt);
        const char* nA = has_next ? (const char*)g.A + (size_t)nxt.pm * tstep : cA; const char* nB = has_next ? (const char*)g.Bt + (size_t)nxt.pn * tstep : cB;
        for (int t = 0; t < nt; t += 2) {
            const bool last = (t == nt - 2);
            const char* a1 = cA + (size_t)(t + 1) * kstep;
            const char* a2 = last ? nA : cA + (size_t)(t + 2) * kstep; const char* b2 = last ? nB : cB + (size_t)(t + 2) * kstep;
            const char* a3 = a2 + kstep; const char* b3 = b2 + kstep;
            if (last && has_next) S.a_ready(nxt);
            if constexpr (SP2) {
            PG8_LDB(B0, 0, 0); PG8_LDB(B1, 0, 1); PG8_SCHED; PG8_LDA(At, 0, 0); PG8_STAGE(PG8_SA(1, 1), a1 + hstep, voffA);
            PG8_WAIT_V(8); PG8_WAIT_L(0); PG8_BAR; PG8_MMA(0, 0, At, B0); PG8_MMA(0, 1, At, B1); PG8_BAR; PG8_SCHED;
            PG8_LDA(At, 0, 1); PG8_STAGE(PG8_SB(0, 0), b2, voffB); PG8_STAGE(PG8_SB(0, 1), b2 + hstep, voffB); PG8_STAGE(PG8_SA(0, 0), a2, voffA);
            PG8_WAIT_V(8); PG8_WAIT_L(0); PG8_BAR; PG8_MMA(1, 0, At, B0); PG8_MMA(1, 1, At, B1); PG8_BAR; PG8_SCHED;
            PG8_LDB(B0, 1, 0); PG8_LDB(B1, 1, 1); PG8_SCHED; PG8_LDA(At, 1, 0); PG8_STAGE(PG8_SA(0, 1), a2 + hstep, voffA);
            PG8_WAIT_V(8); PG8_WAIT_L(0); PG8_BAR; PG8_MMA(0, 0, At, B0); PG8_MMA(0, 1, At, B1); PG8_BAR; PG8_SCHED;
            PG8_LDA(At, 1, 1); PG8_STAGE(PG8_SB(1, 0), b3, voffB); PG8_STAGE(PG8_SB(1, 1), b3 + hstep, voffB); PG8_STAGE(PG8_SA(1, 0), a3, voffA);
            PG8_WAIT_V(8); PG8_WAIT_L(0); PG8_BAR; PG8_MMA(1, 0, At, B0); PG8_MMA(1, 1, At, B1); PG8_BAR; PG8_SCHED;
            } else {
            PG8_LDB(B0, 0, 0); PG8_SCHED; PG8_LDA(At, 0, 0); PG8_STAGE(PG8_SA(1, 1), a1 + hstep, voffA);
            PG8_WAIT_L(8); PG8_BAR; PG8_WAIT_L(0); PG8_MMA(0, 0, At, B0); PG8_BAR; PG8_SCHED;
            PG8_LDB(B1, 0, 1); PG8_STAGE(PG8_SB(0, 0), b2, voffB);
            PG8_BAR; PG8_WAIT_L(0); PG8_MMA(0, 1, At, B1); PG8_BAR;
            PG8_LDA(At, 0, 1); PG8_STAGE(PG8_SA(0, 0), a2, voffA);
            PG8_BAR; PG8_WAIT_L(0); PG8_MMA(1, 0, At, B0); PG8_BAR; PG8_SCHED;
            PG8_STAGE(PG8_SB(0, 1), b2 + hstep, voffB);
            PG8_WAIT_V(6); PG8_BAR; PG8_MMA(1, 1, At, B1); PG8_BAR;
            PG8_LDB(B0, 1, 0); PG8_SCHED; PG8_LDA(At, 1, 0); PG8_STAGE(PG8_SA(0, 1), a2 + hstep, voffA);
            PG8_WAIT_L(8); PG8_BAR; PG8_WAIT_L(0); PG8_MMA(0, 0, At, B0); PG8_BAR; PG8_SCHED;
            PG8_LDB(B1, 1, 1); PG8_STAGE(PG8_SB(1, 0), b3, voffB);
            PG8_BAR; PG8_WAIT_L(0); PG8_MMA(0, 1, At, B1); PG8_BAR;
            PG8_LDA(At, 1, 1); PG8_STAGE(PG8_SA(1, 0), a3, voffA);
            PG8_BAR; PG8_WAIT_L(0); PG8_MMA(1, 0, At, B0); PG8_BAR; PG8_SCHED;
            PG8_STAGE(PG8_SB(1, 1), b3 + hstep, voffB);
            PG8_WAIT_V(6); PG8_BAR; PG8_MMA(1, 1, At, B1); PG8_BAR;
            }
        }
        if constexpr (ALIGN_EPI) { if (wr == 0) PG8_BAR; }
        if constexpr (!Epi::AFTER_DRAIN) { E(acc, cur, wr, wc, fr, fq); S.done(cur); }
        if (!has_next) break;
#pragma unroll
        for (int a = 0; a < 2; ++a)
#pragma unroll
            for (int b = 0; b < 2; ++b)
#pragma unroll
                for (int m = 0; m < 4; ++m)
#pragma unroll
                    for (int n = 0; n < 2; ++n) acc[a][b][m][n] = (f32x4){0.f, 0.f, 0.f, 0.f};
        cur = nxt; cA = nA; cB = nB; ++ui;
        if constexpr (ALIGN_EPI) { if (wr == 1) PG8_BAR; }
    }
    PG8_WAIT_V(0);
    if constexpr (!ALIGN_EPI) { if (wr == 0) PG8_BAR; }
    PG8_BAR;
    if constexpr (Epi::AFTER_DRAIN) { E.fused(acc, cur, wr, wc, fr, fq, lds, wid, lane); S.done(cur); }
#undef PG8_SA
#undef PG8_SB
#undef PG8_STAGE
#undef PG8_LDA
#undef PG8_LDB
#undef PG8_MMA
#undef PG8_WAIT_V
#undef PG8_WAIT_L
#undef PG8_BAR
#undef PG8_SCHED
}

__device__ __forceinline__ float silu_f(float x) { return x * __builtin_amdgcn_rcpf(1.f + __builtin_amdgcn_exp2f(-1.44269504089f * x)); }

struct EpiSwiglu {
    static constexpr bool PERM = true, AFTER_DRAIN = false;
    bf16_t* O;
    __device__ __forceinline__ void operator()(const f32x4 (&acc)[2][2][4][2], const Unit& u, int wr, int wc, int fr, int fq) const {
        const int row0 = u.pm * BM + wr * 64 + fr, col0 = u.pn * 128 + wc * 32 + 8 * fq;
#pragma unroll
        for (int ai = 0; ai < 2; ++ai)
#pragma unroll
            for (int m = 0; m < 4; ++m) {
                bf16_t* rowp = O + (size_t)(row0 + ai * HALF + m * 16) * 2816 + col0;
                const f32x4 g0 = acc[ai][0][m][0], g1 = acc[ai][0][m][1], u0 = acc[ai][1][m][0], u1 = acc[ai][1][m][1];
                u32x4 o;
                o.x = cvt_pk_bf16(silu_f(g0[0]) * u0[0], silu_f(g0[1]) * u0[1]); o.y = cvt_pk_bf16(silu_f(g0[2]) * u0[2], silu_f(g0[3]) * u0[3]);
                o.z = cvt_pk_bf16(silu_f(g1[0]) * u1[0], silu_f(g1[1]) * u1[1]); o.w = cvt_pk_bf16(silu_f(g1[2]) * u1[2], silu_f(g1[3]) * u1[3]);
                *(u32x4*)rowp = o;
            }
    }
};
struct EpiResid {
    static constexpr bool PERM = true, AFTER_DRAIN = false;
    const void* hin; void* hout; const float* gt; float scale; int in_f32, out_f32;
    template <bool INF, bool OUTF> __device__ __forceinline__ void run(const f32x4 (&acc)[2][2][4][2], const f32x4 (&gv)[2][2], int row0, int col0) const {
#pragma unroll
        for (int ai = 0; ai < 2; ++ai)
#pragma unroll
            for (int m = 0; m < 4; ++m) {
                const size_t off = (size_t)(row0 + ai * HALF + m * 16) * 1024 + col0;
#pragma unroll
                for (int bj = 0; bj < 2; ++bj) {
                    const size_t o = off + bj * HALF;
                    f32x4 h0, h1;
                    if (INF) { h0 = *(const f32x4*)((const float*)hin + o); h1 = *(const f32x4*)((const float*)hin + o + 4); }
                    else { const u32x4 u = *(const u32x4*)((const bf16_t*)hin + o); const f32x2_t a = f16x2_to_f32(u[0]), c = f16x2_to_f32(u[1]), d = f16x2_to_f32(u[2]), e = f16x2_to_f32(u[3]);
                           h0 = (f32x4){a[0], a[1], c[0], c[1]}; h1 = (f32x4){d[0], d[1], e[0], e[1]}; }
                    const f32x4 r0 = h0 + gv[bj][0] * acc[ai][bj][m][0], r1 = h1 + gv[bj][1] * acc[ai][bj][m][1];
                    if (OUTF) { *(f32x4*)((float*)hout + o) = r0; *(f32x4*)((float*)hout + o + 4) = r1; }
                    else { u32x4 w; w[0] = cvt_pk_f16(r0[0], r0[1]); w[1] = cvt_pk_f16(r0[2], r0[3]); w[2] = cvt_pk_f16(r1[0], r1[1]); w[3] = cvt_pk_f16(r1[2], r1[3]); *(u32x4*)((bf16_t*)hout + o) = w; }
                }
            }
    }
    __device__ __forceinline__ void operator()(const f32x4 (&acc)[2][2][4][2], const Unit& u, int wr, int wc, int fr, int fq) const {
        const int row0 = u.pm * BM + wr * 64 + fr, col0 = u.pn * BM + wc * 32 + 8 * fq;
        const float* gp = gt + (size_t)(u.pm >> 4) * 9216 + col0;
        f32x4 gv[2][2];
#pragma unroll
        for (int bj = 0; bj < 2; ++bj)
#pragma unroll
            for (int n = 0; n < 2; ++n) { const f32x4 t = *(const f32x4*)(gp + bj * HALF + n * 4); gv[bj][n] = (t + 1.0f) * scale; }
        if (in_f32) run<true, false>(acc, gv, row0, col0); else if (out_f32) run<false, true>(acc, gv, row0, col0); else run<false, false>(acc, gv, row0, col0);
    }
};
struct EpiProj {
    static constexpr bool PERM = false, AFTER_DRAIN = false;
    bf16_t* att; bf16_t* rw; bf16_t* cv;
    template <int LD, bool F16> __device__ __forceinline__ void put(const f32x4 (&acc)[2][2][4][2], bf16_t* base, int row0, int col0) const {
#pragma unroll
        for (int ai = 0; ai < 2; ++ai)
#pragma unroll
            for (int m = 0; m < 4; ++m) { bf16_t* rowp = base + (size_t)(row0 + ai * HALF + m * 16) * LD + col0;
#pragma unroll
                for (int bj = 0; bj < 2; ++bj)
#pragma unroll
                    for (int n = 0; n < 2; ++n) { const f32x4 v = acc[ai][bj][m][n]; uint2 o; o.x = F16 ? cvt_pk_f16(v[0], v[1]) : cvt_pk_bf16(v[0], v[1]); o.y = F16 ? cvt_pk_f16(v[2], v[3]) : cvt_pk_bf16(v[2], v[3]); *(uint2*)(rowp + bj * HALF + n * 16) = o; } }
    }
    __device__ __forceinline__ void operator()(const f32x4 (&acc)[2][2][4][2], const Unit& u, int wr, int wc, int fr, int fq) const {
        const int row0 = u.pm * BM + wr * 64 + fr, cl = wc * 32 + 4 * fq;
        if (u.pn >= 3 && u.pn < 7) put<1024, true>(acc, rw, row0, (u.pn - 3) * BM + cl);
        else put<768, false>(acc, u.pn < 3 ? att : cv, row0, (u.pn < 3 ? u.pn : u.pn - 7) * BM + cl);
    }
};
struct EpiAny {
    int kind; bool perm;
    EpiSwiglu sw; EpiResid rs; EpiProj pj;
    static constexpr bool AFTER_DRAIN = false;
    __device__ __forceinline__ void operator()(const f32x4 (&acc)[2][2][4][2], const Unit& u, int wr, int wc, int fr, int fq) const {
        if (kind == 0) sw(acc, u, wr, wc, fr, fq); else if (kind == 1) rs(acc, u, wr, wc, fr, fq); else pj(acc, u, wr, wc, fr, fq);
    }
};
}

#define LAS __attribute__((address_space(3)))
using pg8::bf16_t; using pg8::bf16x8; using pg8::f32x4; using pg8::u32x4; using pg8::cvt_pk_bf16; using pg8::cvt_pk_f16; using pg8::f16x2_to_f32; using pg8::f32x2_t;
constexpr int NTOK = 32768, SEQL = 4096, DM = 1024, DFF = 2816, DEPTH = 4;
constexpr int LDS_BYTES = 131072 + 64;
constexpr int PPL = 12;
constexpr int NPH = 1 + DEPTH * PPL;

constexpr size_t OFF_MOD = 0;
constexpr size_t OFF_LORA = OFF_MOD + 1179648;
constexpr size_t OFF_BONUS = OFF_LORA + 131072;
constexpr size_t OFF_WB = OFF_BONUS + 524288;
constexpr size_t WB_FFN1IN = 0, WB_FFN1OUT = 5767168, WB_MIXIN = WB_FFN1OUT + 2883584, WB_MIXOUT = WB_MIXIN + 2621440,
                 WB_FFN2IN = WB_MIXOUT + 1048576, WB_FFN2OUT = WB_FFN2IN + 5767168, WB_ELEMS = WB_FFN2OUT + 2883584;
constexpr size_t OFF_HN = OFF_WB + WB_ELEMS * 2;
constexpr size_t OFF_R1 = OFF_HN + (size_t)NTOK * 1024 * 2;
constexpr size_t R1_CONV = (size_t)NTOK * 768 * 2, R1_RWKV = 2 * R1_CONV, R1_BYTES = (size_t)NTOK * 2816 * 2;
constexpr size_t OFF_R2 = OFF_R1 + R1_BYTES;
constexpr int REC_B = 896;
constexpr size_t R2_G = (size_t)NTOK * 4 * REC_B;
constexpr size_t WS_BAR = OFF_R2 + R2_G + (size_t)NTOK * 256 * 2;
constexpr size_t OFF_WB2 = WS_BAR + 16384;
constexpr size_t OFF_LORA2 = OFF_WB2 + WB_ELEMS * 2;
constexpr size_t OFF_YS = OFF_LORA2 + 131072;
constexpr size_t OFF_HB = OFF_YS + (size_t)NTOK * 256 * 4;
constexpr size_t WS_END = OFF_HB + (size_t)NTOK * 1024 * 2;

struct Params { const float* in[28]; float* out; unsigned char* ws; int ph_lo, ph_hi; };

__device__ __forceinline__ float wave_sum(float v) {
#pragma unroll
    for (int o = 1; o < 64; o <<= 1) v += __shfl_xor(v, o);
    return v;
}
template <int CTRL> __device__ __forceinline__ float dpp_f(float x) { return __int_as_float(__builtin_amdgcn_update_dpp(0, __float_as_int(x), CTRL, 0xf, 0xf, true)); }
__device__ __forceinline__ float rowsum16(float x) {
    x += dpp_f<0x128>(x); x += dpp_f<0x124>(x); x += dpp_f<0x122>(x); x += dpp_f<0x121>(x); return x;
}
__device__ __forceinline__ float bflo(unsigned u) { return __uint_as_float(u << 16); }
__device__ __forceinline__ float bfhi(unsigned u) { return __uint_as_float(u & 0xffff0000u); }
__device__ __forceinline__ float sigmoid_f(float x) { return __builtin_amdgcn_rcpf(1.f + __builtin_amdgcn_exp2f(-1.44269504089f * x)); }

__device__ __forceinline__ void phase_mod(const Params& P, LAS unsigned char* lds, int tid, int wid, int lane, int bid, int nblk) {
    LAS float* cact = (LAS float*)lds;
    LAS float* red = (LAS float*)(lds + 32768);
    const float* c = P.in[1];
    float* MOD = (float*)(P.ws + OFF_MOD);
    for (int i = tid; i < 8192; i += 512) { const float v = c[i]; cact[i] = v / (1.f + __expf(-v)); }
    __syncthreads();
    for (int item = bid; item < 288; item += nblk) {
        const int l = item / 72, j0 = (item % 72) * 128, k0 = wid * 128;
        const float* W = P.in[2] + (size_t)l * 1024 * 9216 + j0 + 2 * lane;
        float a0[8], a1[8];
#pragma unroll
        for (int b = 0; b < 8; ++b) { a0[b] = 0.f; a1[b] = 0.f; }
#pragma unroll 8
        for (int k = 0; k < 128; ++k) {
            const float2 w = *(const float2*)(W + (size_t)(k0 + k) * 9216);
#pragma unroll
            for (int b = 0; b < 8; ++b) { const float ca = cact[b * 1024 + k0 + k]; a0[b] += ca * w.x; a1[b] += ca * w.y; }
        }
#pragma unroll
        for (int b = 0; b < 8; ++b) { red[(wid * 8 + b) * 128 + 2 * lane] = a0[b]; red[(wid * 8 + b) * 128 + 2 * lane + 1] = a1[b]; }
        __syncthreads();
        for (int o = tid; o < 1024; o += 512) {
            const int b = o >> 7, ci = o & 127; float s = 0.f;
#pragma unroll
            for (int w = 0; w < 8; ++w) s += red[(w * 8 + b) * 128 + ci];
            MOD[(size_t)(l * 8 + b) * 9216 + j0 + ci] = s + P.in[3][l * 9216 + j0 + ci];
        }
        __syncthreads();
    }
}

__device__ __forceinline__ void transpose_item(const float* W, int K, int N, bf16_t* WT, int k0, int n0, int drow0, LAS float* scr, int lane) {
#pragma unroll 8
    for (int i = 0; i < 32; ++i) { const int kk = 2 * i + (lane >> 5); scr[kk * 33 + (lane & 31)] = W[(size_t)(k0 + kk) * N + n0 + (lane & 31)]; }
    asm volatile("s_waitcnt lgkmcnt(0)" ::: "memory");
    const int c = lane & 7;
#pragma unroll
    for (int j = 0; j < 4; ++j) { const int n = (lane >> 3) + 8 * j; const LAS float* s = scr + (8 * c) * 33 + n;
        u32x4 o; o.x = cvt_pk_bf16(s[0 * 33], s[1 * 33]); o.y = cvt_pk_bf16(s[2 * 33], s[3 * 33]); o.z = cvt_pk_bf16(s[4 * 33], s[5 * 33]); o.w = cvt_pk_bf16(s[6 * 33], s[7 * 33]);
        *(u32x4*)(WT + (size_t)(drow0 + n) * K + k0 + 8 * c) = o; }
    asm volatile("s_waitcnt lgkmcnt(0)" ::: "memory");
}
__device__ __forceinline__ int swiglu_row(int n0) { return n0 < DFF ? ((n0 >> 7) * 256 + (n0 & 127)) : (((n0 - DFF) >> 7) * 256 + 128 + ((n0 - DFF) & 127)); }
__device__ __forceinline__ void phase_convert(const Params& P, int l, LAS unsigned char* lds, int wid, int lane, int bid, int nblk) {
    LAS float* scr = (LAS float*)(lds + wid * 8448);
    bf16_t* WB = (bf16_t*)(P.ws + ((l & 1) ? OFF_WB2 : OFF_WB));
    bf16_t* LT = (bf16_t*)(P.ws + ((l & 1) ? OFF_LORA2 : OFF_LORA));
    const int gw = bid * 8 + wid, NGW = nblk * 8;
    constexpr int I_IN = 16 * 176, I_OUT = 44 * 32, I_MI = 16 * 80, I_MO = 16 * 32;
    constexpr int NIT = 2 * I_IN + 2 * I_OUT + I_MI + I_MO + 32;
    for (int it = gw; it < NIT; it += NGW) {
        int r = it;
        if (r < I_IN) { const int kb = r / 176, nb = r % 176; transpose_item(P.in[5] + (size_t)l * 1024 * 5632, 1024, 5632, WB + WB_FFN1IN, kb * 64, nb * 32, swiglu_row(nb * 32), scr, lane); continue; } r -= I_IN;
        if (r < I_OUT) { const int kb = r / 32, nb = r % 32; transpose_item(P.in[6] + (size_t)l * 2816 * 1024, 2816, 1024, WB + WB_FFN1OUT, kb * 64, nb * 32, nb * 32, scr, lane); continue; } r -= I_OUT;
        if (r < I_MI) { const int kb = r / 80, nb = r % 80; transpose_item(P.in[8] + (size_t)l * 1024 * 2560, 1024, 2560, WB + WB_MIXIN, kb * 64, nb * 32, nb * 32, scr, lane); continue; } r -= I_MI;
        if (r < I_MO) { const int kb = r / 32, nb = r % 32; transpose_item(P.in[9] + (size_t)l * 1024 * 1024, 1024, 1024, WB + WB_MIXOUT, kb * 64, nb * 32, nb * 32, scr, lane); continue; } r -= I_MO;
        if (r < I_IN) { const int kb = r / 176, nb = r % 176; transpose_item(P.in[26] + (size_t)l * 1024 * 5632, 1024, 5632, WB + WB_FFN2IN, kb * 64, nb * 32, swiglu_row(nb * 32), scr, lane); continue; } r -= I_IN;
        if (r < I_OUT) { const int kb = r / 32, nb = r % 32; transpose_item(P.in[27] + (size_t)l * 2816 * 1024, 2816, 1024, WB + WB_FFN2OUT, kb * 64, nb * 32, nb * 32, scr, lane); continue; } r -= I_OUT;
        if (r < 8) { transpose_item(P.in[15] + (size_t)l * 64 * 256, 64, 256, LT, 0, r * 32, r * 32, scr, lane); continue; } r -= 8;
        if (r < 8) { transpose_item(P.in[17] + (size_t)l * 64 * 256, 64, 256, LT + 16384, 0, r * 32, r * 32, scr, lane); continue; } r -= 8;
        { const int kb = r / 8, nb = r % 8; transpose_item(P.in[18] + (size_t)l * 128 * 256, 128, 256, LT + 32768, kb * 64, nb * 32, nb * 32, scr, lane); }
    }
}

template <bool INF>
__device__ __forceinline__ void phase_norm(const Params& P, const void* hin, const float* gain, const float* modl  , int wid, int lane, int bid, int nblk) {
    bf16_t* HN = (bf16_t*)(P.ws + OFF_HN);
    for (int row0 = (bid * 8 + wid) * 4; row0 < NTOK; row0 += nblk * 32) {
        f32x4 v[4][4]; float ss[4];
#pragma unroll
        for (int r = 0; r < 4; ++r) {
            if (INF) { const f32x4* xr = (const f32x4*)((const float*)hin + (size_t)(row0 + r) * 1024) + lane;
#pragma unroll
                for (int j = 0; j < 4; ++j) v[r][j] = xr[64 * j]; }
            else { const uint2* xr = (const uint2*)((const bf16_t*)hin + (size_t)(row0 + r) * 1024) + lane;
#pragma unroll
                for (int j = 0; j < 4; ++j) { const uint2 u = xr[64 * j]; const pg8::f32x2_t a = pg8::f16x2_to_f32(u.x), c = pg8::f16x2_to_f32(u.y); v[r][j] = (f32x4){a[0], a[1], c[0], c[1]}; } }
        }
#pragma unroll
        for (int r = 0; r < 4; ++r) { float a = 0.f;
#pragma unroll
            for (int j = 0; j < 4; ++j) a += (v[r][j][0] * v[r][j][0] + v[r][j][1] * v[r][j][1]) + (v[r][j][2] * v[r][j][2] + v[r][j][3] * v[r][j][3]);
            ss[r] = a; }
#pragma unroll
        for (int o = 1; o < 64; o <<= 1) {
#pragma unroll
            for (int r = 0; r < 4; ++r) ss[r] += __shfl_xor(ss[r], o);
        }
        const float* sh = modl + (size_t)(row0 >> 12) * 9216; const float* sc = sh + 1024;
#pragma unroll
        for (int j = 0; j < 4; ++j) {
            const int col = lane * 4 + 256 * j;
            const f32x4 g = *(const f32x4*)(gain + col), s1 = *(const f32x4*)(sc + col), s0 = *(const f32x4*)(sh + col);
            const f32x4 gs = g * (s1 + 1.0f);
#pragma unroll
            for (int r = 0; r < 4; ++r) {
                const float rstd = rsqrtf(ss[r] * (1.f / 1024.f) + 1e-6f);
                const f32x4 y = v[r][j] * rstd * gs + s0;
                uint2 o; o.x = cvt_pk_bf16(y[0], y[1]); o.y = cvt_pk_bf16(y[2], y[3]);
                ((uint2*)(HN + (size_t)(row0 + r) * 1024) + lane)[64 * j] = o;
            }
        }
    }
}

__device__ __forceinline__ bf16x8 pack8(const float* f) {
    u32x4 o; o.x = cvt_pk_bf16(f[0], f[1]); o.y = cvt_pk_bf16(f[2], f[3]); o.z = cvt_pk_bf16(f[4], f[5]); o.w = cvt_pk_bf16(f[6], f[7]);
    return __builtin_bit_cast(bf16x8, o);
}
__device__ __forceinline__ void attn_item(const Params& P, int l, int item, LAS unsigned char* lds, int tid, int wid, int lane, int var) {
    const bf16_t* PA = (const bf16_t*)(P.ws + OFF_R1);
    bf16_t* Y = (bf16_t*)(P.ws + OFF_HN);
    const int b = item >> 6, n = (item >> 1) & 31, hk = item & 1;
    LAS bf16_t* Ks = (LAS bf16_t*)lds;
    LAS bf16_t* Vt = (LAS bf16_t*)(lds + 36864);
    const float* kg = P.in[11] + l * 64; const float* qg = P.in[10] + l * 64;
    {
        const int row = tid >> 1, half = tid & 1, kt = n * 128 - 128 + row;
        u32x4 kv[4], vv[4];
        if (kt >= 0) {
            const bf16_t* src = PA + (size_t)(b * SEQL + kt) * 768 + 512 + hk * 64 + half * 32;
#pragma unroll
            for (int i = 0; i < 4; ++i) { kv[i] = ((const u32x4*)src)[i]; vv[i] = ((const u32x4*)(src + 128))[i]; }
        } else {
#pragma unroll
            for (int i = 0; i < 4; ++i) { kv[i] = (u32x4){0u, 0u, 0u, 0u}; vv[i] = (u32x4){0u, 0u, 0u, 0u}; }
        }
        float kf[32]; float ss = 0.f;
#pragma unroll
        for (int i = 0; i < 4; ++i)
#pragma unroll
            for (int j = 0; j < 4; ++j) { const float a = bflo(kv[i][j]), c = bfhi(kv[i][j]); kf[i * 8 + 2 * j] = a; kf[i * 8 + 2 * j + 1] = c; ss += a * a + c * c; }
        ss += __shfl_xor(ss, 1);
        const float rstd = rsqrtf(ss * (1.f / 64.f) + 1e-6f);
#pragma unroll
        for (int i = 0; i < 32; ++i) kf[i] *= rstd * kg[half * 32 + i];
#pragma unroll
        for (int i = 0; i < 4; ++i) *(LAS bf16x8*)(Ks + row * 72 + half * 32 + i * 8) = pack8(kf + i * 8);
        const int r32 = row & 31, kp = (row & ~31) + ((r32 & 15) >> 2) * 8 + (r32 >> 4) * 4 + (r32 & 3);
#pragma unroll
        for (int i = 0; i < 4; ++i)
#pragma unroll
            for (int j = 0; j < 4; ++j) { const unsigned w = vv[i][j]; Vt[(half * 32 + i * 8 + 2 * j) * 264 + kp] = (bf16_t)(w & 0xffffu); Vt[(half * 32 + i * 8 + 2 * j + 1) * 264 + kp] = (bf16_t)(w >> 16); }
    }
    __syncthreads();
    const int fr = lane & 15, fq = lane >> 4, hq = hk * 4 + (wid >> 1);
    const float sink = P.in[12][l * 8 + hq];
    for (int i = 0; i < 4; ++i) {
        if (var == 1) { asm volatile("s_waitcnt vmcnt(0) lgkmcnt(0)" ::: "memory"); __syncthreads(); }
        const int q0 = ((wid & 1) * 4 + i) * 16, kb0 = q0 >> 5;
        const bf16_t* qp = PA + (size_t)(b * SEQL + n * 128 + q0 + fr) * 768 + hq * 64 + fq * 8;
        const u32x4 qa = *(const u32x4*)qp, qb = *(const u32x4*)(qp + 32);
        float qf[16]; float ss = 0.f;
#pragma unroll
        for (int j = 0; j < 4; ++j) { qf[2 * j] = bflo(qa[j]); qf[2 * j + 1] = bfhi(qa[j]); qf[8 + 2 * j] = bflo(qb[j]); qf[8 + 2 * j + 1] = bfhi(qb[j]); }
#pragma unroll
        for (int j = 0; j < 16; ++j) ss += qf[j] * qf[j];
        ss += __shfl_xor(ss, 16); ss += __shfl_xor(ss, 32);
        const float rstd = rsqrtf(ss * (1.f / 64.f) + 1e-6f) * 0.125f;
#pragma unroll
        for (int j = 0; j < 8; ++j) { qf[j] *= rstd * qg[fq * 8 + j]; qf[8 + j] *= rstd * qg[32 + fq * 8 + j]; }
        const bf16x8 Q0 = pack8(qf), Q1 = pack8(qf + 8);
        f32x4 s[10];
#pragma unroll
        for (int tt = 0; tt < 10; ++tt) {
            const LAS bf16_t* kr = Ks + ((2 * kb0 + tt) * 16 + fr) * 72 + fq * 8;
            const bf16x8 K0 = *(const LAS bf16x8*)kr, K1 = *(const LAS bf16x8*)(kr + 32);
            f32x4 z = (f32x4){0.f, 0.f, 0.f, 0.f};
            z = __builtin_amdgcn_mfma_f32_16x16x32_bf16(K0, Q0, z, 0, 0, 0);
            s[tt] = __builtin_amdgcn_mfma_f32_16x16x32_bf16(K1, Q1, z, 0, 0, 0);
        }
        if (var == 3) {
#pragma unroll
            for (int tt = 0; tt < 10; ++tt) s[tt] = (f32x4){0.25f, 0.5f, 0.125f, 0.375f};
        }
        const int qi = q0 + fr;
        float m = sink;
#pragma unroll
        for (int tt = 0; tt < 10; ++tt)
#pragma unroll
            for (int j = 0; j < 4; ++j) {
                const int kidx = (2 * kb0 + tt) * 16 + fq * 4 + j;
                const bool vis = (kidx > qi) && (kidx <= qi + 128) && (n > 0 || kidx >= 128);
                const float sv = vis ? s[tt][j] : -INFINITY; s[tt][j] = sv; m = fmaxf(m, sv);
            }
        m = fmaxf(m, __shfl_xor(m, 16)); m = fmaxf(m, __shfl_xor(m, 32));
        float sum = 0.f;
#pragma unroll
        for (int tt = 0; tt < 10; ++tt)
#pragma unroll
            for (int j = 0; j < 4; ++j) { const float p = __expf(s[tt][j] - m); s[tt][j] = p; sum += p; }
        sum += __shfl_xor(sum, 16); sum += __shfl_xor(sum, 32);
        sum += __expf(sink - m);
        const float inv = 1.f / sum;
        f32x4 o[4];
#pragma unroll
        for (int dt = 0; dt < 4; ++dt) o[dt] = (f32x4){0.f, 0.f, 0.f, 0.f};
        if (var == 2) {
#pragma unroll
            for (int dt = 0; dt < 4; ++dt) o[dt] = s[dt] + s[4 + dt] + s[(8 + dt) > 9 ? 9 : 8 + dt];
        } else
        {
#pragma unroll
        for (int kb = 0; kb < 5; ++kb) {
            float pf[8];
#pragma unroll
            for (int j = 0; j < 4; ++j) { pf[j] = s[2 * kb][j] * inv; pf[4 + j] = s[2 * kb + 1][j] * inv; }
            const bf16x8 Pf = pack8(pf);
#pragma unroll
            for (int dt = 0; dt < 4; ++dt) {
                const bf16x8 Vf = *(const LAS bf16x8*)(Vt + (dt * 16 + fr) * 264 + (kb0 + kb) * 32 + fq * 8);
                o[dt] = __builtin_amdgcn_mfma_f32_16x16x32_bf16(Pf, Vf, o[dt], 0, 0, 0);
            }
        }
        }
#pragma unroll
        for (int dt = 0; dt < 4; ++dt)
#pragma unroll
            for (int j = 0; j < 4; ++j)
                Y[(size_t)(b * SEQL + n * 128 + q0 + fq * 4 + j) * 1024 + hq * 64 + dt * 16 + fr] = (bf16_t)(cvt_pk_bf16(o[dt][j], 0.f) & 0xffffu);
    }
    __syncthreads();
}

__device__ __forceinline__ void conv_part(const Params& P, int l, int tid, int bid, int nblk) {
    const bf16_t* PC = (const bf16_t*)(P.ws + OFF_R1 + R1_CONV);
    bf16_t* Y = (bf16_t*)(P.ws + OFF_HN);
    const float* cw = P.in[24] + l * 768;
    for (int idx = bid * 512 + tid; idx < NTOK * 32; idx += nblk * 512) {
        const int tok = idx >> 5, c = (idx & 31) * 8, t = tok & (SEQL - 1);
        const bf16_t* p = PC + (size_t)tok * 768 + c;
        const u32x4 bg = *(const u32x4*)p;
        float u[3][8];
#pragma unroll
        for (int d = 0; d < 3; ++d) {
            if (t >= d) { const u32x4 cg4 = *(const u32x4*)(p - d * 768 + 256), hg = *(const u32x4*)(p - d * 768 + 512);
#pragma unroll
                for (int j = 0; j < 4; ++j) { u[d][2 * j] = bflo(cg4[j]) * bflo(hg[j]); u[d][2 * j + 1] = bfhi(cg4[j]) * bfhi(hg[j]); }
            } else {
#pragma unroll
                for (int j = 0; j < 8; ++j) u[d][j] = 0.f;
            }
        }
        float y[8];
#pragma unroll
        for (int j = 0; j < 8; ++j) {
            const float bgv = (j & 1) ? bfhi(bg[j >> 1]) : bflo(bg[j >> 1]);
            y[j] = bgv * (cw[c + j] * u[2][j] + cw[256 + c + j] * u[1][j] + cw[512 + c + j] * u[0][j]);
        }
        *(bf16x8*)(Y + (size_t)tok * 1024 + 768 + c) = pack8(y);
    }
}

template <int MODE>
__device__ __forceinline__ void prep_tile(const Params& P, int l, int tile, LAS unsigned char* lds, int tid, int wid, int lane) {
    const bf16_t* PR = (const bf16_t*)(P.ws + OFF_R1 + R1_RWKV);
    unsigned char* REC = P.ws + OFF_R2;
    bf16_t* G = (bf16_t*)(P.ws + OFF_R2 + R2_G);
    float* BON = (float*)(P.ws + OFF_BONUS);
    LAS bf16_t* Xs = (LAS bf16_t*)lds;
    const float* mu = P.in[13] + l * 1024;
    const int tok0 = tile * 64;
    {
        const int t = tid >> 3, seg = tid & 7, tok = tok0 + t; const bool first = (tok & (SEQL - 1)) == 0;
        const bf16_t* p = PR + (size_t)tok * 1024 + 768 + seg * 32;
        const float c1 = seg < 2 ? 2.f : 1.f, c2 = seg < 2 ? 2.f : 1.f, c3 = seg < 2 ? -1.f : 0.f; const bool ident = (seg == 2 || seg == 3);
        if ((MODE == 0) == (seg < 4)) {
#pragma unroll
        for (int i = 0; i < 4; ++i) {
            float xo[8];
            const u32x4 ca = ((const u32x4*)p)[i], cp = first ? (u32x4){0u, 0u, 0u, 0u} : ((const u32x4*)(p - 1024))[i];
#pragma unroll
            for (int hh = 0; hh < 2; ++hh) {
                const f32x2_t a01 = f16x2_to_f32(ca[2 * hh]), a23 = f16x2_to_f32(ca[2 * hh + 1]), p01 = f16x2_to_f32(cp[2 * hh]), p23 = f16x2_to_f32(cp[2 * hh + 1]);
                const f32x4 a = (f32x4){a01[0], a01[1], a23[0], a23[1]};
                const f32x4 pv = (f32x4){p01[0], p01[1], p23[0], p23[1]};
                const f32x4 m = ((const f32x4*)(mu + 768 + seg * 32))[2 * i + hh];
                const f32x4 x = a + m * (pv - a);
#pragma unroll
                for (int j = 0; j < 4; ++j) { const float sg = sigmoid_f(c1 * x[j]) * c2 + c3; xo[hh * 4 + j] = ident ? x[j] : sg; }
            }
            *(LAS bf16x8*)(Xs + t * 264 + seg * 32 + i * 8) = pack8(xo);
        }
        }
    }
    __syncthreads();
    const int fr = lane & 15, fq = lane >> 4, hh = wid & 3;
    const bf16_t* WTw = (const bf16_t*)(P.ws + ((l & 1) ? OFF_LORA2 : OFF_LORA)); const bf16_t* WTa = WTw + 16384; const bf16_t* WTg = WTw + 32768;
    const float* w0 = P.in[14] + l * 256; const float* a0 = P.in[16] + l * 256; const float* k_k = P.in[19] + l * 256;
    const float* k_a = P.in[20] + l * 256; const float* r_k = P.in[21] + l * 256;
#pragma unroll
    for (int ti = 0; ti < 2; ++ti) {
        const int tq = (wid >> 2) * 2 + ti;
        bf16x8 xb[8];
#pragma unroll
        for (int ks = (MODE == 0 ? 0 : 4); ks < (MODE == 0 ? 4 : 8); ++ks) xb[ks] = *(const LAS bf16x8*)(Xs + (tq * 16 + fr) * 264 + ks * 32 + fq * 8);
        f32x4 aw[4], aa[4], ag[4];
#pragma unroll
        for (int ct = 0; ct < 4; ++ct) {
            const int col = hh * 64 + ct * 16 + fr;
            f32x4 z = (f32x4){0.f, 0.f, 0.f, 0.f};
            if (MODE == 0) {
#pragma unroll
            for (int ks = 0; ks < 2; ++ks) z = __builtin_amdgcn_mfma_f32_16x16x32_bf16(*(const bf16x8*)(WTw + col * 64 + ks * 32 + fq * 8), xb[ks], z, 0, 0, 0);
            aw[ct] = z; z = (f32x4){0.f, 0.f, 0.f, 0.f};
#pragma unroll
            for (int ks = 0; ks < 2; ++ks) z = __builtin_amdgcn_mfma_f32_16x16x32_bf16(*(const bf16x8*)(WTa + col * 64 + ks * 32 + fq * 8), xb[2 + ks], z, 0, 0, 0);
            aa[ct] = z; z = (f32x4){0.f, 0.f, 0.f, 0.f};
            } else {
#pragma unroll
            for (int ks = 0; ks < 4; ++ks) z = __builtin_amdgcn_mfma_f32_16x16x32_bf16(*(const bf16x8*)(WTg + col * 128 + ks * 32 + fq * 8), xb[4 + ks], z, 0, 0, 0);
            ag[ct] = z;
            }
        }
        const int tok = tok0 + tq * 16 + fr; const bool first = (tok & (SEQL - 1)) == 0;
        if (MODE == 1) {
#pragma unroll
            for (int ct = 0; ct < 4; ++ct) { const int c4 = hh * 64 + ct * 16 + fq * 4; uint2 go; go.x = cvt_pk_f16(ag[ct][0], ag[ct][1]); go.y = cvt_pk_f16(ag[ct][2], ag[ct][3]);
                *(uint2*)(G + (size_t)tok * 256 + c4) = go; }
            continue;
        }
        const bf16_t* pr = PR + (size_t)tok * 1024;
        unsigned char* rec = REC + ((size_t)tok * 4 + hh) * REC_B;
        f32x4 kkv[4], av[4]; float ss = 0.f, bon = 0.f;
        uint2 cur[4][3], prv[4][3];
#pragma unroll
        for (int ct = 0; ct < 4; ++ct)
#pragma unroll
            for (int q = 0; q < 3; ++q) {
                const int c4 = hh * 64 + ct * 16 + fq * 4;
                cur[ct][q] = *(const uint2*)(pr + q * 256 + c4);
                prv[ct][q] = first ? (uint2){0u, 0u} : *(const uint2*)(pr - 1024 + q * 256 + c4);
            }
#pragma unroll
        for (int ct = 0; ct < 4; ++ct) {
            const int c4 = hh * 64 + ct * 16 + fq * 4, lo = ct * 16 + fq * 4;
            f32x4 x3[3];
#pragma unroll
            for (int q = 0; q < 3; ++q) {
                const f32x4 m = *(const f32x4*)(mu + q * 256 + c4);
                const uint2 cu = cur[ct][q], pu = prv[ct][q];
                const f32x2_t c01 = f16x2_to_f32(cu.x), c23 = f16x2_to_f32(cu.y), q01 = f16x2_to_f32(pu.x), q23 = f16x2_to_f32(pu.y);
                const f32x4 cf = (f32x4){c01[0], c01[1], c23[0], c23[1]}, pf = (f32x4){q01[0], q01[1], q23[0], q23[1]};
                x3[q] = cf + m * (pf - cf);
            }
            const f32x4 r4 = x3[0], k4 = x3[1], v4 = x3[2];
            const f32x4 w0v = *(const f32x4*)(w0 + c4), a0v = *(const f32x4*)(a0 + c4), kkw = *(const f32x4*)(k_k + c4), kaw = *(const f32x4*)(k_a + c4), rkw = *(const f32x4*)(r_k + c4);
            f32x4 dec, a4, kp;
#pragma unroll
            for (int j = 0; j < 4; ++j) {
                const float w = w0v[j] + aw[ct][j];
                dec[j] = __builtin_amdgcn_exp2f((-0.6065306597126334f * 1.4426950408889634f) * sigmoid_f(w));
                a4[j] = sigmoid_f(a0v[j] + aa[ct][j]);
            }
            kkv[ct] = k4 * kkw; av[ct] = a4;
            kp = k4 * ((a4 - 1.0f) * kaw + 1.0f);
#pragma unroll
            for (int j = 0; j < 4; ++j) { ss += kkv[ct][j] * kkv[ct][j]; bon += r4[j] * kp[j] * rkw[j]; }
            *(f32x4*)(rec + lo * 4) = dec;
            { uint2 t; t.x = cvt_pk_f16(r4[0], r4[1]); t.y = cvt_pk_f16(r4[2], r4[3]); *(uint2*)(rec + 256 + 0 * 128 + lo * 2) = t;
              t.x = cvt_pk_f16(kp[0], kp[1]); t.y = cvt_pk_f16(kp[2], kp[3]); *(uint2*)(rec + 256 + 1 * 128 + lo * 2) = t;
              t.x = cvt_pk_f16(v4[0], v4[1]); t.y = cvt_pk_f16(v4[2], v4[3]); *(uint2*)(rec + 256 + 2 * 128 + lo * 2) = t; }
        }
        ss += __shfl_xor(ss, 16); ss += __shfl_xor(ss, 32); bon += __shfl_xor(bon, 16); bon += __shfl_xor(bon, 32);
        const float rn = ss > 1e-24f ? __builtin_amdgcn_rsqf(ss) : 1e12f;
#pragma unroll
        for (int ct = 0; ct < 4; ++ct) { const int lo = ct * 16 + fq * 4; const f32x4 kk = kkv[ct] * rn, ka = kk * av[ct]; uint2 t;
            t.x = cvt_pk_f16(kk[0], kk[1]); t.y = cvt_pk_f16(kk[2], kk[3]); *(uint2*)(rec + 256 + 3 * 128 + lo * 2) = t;
            t.x = cvt_pk_f16(ka[0], ka[1]); t.y = cvt_pk_f16(ka[2], ka[3]); *(uint2*)(rec + 256 + 4 * 128 + lo * 2) = t; }
        if (fq == 0) BON[(size_t)tok * 4 + hh] = bon;
    }
    __syncthreads();
}

__device__ __forceinline__ void scan_stage_piece(LAS float* buf, int idx, u32x4 w) {
    const int s = idx / 56, o = idx % 56;
    if (o < 16) { *(LAS u32x4*)(buf + s * 384 + 64 + o * 4) = w; }
    else {
        const int p = o - 16, q = p >> 3, j = p & 7, dq = q == 0 ? 0 : q + 1;
        LAS float* d = buf + s * 384 + dq * 64 + j * 8;
        const f32x2_t e0 = f16x2_to_f32(w[0]), e1 = f16x2_to_f32(w[1]), e2 = f16x2_to_f32(w[2]), e3 = f16x2_to_f32(w[3]);
        *(LAS f32x4*)d = (f32x4){e0[0], e0[1], e1[0], e1[1]};
        *(LAS f32x4*)(d + 4) = (f32x4){e2[0], e2[1], e3[0], e3[1]};
    }
}
__device__ __forceinline__ void phase_scan(const Params& P, LAS unsigned char* lds, int tid, int wid, int lane, int bid, int nblk) {
    const unsigned char* REC = P.ws + OFF_R2;
    float* YS = (float*)(P.ws + OFF_YS);
    for (int item = bid; item < 128; item += nblk) {
        const int bh = (item & 7) * 4 + ((item >> 3) & 3), rg = item >> 5, b = bh >> 2, h = bh & 3;
        const unsigned char* src0 = REC + ((size_t)(b * SEQL) * 4 + h) * REC_B;
        u32x4 st[7]; const int ltid = tid - 256;
        if (wid >= 4) {
#pragma unroll
            for (int i = 0; i < 7; ++i) { const int idx = ltid + 256 * i, s = idx / 56, o = idx % 56; st[i] = *(const u32x4*)(src0 + (size_t)s * (4 * REC_B) + o * 16); }
#pragma unroll
            for (int i = 0; i < 7; ++i) scan_stage_piece((LAS float*)lds, ltid + 256 * i, st[i]);
        }
        __syncthreads();
        typedef float f32x2v __attribute__((ext_vector_type(2)));
        f32x2v Sa = {0.f, 0.f}, Sb = {0.f, 0.f};
        const int rl = lane >> 4, kq = lane & 15, row = rg * 16 + (wid & 3) * 4 + rl;
        for (int ch = 0; ch < 128; ++ch) {
            if (wid >= 4 && ch + 1 < 128) {
#pragma unroll
                for (int i = 0; i < 7; ++i) { const int idx = ltid + 256 * i, s = idx / 56, o = idx % 56; st[i] = *(const u32x4*)(src0 + (size_t)((ch + 1) * 32 + s) * (4 * REC_B) + o * 16); }
            }
            if (wid < 4) {
                const LAS float* buf = (const LAS float*)(lds + (ch & 1) * 49152);
                float* yp = YS + (size_t)(b * SEQL + ch * 32 + kq) * 256 + h * 64 + row;
                const LAS float* rc = buf + kq * 4;
                const LAS float* rv = buf + 192 + row;
                f32x4 r4 = *(const LAS f32x4*)(rc), w4 = *(const LAS f32x4*)(rc + 64), k4 = *(const LAS f32x4*)(rc + 128), kk4 = *(const LAS f32x4*)(rc + 256), ka4 = *(const LAS f32x4*)(rc + 320);
                float v = rv[0];
                float oacc = 0.f;
#define LO2(x) __builtin_shufflevector(x, x, 0, 1)
#define HI2(x) __builtin_shufflevector(x, x, 2, 3)
#pragma unroll
                for (int s = 0; s < 32; ++s) {
                    f32x4 nr4 = r4, nw4 = w4, nk4 = k4, nkk4 = kk4, nka4 = ka4; float nv = v;
                    if (s + 1 < 32) {
                        const LAS float* rn = rc + (s + 1) * 384;
                        nr4 = *(const LAS f32x4*)(rn); nw4 = *(const LAS f32x4*)(rn + 64); nk4 = *(const LAS f32x4*)(rn + 128); nkk4 = *(const LAS f32x4*)(rn + 256); nka4 = *(const LAS f32x4*)(rn + 320);
                        nv = rv[(s + 1) * 384];
                    }
                    f32x2v d2 = Sa * LO2(kk4); d2 = Sb * HI2(kk4) + d2;
                    const float d = rowsum16(d2[0] + d2[1]);
                    const f32x2v vv = {v, v}, dd = {d, d};
                    f32x2v ta = Sa * LO2(w4), tb = Sb * HI2(w4);
                    ta = vv * LO2(k4) + ta; tb = vv * HI2(k4) + tb;
                    Sa = ta - dd * LO2(ka4); Sb = tb - dd * HI2(ka4);
                    f32x2v o2 = Sa * LO2(r4); o2 = Sb * HI2(r4) + o2;
                    const float o = rowsum16(o2[0] + o2[1]);
                    oacc = (kq == (s & 15)) ? o : oacc;
                    if ((s & 15) == 15) yp[(size_t)(s - 15) * 256] = oacc;
                    r4 = nr4; w4 = nw4; k4 = nk4; kk4 = nkk4; ka4 = nka4; v = nv;
                }
#undef LO2
#undef HI2
            }
            if (wid >= 4 && ch + 1 < 128) {
#pragma unroll
                for (int i = 0; i < 7; ++i) scan_stage_piece((LAS float*)(lds + ((ch + 1) & 1) * 49152), ltid + 256 * i, st[i]);
            }
            __syncthreads();
        }
    }
}

__device__ __forceinline__ void phase_post(const Params& P, int l, int tid, int bid, int nblk) {
    const float* YS = (const float*)(P.ws + OFF_YS);
    const unsigned char* REC = P.ws + OFF_R2;
    const bf16_t* G = (const bf16_t*)(P.ws + OFF_R2 + R2_G);
    const float* BON = (const float*)(P.ws + OFF_BONUS);
    bf16_t* Y = (bf16_t*)(P.ws + OFF_HN);
    const float* gw = P.in[22] + l * 256; const float* gb = P.in[23] + l * 256;
    const int stride = nblk * 512;
    for (int base = bid * 512 + tid; base < NTOK * 64; base += 4 * stride) {
        f32x4 y[4]; uint2 vu[4], gg[4]; float bon[4];
#pragma unroll
        for (int j = 0; j < 4; ++j) {
            const int idx = base + j * stride;
            if (idx < NTOK * 64) {
                const int l16 = idx & 15, th = idx >> 4, tok = th >> 2, h = th & 3, c = h * 64 + l16 * 4;
                y[j] = *(const f32x4*)(YS + (size_t)tok * 256 + c);
                vu[j] = *(const uint2*)(REC + ((size_t)tok * 4 + h) * REC_B + 256 + 2 * 128 + l16 * 8);
                gg[j] = *(const uint2*)(G + (size_t)tok * 256 + c);
                bon[j] = BON[(size_t)tok * 4 + h];
            }
        }
#pragma unroll
        for (int j = 0; j < 4; ++j) {
            const int idx = base + j * stride;
            if (idx < NTOK * 64) {
                const int l16 = idx & 15, th = idx >> 4, tok = th >> 2, h = th & 3, c = h * 64 + l16 * 4;
                const float mean = rowsum16((y[j][0] + y[j][1]) + (y[j][2] + y[j][3])) * (1.f / 64.f);
                const f32x4 d = y[j] - mean;
                const float var = rowsum16((d[0] * d[0] + d[1] * d[1]) + (d[2] * d[2] + d[3] * d[3])) * (1.f / 64.f);
                const float rs = rsqrtf(var + 64e-5f);
                const f32x2_t v01 = f16x2_to_f32(vu[j].x), v23 = f16x2_to_f32(vu[j].y), g01 = f16x2_to_f32(gg[j].x), g23 = f16x2_to_f32(gg[j].y);
                const f32x4 v4 = (f32x4){v01[0], v01[1], v23[0], v23[1]}, g4 = (f32x4){g01[0], g01[1], g23[0], g23[1]};
                const f32x4 o = ((d * rs) * *(const f32x4*)(gw + c) + *(const f32x4*)(gb + c) + v4 * bon[j]) * g4;
                uint2 ov; ov.x = cvt_pk_bf16(o[0], o[1]); ov.y = cvt_pk_bf16(o[2], o[3]);
                *(uint2*)(Y + (size_t)tok * 1024 + 512 + c) = ov;
            }
        }
    }
}

#define XB_TMO      128
#define XB_XCNT(j)  (256  + 64 * (j))
#define XB_XSUB(j)  (1280 + 64 * (j))
#define XB_XGEN(j)  (2304 + 64 * (j))
#define XB_TOP      3328
#define XB_TOPGEN   3392
#define XCD_BAR_WORDS 3456
#define XB_SPIN_CAP (1u << 18)

__device__ __forceinline__ unsigned xb_ld(unsigned* p)              { return __hip_atomic_load(p, __ATOMIC_RELAXED, __HIP_MEMORY_SCOPE_AGENT); }
__device__ __forceinline__ unsigned xb_add(unsigned* p, unsigned v) { return __hip_atomic_fetch_add(p, v, __ATOMIC_RELAXED, __HIP_MEMORY_SCOPE_AGENT); }
__device__ __forceinline__ unsigned xb_xcc_id() { return (unsigned)__builtin_amdgcn_s_getreg((3 << 11) | 20) & 0xFu; }
#define XB_SPIN(cond, bar) do { unsigned _sp = 0; while (cond) { __builtin_amdgcn_s_sleep(1); \
    if ((++_sp & 255u) == 0u) { if (xb_ld(&(bar)[XB_TMO])) break; if (_sp > XB_SPIN_CAP) { atomicAdd(&(bar)[XB_TMO], 1u); break; } } } } while (0)

struct XcdBarrier {
    unsigned* bar; unsigned x;
    volatile LAS unsigned* st;
};

__device__ __forceinline__ XcdBarrier xcd_barrier_post(unsigned* bar, volatile LAS unsigned* st) {
    XcdBarrier b; b.bar = bar; b.x = xb_xcc_id(); b.st = st;
    if (threadIdx.x == 0) (void)xb_add(&bar[XB_XCNT(b.x)], 1u);
    return b;
}
__device__ __forceinline__ void xcd_barrier_complete(unsigned* bar, unsigned x, unsigned& nloc, unsigned& nx) {
    const unsigned G = gridDim.x * gridDim.y * gridDim.z;
    unsigned sum, cnt, mine, sp = 0u;
    for (;;) {
        sum = 0u; cnt = 0u; mine = 0u;
#pragma unroll
        for (unsigned j = 0; j < 16; ++j) { const unsigned c = xb_ld(&bar[XB_XCNT(j)]); sum += c; cnt += (c > 0u) ? 1u : 0u; mine = (j == x) ? c : mine; }
        if (sum == G) break;
        __builtin_amdgcn_s_sleep(1);
        if ((++sp & 255u) == 0u) { if (xb_ld(&bar[XB_TMO])) break; if (sp > XB_SPIN_CAP) { atomicAdd(&bar[XB_TMO], 1u); break; } }
    }
    nloc = mine > 0u ? mine : 1u; nx = cnt > 0u ? cnt : 1u;
}

__device__ __forceinline__ void xcd_barrier(const XcdBarrier& b) {
    asm volatile("s_waitcnt vmcnt(0)" ::: "memory");
    __syncthreads();
    if (threadIdx.x == 0) {
        unsigned* bar = b.bar;
        __builtin_amdgcn_s_waitcnt(0);
        unsigned nloc = b.st[0], nx = b.st[1];
        if (nloc == 0u) { xcd_barrier_complete(bar, b.x, nloc, nx); b.st[0] = nloc; b.st[1] = nx; }
        const unsigned old = xb_add(&bar[XB_XSUB(b.x)], 1u);
        const unsigned gen = old / nloc;
        if (old + 1u == (gen + 1u) * nloc) {
            __builtin_amdgcn_fence(__ATOMIC_RELEASE, "agent");
            asm volatile("s_waitcnt vmcnt(0)" ::: "memory");
            const unsigned og = xb_add(&bar[XB_TOP], 1u);
            const unsigned tg = og / nx;
            if (og + 1u == (tg + 1u) * nx) xb_add(&bar[XB_TOPGEN], 1u);
            else XB_SPIN(xb_ld(&bar[XB_TOPGEN]) == tg, bar);
            __builtin_amdgcn_fence(__ATOMIC_ACQUIRE, "agent");
            xb_add(&bar[XB_XGEN(b.x)], 1u);
            asm volatile("s_waitcnt vmcnt(0)" ::: "memory");
        } else {
            XB_SPIN(xb_ld(&bar[XB_XGEN(b.x)]) == gen, bar);
            __builtin_amdgcn_fence(__ATOMIC_ACQUIRE, "agent");
            asm volatile("s_waitcnt vmcnt(0)" ::: "memory");
        }
    }
    __syncthreads();
}


__global__ __launch_bounds__(512, 2) void mega(Params P) {
    extern __shared__ __attribute__((aligned(16))) unsigned char shm[];
    LAS unsigned char* lds = (LAS unsigned char*)shm;
    const int nblk = gridDim.x;
    volatile LAS unsigned* bst = (volatile LAS unsigned*)(lds + 131072);
    if (threadIdx.x < 2) bst[threadIdx.x] = 0u;
    __syncthreads();
    const XcdBarrier xbar = xcd_barrier_post((unsigned*)(P.ws + WS_BAR), bst);
    float* MOD = (float*)(P.ws + OFF_MOD);
    bf16_t* HN = (bf16_t*)(P.ws + OFF_HN);
    bf16_t* ACT = (bf16_t*)(P.ws + OFF_R1);
#ifdef DIAG_TIME
    unsigned long long tA = 0, tB = 0, tprev = __builtin_amdgcn_s_memrealtime();
#endif
    for (int ph = P.ph_lo; ph < P.ph_hi; ++ph) {
#ifdef DBL_PHASE
      for (int rep = (ph > 0 && DBL_PHASE((ph - 1) % PPL)) ? 0 : 1; rep < 2; ++rep) {
#endif
        int tid = threadIdx.x, bid = blockIdx.x;
        asm volatile("" : "+v"(tid)); asm volatile("" : "+s"(bid));
        const int wid = __builtin_amdgcn_readfirstlane(tid >> 6), lane = tid & 63;
        if (ph == 0) {
#ifndef NO_MOD
            phase_mod(P, lds, tid, wid, lane, bid, nblk);
#endif
            phase_convert(P, 0, lds, wid, lane, bid, nblk);
#ifdef DIAG_POISON
            { u32x4* w = (u32x4*)(P.ws + OFF_LORA); const size_t n16 = (WS_END - OFF_LORA) / 16;
              for (size_t i = (size_t)bid * 512 + tid; i < n16; i += (size_t)nblk * 512) w[i] = (u32x4){0xAAAAAAAAu, 0xAAAAAAAAu, 0xAAAAAAAAu, 0xAAAAAAAAu}; }
#endif
        } else {
            const int l = (ph - 1) / PPL, s = (ph - 1) % PPL;
            bf16_t* HB = (bf16_t*)(P.ws + OFF_HB);
            const bool first_h = (l == 0 && s < 3), last_h = (l == DEPTH - 1 && s == PPL - 1);
            const void* hin = first_h ? (const void*)P.in[0] : (const void*)HB;
            void* hout = last_h ? (void*)P.out : (void*)HB;
            const float* modl = MOD + (size_t)l * 8 * 9216;
            bf16_t* WB = (bf16_t*)(P.ws + ((l & 1) ? OFF_WB2 : OFF_WB));
            pg8::Gemm g{HN, WB, NTOK, 1024, 1024}; pg8::EpiAny E{}; bool is_gemm = true;
            switch (s) {
            case 0:
#ifndef NO_NORM
                if (first_h) phase_norm<true>(P, hin, P.in[4] + l * 1024, modl, wid, lane, bid, nblk); else phase_norm<false>(P, hin, P.in[4] + l * 1024, modl, wid, lane, bid, nblk);
#endif
                is_gemm = false; break;
            case 1: g.Bt = WB + WB_FFN1IN; g.N = 2 * DFF; E.kind = 0; E.perm = true; E.sw.O = ACT; break;
            case 2: g.A = ACT; g.Bt = WB + WB_FFN1OUT; g.K = DFF; E.kind = 1; E.perm = true; E.rs = pg8::EpiResid{hin, hout, modl + 2 * 1024, 0.5f, first_h ? 1 : 0, last_h ? 1 : 0}; break;
            case 3: phase_norm<false>(P, hin, P.in[7] + l * 1024, modl + 3 * 1024, wid, lane, bid, nblk); is_gemm = false; break;
            case 4: g.Bt = WB + WB_MIXIN; g.N = 2560; E.kind = 2; E.pj = pg8::EpiProj{(bf16_t*)(P.ws + OFF_R1), (bf16_t*)(P.ws + OFF_R1 + R1_RWKV), (bf16_t*)(P.ws + OFF_R1 + R1_CONV)}; break;
            case 5:
                for (int it = bid; it < 512; it += nblk) prep_tile<0>(P, l, it, lds, tid, wid, lane);
                is_gemm = false; break;
            case 6: {
                const int nscan = nblk >> 1;
                if (bid < nscan) phase_scan(P, lds, tid, wid, lane, bid, nscan);
                else {
                    const int vb = bid - nscan, vn = nblk - nscan;
                    for (int it = vb; it < 512; it += vn) attn_item(P, l, it, lds, tid, wid, lane, P.ph_lo < 0 ? 0 : ATTN_VAR(l));
                    conv_part(P, l, tid, vb, vn);
                    for (int it = vb; it < 512; it += vn) prep_tile<1>(P, l, it, lds, tid, wid, lane);
                    if (l + 1 < DEPTH) phase_convert(P, l + 1, lds, wid, lane, vb, vn);
                }
                is_gemm = false; } break;
            case 7: phase_post(P, l, tid, bid, nblk); is_gemm = false; break;
            case 8: g.Bt = WB + WB_MIXOUT; E.kind = 1; E.perm = true; E.rs = pg8::EpiResid{hin, hout, modl + 5 * 1024, 1.0f, first_h ? 1 : 0, last_h ? 1 : 0}; break;
            case 9: phase_norm<false>(P, hin, P.in[25] + l * 1024, modl + 6 * 1024, wid, lane, bid, nblk); is_gemm = false; break;
            case 10: g.Bt = WB + WB_FFN2IN; g.N = 2 * DFF; E.kind = 0; E.perm = true; E.sw.O = ACT; break;
            default: g.A = ACT; g.Bt = WB + WB_FFN2OUT; g.K = DFF; E.kind = 1; E.perm = true; E.rs = pg8::EpiResid{hin, hout, modl + 8 * 1024, 0.5f, first_h ? 1 : 0, last_h ? 1 : 0}; break;
            }
            if (is_gemm) { pg8::StaticOrder S; S.init(NTOK, g.N, nblk, bid); pg8::gemm_phase<pg8::EpiAny, pg8::StaticOrder, GEMM_ALIGN, GEMM_SP2>(lds, g, S, E, tid); }
        }
#ifdef DIAG_TIME
        const unsigned long long twork = __builtin_amdgcn_s_memrealtime();
        cg::this_grid().sync();
        { const unsigned long long tnow = __builtin_amdgcn_s_memrealtime(); const int sx = ph == 0 ? -1 : (ph - 1) % PPL;
          if (TSEL_A(sx)) tA += (TWAIT_A ? tnow - twork : tnow - tprev);
          if (TSEL_B(sx)) tB += (TWAIT_B ? tnow - twork : tnow - tprev);
          tprev = tnow; }
#else
#ifdef DBL_PHASE
        cg::this_grid().sync();
      }
#else
        if (ph + 1 < P.ph_hi) { if (P.ph_hi > 100000) cg::this_grid().sync(); else xcd_barrier(xbar); }
#ifdef EXTRA_SYNC
        if (ph + 1 < P.ph_hi) { cg::this_grid().sync(); }
#endif
#endif
#endif
    }
#ifdef DIAG_TIME
    {
        unsigned long long* tw = (unsigned long long*)(P.ws + WS_END);
        if (blockIdx.x == 0 && threadIdx.x == 0) { tw[0] = tA; tw[1] = tB; __threadfence(); }
        cg::this_grid().sync();
        const float fa = (float)__hip_atomic_load(tw, __ATOMIC_RELAXED, __HIP_MEMORY_SCOPE_AGENT) * 0.01f * 100.0f, fb = (float)__hip_atomic_load(tw + 1, __ATOMIC_RELAXED, __HIP_MEMORY_SCOPE_AGENT) * 0.01f;
        for (size_t i = (size_t)blockIdx.x * 512 + threadIdx.x; i < (size_t)NTOK * 1024; i += (size_t)gridDim.x * 512) P.out[i] = (i == 0) ? fa : fb;
    }
#endif
}


#ifdef DIAG_SELFTEST
__global__ void diag_checksum(const unsigned* p, size_t nwords, unsigned long long* slot) {
    unsigned long long acc = 0;
    for (size_t i = (size_t)blockIdx.x * blockDim.x + threadIdx.x; i < nwords; i += (size_t)gridDim.x * blockDim.x) acc += (unsigned long long)p[i] * (unsigned long long)(2 * i + 1);
    for (int o = 1; o < 64; o <<= 1) acc += __shfl_xor(acc, o);
    if ((threadIdx.x & 63) == 0) atomicAdd(slot, acc);
}
__global__ void diag_report(const unsigned long long* slots, int nitems, int nrep, float* out, size_t n) {
    int code = 0;
    for (int k = 0; k < nitems; ++k) for (int r = 1; r < nrep; ++r) if (slots[k * nrep + r] != slots[k * nrep]) { code |= 1 << k; break; }
    if (code == 0) return;
    const float c = 4.0f * exp2f((float)code);
    for (size_t i = (size_t)blockIdx.x * blockDim.x + threadIdx.x; i < n; i += (size_t)gridDim.x * blockDim.x) out[i] = c;
}
#endif
extern "C" void kernel_launch(void* const* d_in, const int* in_sizes, int n_in, void* d_out, int out_size, void* d_ws, size_t ws_size, hipStream_t stream) {
    static int grid = 0;
    if (grid == 0) {
        if (n_in != 28 || out_size != NTOK * DM || ws_size < WS_END) { fprintf(stderr, "kernel_launch: unexpected shapes (n_in %d out %d ws %zu need %zu)\n", n_in, out_size, ws_size, (size_t)WS_END); grid = -1; return; }
        int dev = 0, cus = 0, per_cu = 0;
        hipGetDevice(&dev); hipDeviceGetAttribute(&cus, hipDeviceAttributeMultiprocessorCount, dev);
        if (hipFuncSetAttribute((const void*)mega, hipFuncAttributeMaxDynamicSharedMemorySize, LDS_BYTES) != hipSuccess) { fprintf(stderr, "kernel_launch: hipFuncSetAttribute failed\n"); grid = -1; return; }
        if (hipOccupancyMaxActiveBlocksPerMultiprocessor(&per_cu, (const void*)mega, 512, LDS_BYTES) != hipSuccess || per_cu < 1) { fprintf(stderr, "kernel_launch: occupancy query failed (%d)\n", per_cu); per_cu = 1; (void)hipGetLastError(); }
        grid = cus * per_cu;
    }
    if (grid < 0) return;
    Params p{};
    for (int i = 0; i < 28; ++i) p.in[i] = (const float*)d_in[i];
    p.out = (float*)d_out; p.ws = (unsigned char*)d_ws;
#if MK_LAUNCHES == 1
    if (hipMemsetAsync((unsigned char*)d_ws + WS_BAR, 0, 16384, stream) != hipSuccess) { fprintf(stderr, "kernel_launch: memset of barrier words failed\n"); return; }
    p.ph_lo = 0; p.ph_hi = NPH;
    void* args[] = {&p};
    hipError_t e = hipLaunchCooperativeKernel((const void*)mega, dim3(grid), dim3(512), args, LDS_BYTES, stream);
    if (e != hipSuccess) fprintf(stderr, "cooperative launch failed: %s (grid %d)\n", hipGetErrorString(e), grid);
#else
#ifdef DIAG_SELFTEST
    {
        constexpr int NREP = 4;
        unsigned long long* slots = (unsigned long long*)((unsigned char*)d_ws + WS_END);
        hipMemsetAsync(slots, 0, 64 * NREP * 8, stream);
        int item = 0;
        for (int ph = 0; ph < NPH; ++ph) {
            p.ph_lo = ph; p.ph_hi = ph + 1; hipLaunchKernelGGL(mega, dim3(grid), dim3(512), LDS_BYTES, stream, p);
            if (ph == 0) continue;
            const int l = (ph - 1) / PPL, s = (ph - 1) % PPL;
            size_t off = 0, len = 0; bool test = (s == 5);
            switch (s) {
            case 0: off = OFF_LORA; len = OFF_R1 - OFF_LORA; break;
            case 1: case 12: off = OFF_R1; len = (size_t)NTOK * DFF * 2; break;
            case 2: test = false; break;
            case 3: case 5: case 7: case 9: case 11: off = OFF_HN; len = (size_t)NTOK * 1024 * 2; break;
            case 4: off = OFF_R1; len = R1_BYTES; break;
            case 6: off = OFF_R2; len = WS_END - OFF_R2; break;
            case 8: off = OFF_R1 + R1_RWKV; len = (size_t)NTOK * 256 * 4; break;
            default: test = false; break;
            }
            if (!test) continue;
            const unsigned* base = (s == 2) ? (const unsigned*)d_out : (const unsigned*)((unsigned char*)d_ws + off);
            const size_t nw = (s == 2) ? (size_t)NTOK * 1024 : len / 4;
            for (int r = 0; r < NREP; ++r) {
                if (r > 0) hipLaunchKernelGGL(mega, dim3(grid), dim3(512), LDS_BYTES, stream, p);
                hipLaunchKernelGGL(diag_checksum, dim3(2048), dim3(256), 0, stream, base, nw, slots + item * NREP + r);
            }
            ++item;
        }
        hipLaunchKernelGGL(diag_report, dim3(2048), dim3(256), 0, stream, (const unsigned long long*)slots, item, NREP, (float*)d_out, (size_t)NTOK * 1024);
    }
#else
    for (int ph = 0; ph < NPH; ++ph) { p.ph_lo = ph; p.ph_hi = ph + 1; hipLaunchKernelGGL(mega, dim3(grid), dim3(512), LDS_BYTES, stream, p); }
#endif
#endif
}
```

```cpp
#define ATTN_VAR(l) (P.ph_hi > 100000 ? (l) + 1 : 0)
#define GEMM_ALIGN true
#define GEMM_SP2 true
#include <hip/hip_runtime.h>
#include <hip/hip_cooperative_groups.h>
#include <cstdio>
#include <cstdint>
namespace cg = cooperative_groups;

#ifndef MK_LAUNCHES
#define MK_LAUNCHES 1
#endif

namespace pg8 {
#define PG8_LAS __attribute__((address_space(3)))
typedef unsigned short bf16_t;
typedef short bf16x8 __attribute__((ext_vector_type(8)));
typedef float f32x4 __attribute__((ext_vector_type(4)));
typedef unsigned u32x4 __attribute__((ext_vector_type(4)));
constexpr int BM = 256, BK = 64, HALF = 128, HTB = HALF * BK * 2  , STAGE_BYTES = 8 * HTB, NXCD = 8, WGM = 8;

__host__ __device__ __forceinline__ int lds_byte(int r, int c) { const int st = (r >> 4) * 2 + (c >> 5), rr = r & 15, cc = c & 31, ob = rr * 64 + cc * 2; return st * 1024 + (ob ^ (((ob >> 9) & 1) << 5)); }
__host__ __device__ __forceinline__ void stage_rc(int b, int& R, int& C) { const int st = b / 1024, sb = b % 1024, swz = sb ^ (((sb >> 9) & 1) << 5); R = (st >> 1) * 16 + swz / 64; C = (st & 1) * 32 + (swz % 64) / 2; }
__host__ __device__ __forceinline__ int perm32(int rho) { const int n = rho >> 4, i = rho & 15; return 8 * (i >> 2) + 4 * n + (i & 3); }

struct Unit { int pm, pn; };
struct Gemm { const bf16_t* A; const bf16_t* Bt; int M, N, K; };

struct StaticOrder {
    int nM, nN, nwg, G, c;
    __host__ __device__ void init(int M, int N, int G_, int c_) { nM = M / BM; nN = N / BM; nwg = nM * nN; G = G_; c = c_; }
    __host__ __device__ bool next(int i, Unit& u) const {
        const long L = (long)i * G + c; if (L >= nwg) return false;
        int wgid = (int)L; { const int q = nwg / NXCD, r = nwg % NXCD, xcd = wgid % NXCD, off = wgid / NXCD; wgid = (xcd < r ? xcd * (q + 1) : r * (q + 1) + (xcd - r) * q) + off; }
        const int nig = WGM * nN, gid = wgid / nig, fm = gid * WGM, gsz = (nM - fm) < WGM ? (nM - fm) : WGM;
        u.pm = fm + ((wgid % nig) % gsz); u.pn = (wgid % nig) / gsz; return true;
    }
    __device__ __forceinline__ void a_ready(const Unit&) const {}
    __device__ __forceinline__ void done(const Unit&) const {}
};
typedef __bf16 bf16v2_t __attribute__((ext_vector_type(2)));
typedef float f32x2_t __attribute__((ext_vector_type(2)));
__device__ __forceinline__ unsigned cvt_pk_bf16(float lo, float hi) { const f32x2_t v = {lo, hi}; const bf16v2_t b = __builtin_convertvector(v, bf16v2_t); return __builtin_bit_cast(unsigned, b); }

typedef _Float16 h16x2_t __attribute__((ext_vector_type(2)));
__device__ __forceinline__ unsigned cvt_pk_f16(float lo, float hi) { const f32x2_t v = {lo, hi}; const h16x2_t h = __builtin_convertvector(v, h16x2_t); return __builtin_bit_cast(unsigned, h); }
__device__ __forceinline__ f32x2_t f16x2_to_f32(unsigned u) { const h16x2_t h = __builtin_bit_cast(h16x2_t, u); return __builtin_convertvector(h, f32x2_t); }
template <class Epi, class Sched, bool ALIGN_EPI = false, bool SP2 = false>
__device__ __forceinline__ void gemm_phase(PG8_LAS unsigned char* lds, const Gemm g, const Sched& S, const Epi& E, const int tid) {
    const int wid = __builtin_amdgcn_readfirstlane(tid >> 6), lane = tid & 63, wr = wid >> 2, wc = wid & 3, fr = lane & 15, fq = lane >> 4;
    const int K = g.K, nt = K / BK;
    unsigned voffA[2], voffB[2];
#pragma unroll
    for (int i = 0; i < 2; ++i) { int R, C; stage_rc(tid * 16 + i * 8192, R, C); const int Rb = E.perm ? ((R & ~31) + perm32(R & 31)) : R;
        voffA[i] = (unsigned)(R * K + C) * 2u; voffB[i] = (unsigned)(Rb * K + C) * 2u; }
    const size_t kstep = (size_t)(BK * 2);
    const size_t hstep = (size_t)HALF * K * 2;
    const size_t tstep = 2 * hstep;
    const unsigned ldsw = (unsigned)wid * 1024u;
    const int aoff = lds_byte(wr * 64 + fr, fq * 8), boff = lds_byte(wc * 32 + fr, fq * 8);
#define PG8_SA(b, h) (((b) * 2 + (h)) * HTB)
#define PG8_SB(b, h) ((4 + (b) * 2 + (h)) * HTB)
#define PG8_STAGE(bufoff, gbase, voff) do { _Pragma("unroll") for (int _i = 0; _i < 2; ++_i) \
        __builtin_amdgcn_global_load_lds((const unsigned*)((const char*)(gbase) + (voff)[_i]), (PG8_LAS unsigned*)(lds + (bufoff) + ldsw + _i * 8192), 16, 0, 0); } while (0)
#define PG8_LDA(dst, b, h) do { _Pragma("unroll") for (int m = 0; m < 4; ++m) _Pragma("unroll") for (int k = 0; k < 2; ++k) dst[m][k] = *(const PG8_LAS bf16x8*)(lds + PG8_SA(b, h) + aoff + m * 2048 + k * 1024); } while (0)
#define PG8_LDB(dst, b, h) do { _Pragma("unroll") for (int n = 0; n < 2; ++n) _Pragma("unroll") for (int k = 0; k < 2; ++k) dst[n][k] = *(const PG8_LAS bf16x8*)(lds + PG8_SB(b, h) + boff + n * 2048 + k * 1024); } while (0)
#define PG8_MMA(ai, bj, At, Bt) do { __builtin_amdgcn_s_setprio(1); _Pragma("unroll") for (int m = 0; m < 4; ++m) _Pragma("unroll") for (int n = 0; n < 2; ++n) _Pragma("unroll") for (int k = 0; k < 2; ++k) \
        acc[ai][bj][m][n] = __builtin_amdgcn_mfma_f32_16x16x32_bf16(Bt[n][k], At[m][k], acc[ai][bj][m][n], 0, 0, 0); __builtin_amdgcn_s_setprio(0); } while (0)
#define PG8_WAIT_V(n) asm volatile("s_waitcnt vmcnt(" #n ")" ::: "memory")
#define PG8_WAIT_L(n) asm volatile("s_waitcnt lgkmcnt(" #n ")" ::: "memory")
#define PG8_BAR __builtin_amdgcn_s_barrier()
#define PG8_SCHED __builtin_amdgcn_sched_barrier(0)
    Unit cur, nxt; int ui = 0;
    if (!S.next(0, cur)) return;
    f32x4 acc[2][2][4][2];
#pragma unroll
    for (int a = 0; a < 2; ++a)
#pragma unroll
        for (int b = 0; b < 2; ++b)
#pragma unroll
            for (int m = 0; m < 4; ++m)
#pragma unroll
                for (int n = 0; n < 2; ++n) acc[a][b][m][n] = (f32x4){0.f, 0.f, 0.f, 0.f};
    bf16x8 At[4][2], B0[2][2], B1[2][2];
    const char* cA = (const char*)g.A + (size_t)cur.pm * tstep; const char* cB = (const char*)g.Bt + (size_t)cur.pn * tstep;
    S.a_ready(cur);
    if constexpr (SP2) {
        PG8_STAGE(PG8_SB(0, 0), cB, voffB); PG8_STAGE(PG8_SB(0, 1), cB + hstep, voffB); PG8_STAGE(PG8_SA(0, 0), cA, voffA); PG8_STAGE(PG8_SA(0, 1), cA + hstep, voffA);
        if (wr == 1) PG8_BAR;
        PG8_WAIT_V(2); PG8_BAR;
        PG8_STAGE(PG8_SB(1, 0), cB + kstep, voffB); PG8_STAGE(PG8_SA(1, 0), cA + kstep, voffA); PG8_STAGE(PG8_SB(1, 1), cB + hstep + kstep, voffB);
        PG8_WAIT_V(6); PG8_BAR;
    } else {
        PG8_STAGE(PG8_SB(0, 0), cB, voffB); PG8_STAGE(PG8_SA(0, 0), cA, voffA); PG8_STAGE(PG8_SB(0, 1), cB + hstep, voffB); PG8_STAGE(PG8_SA(0, 1), cA + hstep, voffA);
        if (wr == 1) PG8_BAR;
        PG8_WAIT_V(4); PG8_BAR;
        PG8_STAGE(PG8_SB(1, 0), cB + kstep, voffB); PG8_STAGE(PG8_SA(1, 0), cA + kstep, voffA); PG8_STAGE(PG8_SB(1, 1), cB + hstep + kstep, voffB);
        PG8_WAIT_V(6); PG8_BAR;
    }
    for (;;) {
        const bool has_next = S.next(ui + 1, nxt);
        const char* nA = has_next ? (const char*)g.A + (size_t)nxt.pm * tstep : cA; const char* nB = has_next ? (const char*)g.Bt + (size_t)nxt.pn * tstep : cB;
        for (int t = 0; t < nt; t += 2) {
            const bool last = (t == nt - 2);
            const char* a1 = cA + (size_t)(t + 1) * kstep;
            const char* a2 = last ? nA : cA + (size_t)(t + 2) * kstep; const char* b2 = last ? nB : cB + (size_t)(t + 2) * kstep;
            const char* a3 = a2 + kstep; const char* b3 = b2 + kstep;
            if (last && has_next) S.a_ready(nxt);
            if constexpr (SP2) {
            PG8_LDB(B0, 0, 0); PG8_LDB(B1, 0, 1); PG8_SCHED; PG8_LDA(At, 0, 0); PG8_STAGE(PG8_SA(1, 1), a1 + hstep, voffA);
            PG8_WAIT_V(8); PG8_WAIT_L(0); PG8_BAR; PG8_MMA(0, 0, At, B0); PG8_MMA(0, 1, At, B1); PG8_BAR; PG8_SCHED;
            PG8_LDA(At, 0, 1); PG8_STAGE(PG8_SB(0, 0), b2, voffB); PG8_STAGE(PG8_SB(0, 1), b2 + hstep, voffB); PG8_STAGE(PG8_SA(0, 0), a2, voffA);
            PG8_WAIT_V(8); PG8_WAIT_L(0); PG8_BAR; PG8_MMA(1, 0, At, B0); PG8_MMA(1, 1, At, B1); PG8_BAR; PG8_SCHED;
            PG8_LDB(B0, 1, 0); PG8_LDB(B1, 1, 1); PG8_SCHED; PG8_LDA(At, 1, 0); PG8_STAGE(PG8_SA(0, 1), a2 + hstep, voffA);
            PG8_WAIT_V(8); PG8_WAIT_L(0); PG8_BAR; PG8_MMA(0, 0, At, B0); PG8_MMA(0, 1, At, B1); PG8_BAR; PG8_SCHED;
            PG8_LDA(At, 1, 1); PG8_STAGE(PG8_SB(1, 0), b3, voffB); PG8_STAGE(PG8_SB(1, 1), b3 + hstep, voffB); PG8_STAGE(PG8_SA(1, 0), a3, voffA);
            PG8_WAIT_V(8); PG8_WAIT_L(0); PG8_BAR; PG8_MMA(1, 0, At, B0); PG8_MMA(1, 1, At, B1); PG8_BAR; PG8_SCHED;
            } else {
            PG8_LDB(B0, 0, 0); PG8_SCHED; PG8_LDA(At, 0, 0); PG8_STAGE(PG8_SA(1, 1), a1 + hstep, voffA);
            PG8_WAIT_L(8); PG8_BAR; PG8_WAIT_L(0); PG8_MMA(0, 0, At, B0); PG8_BAR; PG8_SCHED;
            PG8_LDB(B1, 0, 1); PG8_STAGE(PG8_SB(0, 0), b2, voffB);
            PG8_BAR; PG8_WAIT_L(0); PG8_MMA(0, 1, At, B1); PG8_BAR;
            PG8_LDA(At, 0, 1); PG8_STAGE(PG8_SA(0, 0), a2, voffA);
            PG8_BAR; PG8_WAIT_L(0); PG8_MMA(1, 0, At, B0); PG8_BAR; PG8_SCHED;
            PG8_STAGE(PG8_SB(0, 1), b2 + hstep, voffB);
            PG8_WAIT_V(6); PG8_BAR; PG8_MMA(1, 1, At, B1); PG8_BAR;
            PG8_LDB(B0, 1, 0); PG8_SCHED; PG8_LDA(At, 1, 0); PG8_STAGE(PG8_SA(0, 1), a2 + hstep, voffA);
            PG8_WAIT_L(8); PG8_BAR; PG8_WAIT_L(0); PG8_MMA(0, 0, At, B0); PG8_BAR; PG8_SCHED;
            PG8_LDB(B1, 1, 1); PG8_STAGE(PG8_SB(1, 0), b3, voffB);
            PG8_BAR; PG8_WAIT_L(0); PG8_MMA(0, 1, At, B1); PG8_BAR;
            PG8_LDA(At, 1, 1); PG8_STAGE(PG8_SA(1, 0), a3, voffA);
            PG8_BAR; PG8_WAIT_L(0); PG8_MMA(1, 0, At, B0); PG8_BAR; PG8_SCHED;
            PG8_STAGE(PG8_SB(1, 1), b3 + hstep, voffB);
            PG8_WAIT_V(6); PG8_BAR; PG8_MMA(1, 1, At, B1); PG8_BAR;
            }
        }
        if constexpr (ALIGN_EPI) { if (wr == 0) PG8_BAR; }
        if constexpr (!Epi::AFTER_DRAIN) { E(acc, cur, wr, wc, fr, fq); S.done(cur); }
        if (!has_next) break;
#pragma unroll
        for (int a = 0; a < 2; ++a)
#pragma unroll
            for (int b = 0; b < 2; ++b)
#pragma unroll
                for (int m = 0; m < 4; ++m)
#pragma unroll
                    for (int n = 0; n < 2; ++n) acc[a][b][m][n] = (f32x4){0.f, 0.f, 0.f, 0.f};
        cur = nxt; cA = nA; cB = nB; ++ui;
        if constexpr (ALIGN_EPI) { if (wr == 1) PG8_BAR; }
    }
    PG8_WAIT_V(0);
    if constexpr (!ALIGN_EPI) { if (wr == 0) PG8_BAR; }
    PG8_BAR;
    if constexpr (Epi::AFTER_DRAIN) { E.fused(acc, cur, wr, wc, fr, fq, lds, wid, lane); S.done(cur); }
#undef PG8_SA
#undef PG8_SB
#undef PG8_STAGE
#undef PG8_LDA
#undef PG8_LDB
#undef PG8_MMA
#undef PG8_WAIT_V
#undef PG8_WAIT_L
#undef PG8_BAR
#undef PG8_SCHED
}

__device__ __forceinline__ float silu_f(float x) { return x * __builtin_amdgcn_rcpf(1.f + __builtin_amdgcn_exp2f(-1.44269504089f * x)); }

struct EpiSwiglu {
    static constexpr bool PERM = true, AFTER_DRAIN = false;
    bf16_t* O;
    __device__ __forceinline__ void operator()(const f32x4 (&acc)[2][2][4][2], const Unit& u, int wr, int wc, int fr, int fq) const {
        const int row0 = u.pm * BM + wr * 64 + fr, col0 = u.pn * 128 + wc * 32 + 8 * fq;
#pragma unroll
        for (int ai = 0; ai < 2; ++ai)
#pragma unroll
            for (int m = 0; m < 4; ++m) {
                bf16_t* rowp = O + (size_t)(row0 + ai * HALF + m * 16) * 2816 + col0;
                const f32x4 g0 = acc[ai][0][m][0], g1 = acc[ai][0][m][1], u0 = acc[ai][1][m][0], u1 = acc[ai][1][m][1];
                u32x4 o;
                o.x = cvt_pk_bf16(silu_f(g0[0]) * u0[0], silu_f(g0[1]) * u0[1]); o.y = cvt_pk_bf16(silu_f(g0[2]) * u0[2], silu_f(g0[3]) * u0[3]);
                o.z = cvt_pk_bf16(silu_f(g1[0]) * u1[0], silu_f(g1[1]) * u1[1]); o.w = cvt_pk_bf16(silu_f(g1[2]) * u1[2], silu_f(g1[3]) * u1[3]);
                *(u32x4*)rowp = o;
            }
    }
};
struct EpiResid {
    static constexpr bool PERM = true, AFTER_DRAIN = false;
    const void* hin; void* hout; const float* gt; float scale; int in_f32, out_f32;
    template <bool INF, bool OUTF> __device__ __forceinline__ void run(const f32x4 (&acc)[2][2][4][2], const f32x4 (&gv)[2][2], int row0, int col0) const {
#pragma unroll
        for (int ai = 0; ai < 2; ++ai)
#pragma unroll
            for (int m = 0; m < 4; ++m) {
                const size_t off = (size_t)(row0 + ai * HALF + m * 16) * 1024 + col0;
#pragma unroll
                for (int bj = 0; bj < 2; ++bj) {
                    const size_t o = off + bj * HALF;
                    f32x4 h0, h1;
                    if (INF) { h0 = *(const f32x4*)((const float*)hin + o); h1 = *(const f32x4*)((const float*)hin + o + 4); }
                    else { const u32x4 u = *(const u32x4*)((const bf16_t*)hin + o); const f32x2_t a = f16x2_to_f32(u[0]), c = f16x2_to_f32(u[1]), d = f16x2_to_f32(u[2]), e = f16x2_to_f32(u[3]);
                           h0 = (f32x4){a[0], a[1], c[0], c[1]}; h1 = (f32x4){d[0], d[1], e[0], e[1]}; }
                    const f32x4 r0 = h0 + gv[bj][0] * acc[ai][bj][m][0], r1 = h1 + gv[bj][1] * acc[ai][bj][m][1];
                    if (OUTF) { *(f32x4*)((float*)hout + o) = r0; *(f32x4*)((float*)hout + o + 4) = r1; }
                    else { u32x4 w; w[0] = cvt_pk_f16(r0[0], r0[1]); w[1] = cvt_pk_f16(r0[2], r0[3]); w[2] = cvt_pk_f16(r1[0], r1[1]); w[3] = cvt_pk_f16(r1[2], r1[3]); *(u32x4*)((bf16_t*)hout + o) = w; }
                }
            }
    }
    __device__ __forceinline__ void operator()(const f32x4 (&acc)[2][2][4][2], const Unit& u, int wr, int wc, int fr, int fq) const {
        const int row0 = u.pm * BM + wr * 64 + fr, col0 = u.pn * BM + wc * 32 + 8 * fq;
        const float* gp = gt + (size_t)(u.pm >> 4) * 9216 + col0;
        f32x4 gv[2][2];
#pragma unroll
        for (int bj = 0; bj < 2; ++bj)
#pragma unroll
            for (int n = 0; n < 2; ++n) { const f32x4 t = *(const f32x4*)(gp + bj * HALF + n * 4); gv[bj][n] = (t + 1.0f) * scale; }
        if (in_f32) run<true, false>(acc, gv, row0, col0); else if (out_f32) run<false, true>(acc, gv, row0, col0); else run<false, false>(acc, gv, row0, col0);
    }
};
struct EpiProj {
    static constexpr bool PERM = true, AFTER_DRAIN = false;
    bf16_t* att; bf16_t* rw; bf16_t* cv;
    template <int LD, bool F16> __device__ __forceinline__ void put(const f32x4 (&acc)[2][2][4][2], bf16_t* base, int row0, int col0) const {
#pragma unroll
        for (int ai = 0; ai < 2; ++ai)
#pragma unroll
            for (int m = 0; m < 4; ++m) { bf16_t* rowp = base + (size_t)(row0 + ai * HALF + m * 16) * LD + col0;
#pragma unroll
                for (int bj = 0; bj < 2; ++bj) { const f32x4 v0 = acc[ai][bj][m][0], v1 = acc[ai][bj][m][1]; u32x4 o;
                    o[0] = F16 ? cvt_pk_f16(v0[0], v0[1]) : cvt_pk_bf16(v0[0], v0[1]); o[1] = F16 ? cvt_pk_f16(v0[2], v0[3]) : cvt_pk_bf16(v0[2], v0[3]);
                    o[2] = F16 ? cvt_pk_f16(v1[0], v1[1]) : cvt_pk_bf16(v1[0], v1[1]); o[3] = F16 ? cvt_pk_f16(v1[2], v1[3]) : cvt_pk_bf16(v1[2], v1[3]);
                    *(u32x4*)(rowp + bj * HALF) = o; } }
    }
    __device__ __forceinline__ void operator()(const f32x4 (&acc)[2][2][4][2], const Unit& u, int wr, int wc, int fr, int fq) const {
        const int row0 = u.pm * BM + wr * 64 + fr, cl = wc * 32 + 8 * fq;
        if (u.pn >= 3 && u.pn < 7) put<1024, true>(acc, rw, row0, (u.pn - 3) * BM + cl);
        else put<768, false>(acc, u.pn < 3 ? att : cv, row0, (u.pn < 3 ? u.pn : u.pn - 7) * BM + cl);
    }
};
struct EpiAny {
    int kind; bool perm;
    EpiSwiglu sw; EpiResid rs; EpiProj pj;
    static constexpr bool AFTER_DRAIN = false;
    __device__ __forceinline__ void operator()(const f32x4 (&acc)[2][2][4][2], const Unit& u, int wr, int wc, int fr, int fq) const {
        if (kind == 0) sw(acc, u, wr, wc, fr, fq); else if (kind == 1) rs(acc, u, wr, wc, fr, fq); else pj(acc, u, wr, wc, fr, fq);
    }
};
}

#define LAS __attribute__((address_space(3)))
using pg8::bf16_t; using pg8::bf16x8; using pg8::f32x4; using pg8::u32x4; using pg8::cvt_pk_bf16; using pg8::cvt_pk_f16; using pg8::f16x2_to_f32; using pg8::f32x2_t;
constexpr int NTOK = 32768, SEQL = 4096, DM = 1024, DFF = 2816, DEPTH = 4;
constexpr int LDS_BYTES = 131072 + 64;
constexpr int PPL = 12;
constexpr int NPH = 1 + DEPTH * PPL;

constexpr size_t OFF_MOD = 0;
constexpr size_t OFF_LORA = OFF_MOD + 1179648;
constexpr size_t OFF_BONUS = OFF_LORA + 131072;
constexpr size_t OFF_WB = OFF_BONUS + 524288;
constexpr size_t WB_FFN1IN = 0, WB_FFN1OUT = 5767168, WB_MIXIN = WB_FFN1OUT + 2883584, WB_MIXOUT = WB_MIXIN + 2621440,
                 WB_FFN2IN = WB_MIXOUT + 1048576, WB_FFN2OUT = WB_FFN2IN + 5767168, WB_ELEMS = WB_FFN2OUT + 2883584;
constexpr size_t OFF_HN = OFF_WB + WB_ELEMS * 2;
constexpr size_t OFF_R1 = OFF_HN + (size_t)NTOK * 1024 * 2;
constexpr size_t R1_CONV = (size_t)NTOK * 768 * 2, R1_RWKV = 2 * R1_CONV, R1_BYTES = (size_t)NTOK * 2816 * 2;
constexpr size_t OFF_R2 = OFF_R1 + R1_BYTES;
constexpr int REC_B = 896;
constexpr size_t R2_G = (size_t)NTOK * 4 * REC_B;
constexpr size_t WS_BAR = OFF_R2 + R2_G + (size_t)NTOK * 256 * 2;
constexpr size_t OFF_WB2 = WS_BAR + 16384;
constexpr size_t OFF_LORA2 = OFF_WB2 + WB_ELEMS * 2;
constexpr size_t OFF_YS = OFF_LORA2 + 131072;
constexpr size_t OFF_HB = OFF_YS + (size_t)NTOK * 256 * 4;
constexpr size_t WS_END = OFF_HB + (size_t)NTOK * 1024 * 2;

struct Params { const float* in[28]; float* out; unsigned char* ws; int ph_lo, ph_hi; };

__device__ __forceinline__ float wave_sum(float v) {
#pragma unroll
    for (int o = 1; o < 64; o <<= 1) v += __shfl_xor(v, o);
    return v;
}
template <int CTRL> __device__ __forceinline__ float dpp_f(float x) { return __int_as_float(__builtin_amdgcn_update_dpp(0, __float_as_int(x), CTRL, 0xf, 0xf, true)); }
__device__ __forceinline__ float rowsum16(float x) {
    x += dpp_f<0x128>(x); x += dpp_f<0x124>(x); x += dpp_f<0x122>(x); x += dpp_f<0x121>(x); return x;
}
__device__ __forceinline__ float bflo(unsigned u) { return __uint_as_float(u << 16); }
__device__ __forceinline__ float bfhi(unsigned u) { return __uint_as_float(u & 0xffff0000u); }
__device__ __forceinline__ float sigmoid_f(float x) { return __builtin_amdgcn_rcpf(1.f + __builtin_amdgcn_exp2f(-1.44269504089f * x)); }

__device__ __forceinline__ void phase_mod(const Params& P, LAS unsigned char* lds, int tid, int wid, int lane, int bid, int nblk) {
    LAS float* cact = (LAS float*)lds;
    LAS float* red = (LAS float*)(lds + 32768);
    const float* c = P.in[1];
    float* MOD = (float*)(P.ws + OFF_MOD);
    for (int i = tid; i < 8192; i += 512) { const float v = c[i]; cact[i] = v / (1.f + __expf(-v)); }
    __syncthreads();
    for (int item = bid; item < 288; item += nblk) {
        const int l = item / 72, j0 = (item % 72) * 128, k0 = wid * 128;
        const float* W = P.in[2] + (size_t)l * 1024 * 9216 + j0 + 2 * lane;
        float a0[8], a1[8];
#pragma unroll
        for (int b = 0; b < 8; ++b) { a0[b] = 0.f; a1[b] = 0.f; }
#pragma unroll 8
        for (int k = 0; k < 128; ++k) {
            const float2 w = *(const float2*)(W + (size_t)(k0 + k) * 9216);
#pragma unroll
            for (int b = 0; b < 8; ++b) { const float ca = cact[b * 1024 + k0 + k]; a0[b] += ca * w.x; a1[b] += ca * w.y; }
        }
#pragma unroll
        for (int b = 0; b < 8; ++b) { red[(wid * 8 + b) * 128 + 2 * lane] = a0[b]; red[(wid * 8 + b) * 128 + 2 * lane + 1] = a1[b]; }
        __syncthreads();
        for (int o = tid; o < 1024; o += 512) {
            const int b = o >> 7, ci = o & 127; float s = 0.f;
#pragma unroll
            for (int w = 0; w < 8; ++w) s += red[(w * 8 + b) * 128 + ci];
            MOD[(size_t)(l * 8 + b) * 9216 + j0 + ci] = s + P.in[3][l * 9216 + j0 + ci];
        }
        __syncthreads();
    }
}

__device__ __forceinline__ void transpose_item(const float* W, int K, int N, bf16_t* WT, int k0, int n0, int drow0, LAS float* scr, int lane) {
#pragma unroll 8
    for (int i = 0; i < 32; ++i) { const int kk = 2 * i + (lane >> 5); scr[kk * 33 + (lane & 31)] = W[(size_t)(k0 + kk) * N + n0 + (lane & 31)]; }
    asm volatile("s_waitcnt lgkmcnt(0)" ::: "memory");
    const int c = lane & 7;
#pragma unroll
    for (int j = 0; j < 4; ++j) { const int n = (lane >> 3) + 8 * j; const LAS float* s = scr + (8 * c) * 33 + n;
        u32x4 o; o.x = cvt_pk_bf16(s[0 * 33], s[1 * 33]); o.y = cvt_pk_bf16(s[2 * 33], s[3 * 33]); o.z = cvt_pk_bf16(s[4 * 33], s[5 * 33]); o.w = cvt_pk_bf16(s[6 * 33], s[7 * 33]);
        *(u32x4*)(WT + (size_t)(drow0 + n) * K + k0 + 8 * c) = o; }
    asm volatile("s_waitcnt lgkmcnt(0)" ::: "memory");
}
__device__ __forceinline__ int swiglu_row(int n0) { return n0 < DFF ? ((n0 >> 7) * 256 + (n0 & 127)) : (((n0 - DFF) >> 7) * 256 + 128 + ((n0 - DFF) & 127)); }
__device__ __forceinline__ void phase_convert(const Params& P, int l, LAS unsigned char* lds, int wid, int lane, int bid, int nblk) {
    LAS float* scr = (LAS float*)(lds + wid * 8448);
    bf16_t* WB = (bf16_t*)(P.ws + ((l & 1) ? OFF_WB2 : OFF_WB));
    bf16_t* LT = (bf16_t*)(P.ws + ((l & 1) ? OFF_LORA2 : OFF_LORA));
    const int gw = bid * 8 + wid, NGW = nblk * 8;
    constexpr int I_IN = 16 * 176, I_OUT = 44 * 32, I_MI = 16 * 80, I_MO = 16 * 32;
    constexpr int NIT = 2 * I_IN + 2 * I_OUT + I_MI + I_MO + 32;
    for (int it = gw; it < NIT; it += NGW) {
        int r = it;
        if (r < I_IN) { const int kb = r / 176, nb = r % 176; transpose_item(P.in[5] + (size_t)l * 1024 * 5632, 1024, 5632, WB + WB_FFN1IN, kb * 64, nb * 32, swiglu_row(nb * 32), scr, lane); continue; } r -= I_IN;
        if (r < I_OUT) { const int kb = r / 32, nb = r % 32; transpose_item(P.in[6] + (size_t)l * 2816 * 1024, 2816, 1024, WB + WB_FFN1OUT, kb * 64, nb * 32, nb * 32, scr, lane); continue; } r -= I_OUT;
        if (r < I_MI) { const int kb = r / 80, nb = r % 80; transpose_item(P.in[8] + (size_t)l * 1024 * 2560, 1024, 2560, WB + WB_MIXIN, kb * 64, nb * 32, nb * 32, scr, lane); continue; } r -= I_MI;
        if (r < I_MO) { const int kb = r / 32, nb = r % 32; transpose_item(P.in[9] + (size_t)l * 1024 * 1024, 1024, 1024, WB + WB_MIXOUT, kb * 64, nb * 32, nb * 32, scr, lane); continue; } r -= I_MO;
        if (r < I_IN) { const int kb = r / 176, nb = r % 176; transpose_item(P.in[26] + (size_t)l * 1024 * 5632, 1024, 5632, WB + WB_FFN2IN, kb * 64, nb * 32, swiglu_row(nb * 32), scr, lane); continue; } r -= I_IN;
        if (r < I_OUT) { const int kb = r / 32, nb = r % 32; transpose_item(P.in[27] + (size_t)l * 2816 * 1024, 2816, 1024, WB + WB_FFN2OUT, kb * 64, nb * 32, nb * 32, scr, lane); continue; } r -= I_OUT;
        if (r < 8) { transpose_item(P.in[15] + (size_t)l * 64 * 256, 64, 256, LT, 0, r * 32, r * 32, scr, lane); continue; } r -= 8;
        if (r < 8) { transpose_item(P.in[17] + (size_t)l * 64 * 256, 64, 256, LT + 16384, 0, r * 32, r * 32, scr, lane); continue; } r -= 8;
        { const int kb = r / 8, nb = r % 8; transpose_item(P.in[18] + (size_t)l * 128 * 256, 128, 256, LT + 32768, kb * 64, nb * 32, nb * 32, scr, lane); }
    }
}

template <bool INF>
__device__ __forceinline__ void phase_norm(const Params& P, const void* hin, const float* gain, const float* modl  , int wid, int lane, int bid, int nblk) {
    bf16_t* HN = (bf16_t*)(P.ws + OFF_HN);
    for (int row0 = (bid * 8 + wid) * 4; row0 < NTOK; row0 += nblk * 32) {
        f32x4 v[4][4]; float ss[4];
#pragma unroll
        for (int r = 0; r < 4; ++r) {
            if (INF) { const f32x4* xr = (const f32x4*)((const float*)hin + (size_t)(row0 + r) * 1024) + lane;
#pragma unroll
                for (int j = 0; j < 4; ++j) v[r][j] = xr[64 * j]; }
            else { const uint2* xr = (const uint2*)((const bf16_t*)hin + (size_t)(row0 + r) * 1024) + lane;
#pragma unroll
                for (int j = 0; j < 4; ++j) { const uint2 u = xr[64 * j]; const pg8::f32x2_t a = pg8::f16x2_to_f32(u.x), c = pg8::f16x2_to_f32(u.y); v[r][j] = (f32x4){a[0], a[1], c[0], c[1]}; } }
        }
#pragma unroll
        for (int r = 0; r < 4; ++r) { float a = 0.f;
#pragma unroll
            for (int j = 0; j < 4; ++j) a += (v[r][j][0] * v[r][j][0] + v[r][j][1] * v[r][j][1]) + (v[r][j][2] * v[r][j][2] + v[r][j][3] * v[r][j][3]);
            ss[r] = a; }
#pragma unroll
        for (int o = 1; o < 64; o <<= 1) {
#pragma unroll
            for (int r = 0; r < 4; ++r) ss[r] += __shfl_xor(ss[r], o);
        }
        const float* sh = modl + (size_t)(row0 >> 12) * 9216; const float* sc = sh + 1024;
#pragma unroll
        for (int j = 0; j < 4; ++j) {
            const int col = lane * 4 + 256 * j;
            const f32x4 g = *(const f32x4*)(gain + col), s1 = *(const f32x4*)(sc + col), s0 = *(const f32x4*)(sh + col);
            const f32x4 gs = g * (s1 + 1.0f);
#pragma unroll
            for (int r = 0; r < 4; ++r) {
                const float rstd = rsqrtf(ss[r] * (1.f / 1024.f) + 1e-6f);
                const f32x4 y = v[r][j] * rstd * gs + s0;
                uint2 o; o.x = cvt_pk_bf16(y[0], y[1]); o.y = cvt_pk_bf16(y[2], y[3]);
                ((uint2*)(HN + (size_t)(row0 + r) * 1024) + lane)[64 * j] = o;
            }
        }
    }
}

__device__ __forceinline__ bf16x8 pack8(const float* f) {
    u32x4 o; o.x = cvt_pk_bf16(f[0], f[1]); o.y = cvt_pk_bf16(f[2], f[3]); o.z = cvt_pk_bf16(f[4], f[5]); o.w = cvt_pk_bf16(f[6], f[7]);
    return __builtin_bit_cast(bf16x8, o);
}
__device__ __forceinline__ void attn_item(const Params& P, int l, int item, LAS unsigned char* lds, int tid, int wid, int lane, int var) {
    const bf16_t* PA = (const bf16_t*)(P.ws + OFF_R1);
    bf16_t* Y = (bf16_t*)(P.ws + OFF_HN);
    const int b = item >> 6, n = (item >> 1) & 31, hk = item & 1;
    LAS bf16_t* Ks = (LAS bf16_t*)lds;
    LAS bf16_t* Vt = (LAS bf16_t*)(lds + 36864);
    const float* kg = P.in[11] + l * 64; const float* qg = P.in[10] + l * 64;
    {
        const int row = tid >> 1, half = tid & 1, kt = n * 128 - 128 + row;
        u32x4 kv[4], vv[4];
        if (kt >= 0) {
            const bf16_t* src = PA + (size_t)(b * SEQL + kt) * 768 + 512 + hk * 64 + half * 32;
#pragma unroll
            for (int i = 0; i < 4; ++i) { kv[i] = ((const u32x4*)src)[i]; vv[i] = ((const u32x4*)(src + 128))[i]; }
        } else {
#pragma unroll
            for (int i = 0; i < 4; ++i) { kv[i] = (u32x4){0u, 0u, 0u, 0u}; vv[i] = (u32x4){0u, 0u, 0u, 0u}; }
        }
        float kf[32]; float ss = 0.f;
#pragma unroll
        for (int i = 0; i < 4; ++i)
#pragma unroll
            for (int j = 0; j < 4; ++j) { const float a = bflo(kv[i][j]), c = bfhi(kv[i][j]); kf[i * 8 + 2 * j] = a; kf[i * 8 + 2 * j + 1] = c; ss += a * a + c * c; }
        ss += __shfl_xor(ss, 1);
        const float rstd = rsqrtf(ss * (1.f / 64.f) + 1e-6f);
#pragma unroll
        for (int i = 0; i < 32; ++i) kf[i] *= rstd * kg[half * 32 + i];
#pragma unroll
        for (int i = 0; i < 4; ++i) *(LAS bf16x8*)(Ks + row * 72 + half * 32 + i * 8) = pack8(kf + i * 8);
        const int r32 = row & 31, kp = (row & ~31) + ((r32 & 15) >> 2) * 8 + (r32 >> 4) * 4 + (r32 & 3);
#pragma unroll
        for (int i = 0; i < 4; ++i)
#pragma unroll
            for (int j = 0; j < 4; ++j) { const unsigned w = vv[i][j]; Vt[(half * 32 + i * 8 + 2 * j) * 264 + kp] = (bf16_t)(w & 0xffffu); Vt[(half * 32 + i * 8 + 2 * j + 1) * 264 + kp] = (bf16_t)(w >> 16); }
    }
    __syncthreads();
    const int fr = lane & 15, fq = lane >> 4, hq = hk * 4 + (wid >> 1);
    const float sink = P.in[12][l * 8 + hq];
    for (int i = 0; i < 4; ++i) {
        if (var == 1) { asm volatile("s_waitcnt vmcnt(0) lgkmcnt(0)" ::: "memory"); __syncthreads(); }
        const int q0 = ((wid & 1) * 4 + i) * 16, kb0 = q0 >> 5;
        const bf16_t* qp = PA + (size_t)(b * SEQL + n * 128 + q0 + fr) * 768 + hq * 64 + fq * 8;
        const u32x4 qa = *(const u32x4*)qp, qb = *(const u32x4*)(qp + 32);
        float qf[16]; float ss = 0.f;
#pragma unroll
        for (int j = 0; j < 4; ++j) { qf[2 * j] = bflo(qa[j]); qf[2 * j + 1] = bfhi(qa[j]); qf[8 + 2 * j] = bflo(qb[j]); qf[8 + 2 * j + 1] = bfhi(qb[j]); }
#pragma unroll
        for (int j = 0; j < 16; ++j) ss += qf[j] * qf[j];
        ss += __shfl_xor(ss, 16); ss += __shfl_xor(ss, 32);
        const float rstd = rsqrtf(ss * (1.f / 64.f) + 1e-6f) * 0.125f;
#pragma unroll
        for (int j = 0; j < 8; ++j) { qf[j] *= rstd * qg[fq * 8 + j]; qf[8 + j] *= rstd * qg[32 + fq * 8 + j]; }
        const bf16x8 Q0 = pack8(qf), Q1 = pack8(qf + 8);
        f32x4 s[10];
#pragma unroll
        for (int tt = 0; tt < 10; ++tt) {
            const LAS bf16_t* kr = Ks + ((2 * kb0 + tt) * 16 + fr) * 72 + fq * 8;
            const bf16x8 K0 = *(const LAS bf16x8*)kr, K1 = *(const LAS bf16x8*)(kr + 32);
            f32x4 z = (f32x4){0.f, 0.f, 0.f, 0.f};
            z = __builtin_amdgcn_mfma_f32_16x16x32_bf16(K0, Q0, z, 0, 0, 0);
            s[tt] = __builtin_amdgcn_mfma_f32_16x16x32_bf16(K1, Q1, z, 0, 0, 0);
        }
        if (var == 3) {
#pragma unroll
            for (int tt = 0; tt < 10; ++tt) s[tt] = (f32x4){0.25f, 0.5f, 0.125f, 0.375f};
        }
        const int qi = q0 + fr;
        float m = sink;
#pragma unroll
        for (int tt = 0; tt < 10; ++tt)
#pragma unroll
            for (int j = 0; j < 4; ++j) {
                const int kidx = (2 * kb0 + tt) * 16 + fq * 4 + j;
                const bool vis = (kidx > qi) && (kidx <= qi + 128) && (n > 0 || kidx >= 128);
                const float sv = vis ? s[tt][j] : -INFINITY; s[tt][j] = sv; m = fmaxf(m, sv);
            }
        m = fmaxf(m, __shfl_xor(m, 16)); m = fmaxf(m, __shfl_xor(m, 32));
        float sum = 0.f;
#pragma unroll
        for (int tt = 0; tt < 10; ++tt)
#pragma unroll
            for (int j = 0; j < 4; ++j) { const float p = __expf(s[tt][j] - m); s[tt][j] = p; sum += p; }
        sum += __shfl_xor(sum, 16); sum += __shfl_xor(sum, 32);
        sum += __expf(sink - m);
        const float inv = 1.f / sum;
        f32x4 o[4];
#pragma unroll
        for (int dt = 0; dt < 4; ++dt) o[dt] = (f32x4){0.f, 0.f, 0.f, 0.f};
        if (var == 2) {
#pragma unroll
            for (int dt = 0; dt < 4; ++dt) o[dt] = s[dt] + s[4 + dt] + s[(8 + dt) > 9 ? 9 : 8 + dt];
        } else
        {
#pragma unroll
        for (int kb = 0; kb < 5; ++kb) {
            float pf[8];
#pragma unroll
            for (int j = 0; j < 4; ++j) { pf[j] = s[2 * kb][j] * inv; pf[4 + j] = s[2 * kb + 1][j] * inv; }
            const bf16x8 Pf = pack8(pf);
#pragma unroll
            for (int dt = 0; dt < 4; ++dt) {
                const bf16x8 Vf = *(const LAS bf16x8*)(Vt + (dt * 16 + fr) * 264 + (kb0 + kb) * 32 + fq * 8);
                o[dt] = __builtin_amdgcn_mfma_f32_16x16x32_bf16(Pf, Vf, o[dt], 0, 0, 0);
            }
        }
        }
#pragma unroll
        for (int dt = 0; dt < 4; ++dt)
#pragma unroll
            for (int j = 0; j < 4; ++j)
                Y[(size_t)(b * SEQL + n * 128 + q0 + fq * 4 + j) * 1024 + hq * 64 + dt * 16 + fr] = (bf16_t)(cvt_pk_bf16(o[dt][j], 0.f) & 0xffffu);
    }
    __syncthreads();
}

__device__ __forceinline__ void conv_part(const Params& P, int l, int tid, int bid, int nblk) {
    const bf16_t* PC = (const bf16_t*)(P.ws + OFF_R1 + R1_CONV);
    bf16_t* Y = (bf16_t*)(P.ws + OFF_HN);
    const float* cw = P.in[24] + l * 768;
    for (int idx = bid * 512 + tid; idx < NTOK * 32; idx += nblk * 512) {
        const int tok = idx >> 5, c = (idx & 31) * 8, t = tok & (SEQL - 1);
        const bf16_t* p = PC + (size_t)tok * 768 + c;
        const u32x4 bg = *(const u32x4*)p;
        float u[3][8];
#pragma unroll
        for (int d = 0; d < 3; ++d) {
            if (t >= d) { const u32x4 cg4 = *(const u32x4*)(p - d * 768 + 256), hg = *(const u32x4*)(p - d * 768 + 512);
#pragma unroll
                for (int j = 0; j < 4; ++j) { u[d][2 * j] = bflo(cg4[j]) * bflo(hg[j]); u[d][2 * j + 1] = bfhi(cg4[j]) * bfhi(hg[j]); }
            } else {
#pragma unroll
                for (int j = 0; j < 8; ++j) u[d][j] = 0.f;
            }
        }
        float y[8];
#pragma unroll
        for (int j = 0; j < 8; ++j) {
            const float bgv = (j & 1) ? bfhi(bg[j >> 1]) : bflo(bg[j >> 1]);
            y[j] = bgv * (cw[c + j] * u[2][j] + cw[256 + c + j] * u[1][j] + cw[512 + c + j] * u[0][j]);
        }
        *(bf16x8*)(Y + (size_t)tok * 1024 + 768 + c) = pack8(y);
    }
}

template <int MODE>
__device__ __forceinline__ void prep_tile(const Params& P, int l, int tile, LAS unsigned char* lds, int tid, int wid, int lane) {
    const bf16_t* PR = (const bf16_t*)(P.ws + OFF_R1 + R1_RWKV);
    unsigned char* REC = P.ws + OFF_R2;
    bf16_t* G = (bf16_t*)(P.ws + OFF_R2 + R2_G);
    float* BON = (float*)(P.ws + OFF_BONUS);
    LAS bf16_t* Xs = (LAS bf16_t*)lds;
    const float* mu = P.in[13] + l * 1024;
    const int tok0 = tile * 64;
    {
        const int t = tid >> 3, seg = tid & 7, tok = tok0 + t; const bool first = (tok & (SEQL - 1)) == 0;
        const bf16_t* p = PR + (size_t)tok * 1024 + 768 + seg * 32;
        const float c1 = seg < 2 ? 2.f : 1.f, c2 = seg < 2 ? 2.f : 1.f, c3 = seg < 2 ? -1.f : 0.f; const bool ident = (seg == 2 || seg == 3);
        if ((MODE == 0) == (seg < 4)) {
#pragma unroll
        for (int i = 0; i < 4; ++i) {
            float xo[8];
            const u32x4 ca = ((const u32x4*)p)[i], cp = first ? (u32x4){0u, 0u, 0u, 0u} : ((const u32x4*)(p - 1024))[i];
#pragma unroll
            for (int hh = 0; hh < 2; ++hh) {
                const f32x2_t a01 = f16x2_to_f32(ca[2 * hh]), a23 = f16x2_to_f32(ca[2 * hh + 1]), p01 = f16x2_to_f32(cp[2 * hh]), p23 = f16x2_to_f32(cp[2 * hh + 1]);
                const f32x4 a = (f32x4){a01[0], a01[1], a23[0], a23[1]};
                const f32x4 pv = (f32x4){p01[0], p01[1], p23[0], p23[1]};
                const f32x4 m = ((const f32x4*)(mu + 768 + seg * 32))[2 * i + hh];
                const f32x4 x = a + m * (pv - a);
#pragma unroll
                for (int j = 0; j < 4; ++j) { const float sg = sigmoid_f(c1 * x[j]) * c2 + c3; xo[hh * 4 + j] = ident ? x[j] : sg; }
            }
            *(LAS bf16x8*)(Xs + t * 264 + seg * 32 + i * 8) = pack8(xo);
        }
        }
    }
    __syncthreads();
    const int fr = lane & 15, fq = lane >> 4, hh = wid & 3;
    const bf16_t* WTw = (const bf16_t*)(P.ws + ((l & 1) ? OFF_LORA2 : OFF_LORA)); const bf16_t* WTa = WTw + 16384; const bf16_t* WTg = WTw + 32768;
    const float* w0 = P.in[14] + l * 256; const float* a0 = P.in[16] + l * 256; const float* k_k = P.in[19] + l * 256;
    const float* k_a = P.in[20] + l * 256; const float* r_k = P.in[21] + l * 256;
#pragma unroll
    for (int ti = 0; ti < 2; ++ti) {
        const int tq = (wid >> 2) * 2 + ti;
        bf16x8 xb[8];
#pragma unroll
        for (int ks = (MODE == 0 ? 0 : 4); ks < (MODE == 0 ? 4 : 8); ++ks) xb[ks] = *(const LAS bf16x8*)(Xs + (tq * 16 + fr) * 264 + ks * 32 + fq * 8);
        f32x4 aw[4], aa[4], ag[4];
#pragma unroll
        for (int ct = 0; ct < 4; ++ct) {
            const int col = hh * 64 + ct * 16 + fr;
            f32x4 z = (f32x4){0.f, 0.f, 0.f, 0.f};
            if (MODE == 0) {
#pragma unroll
            for (int ks = 0; ks < 2; ++ks) z = __builtin_amdgcn_mfma_f32_16x16x32_bf16(*(const bf16x8*)(WTw + col * 64 + ks * 32 + fq * 8), xb[ks], z, 0, 0, 0);
            aw[ct] = z; z = (f32x4){0.f, 0.f, 0.f, 0.f};
#pragma unroll
            for (int ks = 0; ks < 2; ++ks) z = __builtin_amdgcn_mfma_f32_16x16x32_bf16(*(const bf16x8*)(WTa + col * 64 + ks * 32 + fq * 8), xb[2 + ks], z, 0, 0, 0);
            aa[ct] = z; z = (f32x4){0.f, 0.f, 0.f, 0.f};
            } else {
#pragma unroll
            for (int ks = 0; ks < 4; ++ks) z = __builtin_amdgcn_mfma_f32_16x16x32_bf16(*(const bf16x8*)(WTg + col * 128 + ks * 32 + fq * 8), xb[4 + ks], z, 0, 0, 0);
            ag[ct] = z;
            }
        }
        const int tok = tok0 + tq * 16 + fr; const bool first = (tok & (SEQL - 1)) == 0;
        if (MODE == 1) {
#pragma unroll
            for (int ct = 0; ct < 4; ++ct) { const int c4 = hh * 64 + ct * 16 + fq * 4; uint2 go; go.x = cvt_pk_f16(ag[ct][0], ag[ct][1]); go.y = cvt_pk_f16(ag[ct][2], ag[ct][3]);
                *(uint2*)(G + (size_t)tok * 256 + c4) = go; }
            continue;
        }
        const bf16_t* pr = PR + (size_t)tok * 1024;
        unsigned char* rec = REC + ((size_t)tok * 4 + hh) * REC_B;
        f32x4 kkv[4], av[4]; float ss = 0.f, bon = 0.f;
        uint2 cur[4][3], prv[4][3];
#pragma unroll
        for (int ct = 0; ct < 4; ++ct)
#pragma unroll
            for (int q = 0; q < 3; ++q) {
                const int c4 = hh * 64 + ct * 16 + fq * 4;
                cur[ct][q] = *(const uint2*)(pr + q * 256 + c4);
                prv[ct][q] = first ? (uint2){0u, 0u} : *(const uint2*)(pr - 1024 + q * 256 + c4);
            }
#pragma unroll
        for (int ct = 0; ct < 4; ++ct) {
            const int c4 = hh * 64 + ct * 16 + fq * 4, lo = ct * 16 + fq * 4;
            f32x4 x3[3];
#pragma unroll
            for (int q = 0; q < 3; ++q) {
                const f32x4 m = *(const f32x4*)(mu + q * 256 + c4);
                const uint2 cu = cur[ct][q], pu = prv[ct][q];
                const f32x2_t c01 = f16x2_to_f32(cu.x), c23 = f16x2_to_f32(cu.y), q01 = f16x2_to_f32(pu.x), q23 = f16x2_to_f32(pu.y);
                const f32x4 cf = (f32x4){c01[0], c01[1], c23[0], c23[1]}, pf = (f32x4){q01[0], q01[1], q23[0], q23[1]};
                x3[q] = cf + m * (pf - cf);
            }
            const f32x4 r4 = x3[0], k4 = x3[1], v4 = x3[2];
            const f32x4 w0v = *(const f32x4*)(w0 + c4), a0v = *(const f32x4*)(a0 + c4), kkw = *(const f32x4*)(k_k + c4), kaw = *(const f32x4*)(k_a + c4), rkw = *(const f32x4*)(r_k + c4);
            f32x4 dec, a4, kp;
#pragma unroll
            for (int j = 0; j < 4; ++j) {
                const float w = w0v[j] + aw[ct][j];
                dec[j] = __builtin_amdgcn_exp2f((-0.6065306597126334f * 1.4426950408889634f) * sigmoid_f(w));
                a4[j] = sigmoid_f(a0v[j] + aa[ct][j]);
            }
            kkv[ct] = k4 * kkw; av[ct] = a4;
            kp = k4 * ((a4 - 1.0f) * kaw + 1.0f);
#pragma unroll
            for (int j = 0; j < 4; ++j) { ss += kkv[ct][j] * kkv[ct][j]; bon += r4[j] * kp[j] * rkw[j]; }
            *(f32x4*)(rec + lo * 4) = dec;
            { uint2 t; t.x = cvt_pk_f16(r4[0], r4[1]); t.y = cvt_pk_f16(r4[2], r4[3]); *(uint2*)(rec + 256 + 0 * 128 + lo * 2) = t;
              t.x = cvt_pk_f16(kp[0], kp[1]); t.y = cvt_pk_f16(kp[2], kp[3]); *(uint2*)(rec + 256 + 1 * 128 + lo * 2) = t;
              t.x = cvt_pk_f16(v4[0], v4[1]); t.y = cvt_pk_f16(v4[2], v4[3]); *(uint2*)(rec + 256 + 2 * 128 + lo * 2) = t; }
        }
        ss += __shfl_xor(ss, 16); ss += __shfl_xor(ss, 32); bon += __shfl_xor(bon, 16); bon += __shfl_xor(bon, 32);
        const float rn = ss > 1e-24f ? __builtin_amdgcn_rsqf(ss) : 1e12f;
#pragma unroll
        for (int ct = 0; ct < 4; ++ct) { const int lo = ct * 16 + fq * 4; const f32x4 kk = kkv[ct] * rn, ka = kk * av[ct]; uint2 t;
            t.x = cvt_pk_f16(kk[0], kk[1]); t.y = cvt_pk_f16(kk[2], kk[3]); *(uint2*)(rec + 256 + 3 * 128 + lo * 2) = t;
            t.x = cvt_pk_f16(ka[0], ka[1]); t.y = cvt_pk_f16(ka[2], ka[3]); *(uint2*)(rec + 256 + 4 * 128 + lo * 2) = t; }
        if (fq == 0) BON[(size_t)tok * 4 + hh] = bon;
    }
    __syncthreads();
}

__device__ __forceinline__ void scan_stage_piece(LAS float* buf, int idx, u32x4 w) {
    const int s = idx / 56, o = idx % 56;
    if (o < 16) { *(LAS u32x4*)(buf + s * 384 + 64 + o * 4) = w; }
    else {
        const int p = o - 16, q = p >> 3, j = p & 7, dq = q == 0 ? 0 : q + 1;
        LAS float* d = buf + s * 384 + dq * 64 + j * 8;
        const f32x2_t e0 = f16x2_to_f32(w[0]), e1 = f16x2_to_f32(w[1]), e2 = f16x2_to_f32(w[2]), e3 = f16x2_to_f32(w[3]);
        *(LAS f32x4*)d = (f32x4){e0[0], e0[1], e1[0], e1[1]};
        *(LAS f32x4*)(d + 4) = (f32x4){e2[0], e2[1], e3[0], e3[1]};
    }
}
__device__ __forceinline__ void phase_scan(const Params& P, LAS unsigned char* lds, int tid, int wid, int lane, int bid, int nblk) {
    const unsigned char* REC = P.ws + OFF_R2;
    float* YS = (float*)(P.ws + OFF_YS);
    for (int item = bid; item < 128; item += nblk) {
        const int bh = (item & 7) * 4 + ((item >> 3) & 3), rg = item >> 5, b = bh >> 2, h = bh & 3;
        const unsigned char* src0 = REC + ((size_t)(b * SEQL) * 4 + h) * REC_B;
        u32x4 st[7]; const int ltid = tid - 256;
        if (wid >= 4) {
#pragma unroll
            for (int i = 0; i < 7; ++i) { const int idx = ltid + 256 * i, s = idx / 56, o = idx % 56; st[i] = *(const u32x4*)(src0 + (size_t)s * (4 * REC_B) + o * 16); }
#pragma unroll
            for (int i = 0; i < 7; ++i) scan_stage_piece((LAS float*)lds, ltid + 256 * i, st[i]);
        }
        __syncthreads();
        typedef float f32x2v __attribute__((ext_vector_type(2)));
        f32x2v Sa = {0.f, 0.f}, Sb = {0.f, 0.f};
        const int rl = lane >> 4, kq = lane & 15, row = rg * 16 + (wid & 3) * 4 + rl;
        for (int ch = 0; ch < 128; ++ch) {
            if (wid >= 4 && ch + 1 < 128) {
#pragma unroll
                for (int i = 0; i < 7; ++i) { const int idx = ltid + 256 * i, s = idx / 56, o = idx % 56; st[i] = *(const u32x4*)(src0 + (size_t)((ch + 1) * 32 + s) * (4 * REC_B) + o * 16); }
            }
            if (wid < 4) {
                const LAS float* buf = (const LAS float*)(lds + (ch & 1) * 49152);
                float* yp = YS + (size_t)(b * SEQL + ch * 32 + kq) * 256 + h * 64 + row;
                const LAS float* rc = buf + kq * 4;
                const LAS float* rv = buf + 192 + row;
                f32x4 r4 = *(const LAS f32x4*)(rc), w4 = *(const LAS f32x4*)(rc + 64), k4 = *(const LAS f32x4*)(rc + 128), kk4 = *(const LAS f32x4*)(rc + 256), ka4 = *(const LAS f32x4*)(rc + 320);
                float v = rv[0];
                float oacc = 0.f;
#define LO2(x) __builtin_shufflevector(x, x, 0, 1)
#define HI2(x) __builtin_shufflevector(x, x, 2, 3)
#pragma unroll
                for (int s = 0; s < 32; ++s) {
                    f32x4 nr4 = r4, nw4 = w4, nk4 = k4, nkk4 = kk4, nka4 = ka4; float nv = v;
                    if (s + 1 < 32) {
                        const LAS float* rn = rc + (s + 1) * 384;
                        nr4 = *(const LAS f32x4*)(rn); nw4 = *(const LAS f32x4*)(rn + 64); nk4 = *(const LAS f32x4*)(rn + 128); nkk4 = *(const LAS f32x4*)(rn + 256); nka4 = *(const LAS f32x4*)(rn + 320);
                        nv = rv[(s + 1) * 384];
                    }
                    f32x2v d2 = Sa * LO2(kk4); d2 = Sb * HI2(kk4) + d2;
                    const float d = rowsum16(d2[0] + d2[1]);
                    const f32x2v vv = {v, v}, dd = {d, d};
                    f32x2v ta = Sa * LO2(w4), tb = Sb * HI2(w4);
                    ta = vv * LO2(k4) + ta; tb = vv * HI2(k4) + tb;
                    Sa = ta - dd * LO2(ka4); Sb = tb - dd * HI2(ka4);
                    f32x2v o2 = Sa * LO2(r4); o2 = Sb * HI2(r4) + o2;
                    const float o = rowsum16(o2[0] + o2[1]);
                    oacc = (kq == (s & 15)) ? o : oacc;
                    if ((s & 15) == 15) yp[(size_t)(s - 15) * 256] = oacc;
                    r4 = nr4; w4 = nw4; k4 = nk4; kk4 = nkk4; ka4 = nka4; v = nv;
                }
#undef LO2
#undef HI2
            }
            if (wid >= 4 && ch + 1 < 128) {
#pragma unroll
                for (int i = 0; i < 7; ++i) scan_stage_piece((LAS float*)(lds + ((ch + 1) & 1) * 49152), ltid + 256 * i, st[i]);
            }
            __syncthreads();
        }
    }
}

__device__ __forceinline__ void phase_post(const Params& P, int l, int tid, int bid, int nblk) {
    const float* YS = (const float*)(P.ws + OFF_YS);
    const unsigned char* REC = P.ws + OFF_R2;
    const bf16_t* G = (const bf16_t*)(P.ws + OFF_R2 + R2_G);
    const float* BON = (const float*)(P.ws + OFF_BONUS);
    bf16_t* Y = (bf16_t*)(P.ws + OFF_HN);
    const float* gw = P.in[22] + l * 256; const float* gb = P.in[23] + l * 256;
    const int stride = nblk * 512;
    for (int base = bid * 512 + tid; base < NTOK * 64; base += 4 * stride) {
        f32x4 y[4]; uint2 vu[4], gg[4]; float bon[4];
#pragma unroll
        for (int j = 0; j < 4; ++j) {
            const int idx = base + j * stride;
            if (idx < NTOK * 64) {
                const int l16 = idx & 15, th = idx >> 4, tok = th >> 2, h = th & 3, c = h * 64 + l16 * 4;
                y[j] = *(const f32x4*)(YS + (size_t)tok * 256 + c);
                vu[j] = *(const uint2*)(REC + ((size_t)tok * 4 + h) * REC_B + 256 + 2 * 128 + l16 * 8);
                gg[j] = *(const uint2*)(G + (size_t)tok * 256 + c);
                bon[j] = BON[(size_t)tok * 4 + h];
            }
        }
#pragma unroll
        for (int j = 0; j < 4; ++j) {
            const int idx = base + j * stride;
            if (idx < NTOK * 64) {
                const int l16 = idx & 15, th = idx >> 4, tok = th >> 2, h = th & 3, c = h * 64 + l16 * 4;
                const float mean = rowsum16((y[j][0] + y[j][1]) + (y[j][2] + y[j][3])) * (1.f / 64.f);
                const f32x4 d = y[j] - mean;
                const float var = rowsum16((d[0] * d[0] + d[1] * d[1]) + (d[2] * d[2] + d[3] * d[3])) * (1.f / 64.f);
                const float rs = rsqrtf(var + 64e-5f);
                const f32x2_t v01 = f16x2_to_f32(vu[j].x), v23 = f16x2_to_f32(vu[j].y), g01 = f16x2_to_f32(gg[j].x), g23 = f16x2_to_f32(gg[j].y);
                const f32x4 v4 = (f32x4){v01[0], v01[1], v23[0], v23[1]}, g4 = (f32x4){g01[0], g01[1], g23[0], g23[1]};
                const f32x4 o = ((d * rs) * *(const f32x4*)(gw + c) + *(const f32x4*)(gb + c) + v4 * bon[j]) * g4;
                uint2 ov; ov.x = cvt_pk_bf16(o[0], o[1]); ov.y = cvt_pk_bf16(o[2], o[3]);
                *(uint2*)(Y + (size_t)tok * 1024 + 512 + c) = ov;
            }
        }
    }
}

#define XB_TMO      128
#define XB_XCNT(j)  (256  + 64 * (j))
#define XB_XSUB(j)  (1280 + 64 * (j))
#define XB_XGEN(j)  (2304 + 64 * (j))
#define XB_TOP      3328
#define XB_TOPGEN   3392
#define XCD_BAR_WORDS 3456
#define XB_SPIN_CAP (1u << 18)

__device__ __forceinline__ unsigned xb_ld(unsigned* p)              { return __hip_atomic_load(p, __ATOMIC_RELAXED, __HIP_MEMORY_SCOPE_AGENT); }
__device__ __forceinline__ unsigned xb_add(unsigned* p, unsigned v) { return __hip_atomic_fetch_add(p, v, __ATOMIC_RELAXED, __HIP_MEMORY_SCOPE_AGENT); }
__device__ __forceinline__ unsigned xb_xcc_id() { return (unsigned)__builtin_amdgcn_s_getreg((3 << 11) | 20) & 0xFu; }
#define XB_SPIN(cond, bar) do { unsigned _sp = 0; while (cond) { __builtin_amdgcn_s_sleep(1); \
    if ((++_sp & 255u) == 0u) { if (xb_ld(&(bar)[XB_TMO])) break; if (_sp > XB_SPIN_CAP) { atomicAdd(&(bar)[XB_TMO], 1u); break; } } } } while (0)

struct XcdBarrier {
    unsigned* bar; unsigned x;
    volatile LAS unsigned* st;
};

__device__ __forceinline__ XcdBarrier xcd_barrier_post(unsigned* bar, volatile LAS unsigned* st) {
    XcdBarrier b; b.bar = bar; b.x = xb_xcc_id(); b.st = st;
    if (threadIdx.x == 0) (void)xb_add(&bar[XB_XCNT(b.x)], 1u);
    return b;
}
__device__ __forceinline__ void xcd_barrier_complete(unsigned* bar, unsigned x, unsigned& nloc, unsigned& nx) {
    const unsigned G = gridDim.x * gridDim.y * gridDim.z;
    unsigned sum, cnt, mine, sp = 0u;
    for (;;) {
        sum = 0u; cnt = 0u; mine = 0u;
#pragma unroll
        for (unsigned j = 0; j < 16; ++j) { const unsigned c = xb_ld(&bar[XB_XCNT(j)]); sum += c; cnt += (c > 0u) ? 1u : 0u; mine = (j == x) ? c : mine; }
        if (sum == G) break;
        __builtin_amdgcn_s_sleep(1);
        if ((++sp & 255u) == 0u) { if (xb_ld(&bar[XB_TMO])) break; if (sp > XB_SPIN_CAP) { atomicAdd(&bar[XB_TMO], 1u); break; } }
    }
    nloc = mine > 0u ? mine : 1u; nx = cnt > 0u ? cnt : 1u;
}

__device__ __forceinline__ void xcd_barrier(const XcdBarrier& b) {
    asm volatile("s_waitcnt vmcnt(0)" ::: "memory");
    __syncthreads();
    if (threadIdx.x == 0) {
        unsigned* bar = b.bar;
        __builtin_amdgcn_s_waitcnt(0);
        unsigned nloc = b.st[0], nx = b.st[1];
        if (nloc == 0u) { xcd_barrier_complete(bar, b.x, nloc, nx); b.st[0] = nloc; b.st[1] = nx; }
        const unsigned old = xb_add(&bar[XB_XSUB(b.x)], 1u);
        const unsigned gen = old / nloc;
        if (old + 1u == (gen + 1u) * nloc) {
            __builtin_amdgcn_fence(__ATOMIC_RELEASE, "agent");
            asm volatile("s_waitcnt vmcnt(0)" ::: "memory");
            const unsigned og = xb_add(&bar[XB_TOP], 1u);
            const unsigned tg = og / nx;
            if (og + 1u == (tg + 1u) * nx) xb_add(&bar[XB_TOPGEN], 1u);
            else XB_SPIN(xb_ld(&bar[XB_TOPGEN]) == tg, bar);
            __builtin_amdgcn_fence(__ATOMIC_ACQUIRE, "agent");
            xb_add(&bar[XB_XGEN(b.x)], 1u);
            asm volatile("s_waitcnt vmcnt(0)" ::: "memory");
        } else {
            XB_SPIN(xb_ld(&bar[XB_XGEN(b.x)]) == gen, bar);
            __builtin_amdgcn_fence(__ATOMIC_ACQUIRE, "agent");
            asm volatile("s_waitcnt vmcnt(0)" ::: "memory");
        }
    }
    __syncthreads();
}


__global__ __launch_bounds__(512, 2) void mega(Params P) {
    extern __shared__ __attribute__((aligned(16))) unsigned char shm[];
    LAS unsigned char* lds = (LAS unsigned char*)shm;
    const int nblk = gridDim.x;
    volatile LAS unsigned* bst = (volatile LAS unsigned*)(lds + 131072);
    if (threadIdx.x < 2) bst[threadIdx.x] = 0u;
    __syncthreads();
    const XcdBarrier xbar = xcd_barrier_post((unsigned*)(P.ws + WS_BAR), bst);
    float* MOD = (float*)(P.ws + OFF_MOD);
    bf16_t* HN = (bf16_t*)(P.ws + OFF_HN);
    bf16_t* ACT = (bf16_t*)(P.ws + OFF_R1);
#ifdef DIAG_TIME
    unsigned long long tA = 0, tB = 0, tprev = __builtin_amdgcn_s_memrealtime();
#endif
    for (int ph = P.ph_lo; ph < P.ph_hi; ++ph) {
#ifdef DBL_PHASE
      for (int rep = (ph > 0 && DBL_PHASE((ph - 1) % PPL)) ? 0 : 1; rep < 2; ++rep) {
#endif
        int tid = threadIdx.x, bid = blockIdx.x;
        asm volatile("" : "+v"(tid)); asm volatile("" : "+s"(bid));
        const int wid = __builtin_amdgcn_readfirstlane(tid >> 6), lane = tid & 63;
        if (ph == 0) {
#ifndef NO_MOD
            phase_mod(P, lds, tid, wid, lane, bid, nblk);
#endif
            phase_convert(P, 0, lds, wid, lane, bid, nblk);
#ifdef DIAG_POISON
            { u32x4* w = (u32x4*)(P.ws + OFF_LORA); const size_t n16 = (WS_END - OFF_LORA) / 16;
              for (size_t i = (size_t)bid * 512 + tid; i < n16; i += (size_t)nblk * 512) w[i] = (u32x4){0xAAAAAAAAu, 0xAAAAAAAAu, 0xAAAAAAAAu, 0xAAAAAAAAu}; }
#endif
        } else {
            const int l = (ph - 1) / PPL, s = (ph - 1) % PPL;
            bf16_t* HB = (bf16_t*)(P.ws + OFF_HB);
            const bool first_h = (l == 0 && s < 3), last_h = (l == DEPTH - 1 && s == PPL - 1);
            const void* hin = first_h ? (const void*)P.in[0] : (const void*)HB;
            void* hout = last_h ? (void*)P.out : (void*)HB;
            const float* modl = MOD + (size_t)l * 8 * 9216;
            bf16_t* WB = (bf16_t*)(P.ws + ((l & 1) ? OFF_WB2 : OFF_WB));
            pg8::Gemm g{HN, WB, NTOK, 1024, 1024}; pg8::EpiAny E{}; bool is_gemm = true;
            switch (s) {
            case 0:
#ifndef NO_NORM
                if (first_h) phase_norm<true>(P, hin, P.in[4] + l * 1024, modl, wid, lane, bid, nblk); else phase_norm<false>(P, hin, P.in[4] + l * 1024, modl, wid, lane, bid, nblk);
#endif
                is_gemm = false; break;
            case 1: g.Bt = WB + WB_FFN1IN; g.N = 2 * DFF; E.kind = 0; E.perm = true; E.sw.O = ACT; break;
            case 2: g.A = ACT; g.Bt = WB + WB_FFN1OUT; g.K = DFF; E.kind = 1; E.perm = true; E.rs = pg8::EpiResid{hin, hout, modl + 2 * 1024, 0.5f, first_h ? 1 : 0, last_h ? 1 : 0}; break;
            case 3: phase_norm<false>(P, hin, P.in[7] + l * 1024, modl + 3 * 1024, wid, lane, bid, nblk); is_gemm = false; break;
            case 4: g.Bt = WB + WB_MIXIN; g.N = 2560; E.kind = 2; E.perm = true; E.pj = pg8::EpiProj{(bf16_t*)(P.ws + OFF_R1), (bf16_t*)(P.ws + OFF_R1 + R1_RWKV), (bf16_t*)(P.ws + OFF_R1 + R1_CONV)}; break;
            case 5:
                for (int it = bid; it < 512; it += nblk) prep_tile<0>(P, l, it, lds, tid, wid, lane);
                is_gemm = false; break;
            case 6: {
                const int nscan = nblk >> 1;
                if (bid < nscan) phase_scan(P, lds, tid, wid, lane, bid, nscan);
                else {
                    const int vb = bid - nscan, vn = nblk - nscan;
                    for (int it = vb; it < 512; it += vn) attn_item(P, l, it, lds, tid, wid, lane, P.ph_lo < 0 ? 0 : ATTN_VAR(l));
                    conv_part(P, l, tid, vb, vn);
                    for (int it = vb; it < 512; it += vn) prep_tile<1>(P, l, it, lds, tid, wid, lane);
                    if (l + 1 < DEPTH) phase_convert(P, l + 1, lds, wid, lane, vb, vn);
                }
                is_gemm = false; } break;
            case 7: phase_post(P, l, tid, bid, nblk); is_gemm = false; break;
            case 8: g.Bt = WB + WB_MIXOUT; E.kind = 1; E.perm = true; E.rs = pg8::EpiResid{hin, hout, modl + 5 * 1024, 1.0f, first_h ? 1 : 0, last_h ? 1 : 0}; break;
            case 9: phase_norm<false>(P, hin, P.in[25] + l * 1024, modl + 6 * 1024, wid, lane, bid, nblk); is_gemm = false; break;
            case 10: g.Bt = WB + WB_FFN2IN; g.N = 2 * DFF; E.kind = 0; E.perm = true; E.sw.O = ACT; break;
            default: g.A = ACT; g.Bt = WB + WB_FFN2OUT; g.K = DFF; E.kind = 1; E.perm = true; E.rs = pg8::EpiResid{hin, hout, modl + 8 * 1024, 0.5f, first_h ? 1 : 0, last_h ? 1 : 0}; break;
            }
            if (is_gemm) { pg8::StaticOrder S; S.init(NTOK, g.N, nblk, bid); pg8::gemm_phase<pg8::EpiAny, pg8::StaticOrder, GEMM_ALIGN, GEMM_SP2>(lds, g, S, E, tid); }
        }
#ifdef DIAG_TIME
        const unsigned long long twork = __builtin_amdgcn_s_memrealtime();
        cg::this_grid().sync();
        { const unsigned long long tnow = __builtin_amdgcn_s_memrealtime(); const int sx = ph == 0 ? -1 : (ph - 1) % PPL;
          if (TSEL_A(sx)) tA += (TWAIT_A ? tnow - twork : tnow - tprev);
          if (TSEL_B(sx)) tB += (TWAIT_B ? tnow - twork : tnow - tprev);
          tprev = tnow; }
#else
#ifdef DBL_PHASE
        cg::this_grid().sync();
      }
#else
        if (ph + 1 < P.ph_hi) { if (P.ph_hi > 100000) cg::this_grid().sync(); else xcd_barrier(xbar); }
#ifdef EXTRA_SYNC
        if (ph + 1 < P.ph_hi) { cg::this_grid().sync(); }
#endif
#endif
#endif
    }
#ifdef DIAG_TIME
    {
        unsigned long long* tw = (unsigned long long*)(P.ws + WS_END);
        if (blockIdx.x == 0 && threadIdx.x == 0) { tw[0] = tA; tw[1] = tB; __threadfence(); }
        cg::this_grid().sync();
        const float fa = (float)__hip_atomic_load(tw, __ATOMIC_RELAXED, __HIP_MEMORY_SCOPE_AGENT) * 0.01f * 100.0f, fb = (float)__hip_atomic_load(tw + 1, __ATOMIC_RELAXED, __HIP_MEMORY_SCOPE_AGENT) * 0.01f;
        for (size_t i = (size_t)blockIdx.x * 512 + threadIdx.x; i < (size_t)NTOK * 1024; i += (size_t)gridDim.x * 512) P.out[i] = (i == 0) ? fa : fb;
    }
#endif
}


#ifdef DIAG_SELFTEST
__global__ void diag_checksum(const unsigned* p, size_t nwords, unsigned long long* slot) {
    unsigned long long acc = 0;
    for (size_t i = (size_t)blockIdx.x * blockDim.x + threadIdx.x; i < nwords; i += (size_t)gridDim.x * blockDim.x) acc += (unsigned long long)p[i] * (unsigned long long)(2 * i + 1);
    for (int o = 1; o < 64; o <<= 1) acc += __shfl_xor(acc, o);
    if ((threadIdx.x & 63) == 0) atomicAdd(slot, acc);
}
__global__ void diag_report(const unsigned long long* slots, int nitems, int nrep, float* out, size_t n) {
    int code = 0;
    for (int k = 0; k < nitems; ++k) for (int r = 1; r < nrep; ++r) if (slots[k * nrep + r] != slots[k * nrep]) { code |= 1 << k; break; }
    if (code == 0) return;
    const float c = 4.0f * exp2f((float)code);
    for (size_t i = (size_t)blockIdx.x * blockDim.x + threadIdx.x; i < n; i += (size_t)gridDim.x * blockDim.x) out[i] = c;
}
#endif
extern "C" void kernel_launch(void* const* d_in, const int* in_sizes, int n_in, void* d_out, int out_size, void* d_ws, size_t ws_size, hipStream_t stream) {
    static int grid = 0;
    if (grid == 0) {
        if (n_in != 28 || out_size != NTOK * DM || ws_size < WS_END) { fprintf(stderr, "kernel_launch: unexpected shapes (n_in %d out %d ws %zu need %zu)\n", n_in, out_size, ws_size, (size_t)WS_END); grid = -1; return; }
        int dev = 0, cus = 0, per_cu = 0;
        hipGetDevice(&dev); hipDeviceGetAttribute(&cus, hipDeviceAttributeMultiprocessorCount, dev);
        if (hipFuncSetAttribute((const void*)mega, hipFuncAttributeMaxDynamicSharedMemorySize, LDS_BYTES) != hipSuccess) { fprintf(stderr, "kernel_launch: hipFuncSetAttribute failed\n"); grid = -1; return; }
        if (hipOccupancyMaxActiveBlocksPerMultiprocessor(&per_cu, (const void*)mega, 512, LDS_BYTES) != hipSuccess || per_cu < 1) { fprintf(stderr, "kernel_launch: occupancy query failed (%d)\n", per_cu); per_cu = 1; (void)hipGetLastError(); }
        grid = cus * per_cu;
    }
    if (grid < 0) return;
    Params p{};
    for (int i = 0; i < 28; ++i) p.in[i] = (const float*)d_in[i];
    p.out = (float*)d_out; p.ws = (unsigned char*)d_ws;
#if MK_LAUNCHES == 1
    if (hipMemsetAsync((unsigned char*)d_ws + WS_BAR, 0, 16384, stream) != hipSuccess) { fprintf(stderr, "kernel_launch: memset of barrier words failed\n"); return; }
    p.ph_lo = 0; p.ph_hi = NPH;
    void* args[] = {&p};
    hipError_t e = hipLaunchCooperativeKernel((const void*)mega, dim3(grid), dim3(512), args, LDS_BYTES, stream);
    if (e != hipSuccess) fprintf(stderr, "cooperative launch failed: %s (grid %d)\n", hipGetErrorString(e), grid);
#else
#ifdef DIAG_SELFTEST
    {
        constexpr int NREP = 4;
        unsigned long long* slots = (unsigned long long*)((unsigned char*)d_ws + WS_END);
        hipMemsetAsync(slots, 0, 64 * NREP * 8, stream);
        int item = 0;
        for (int ph = 0; ph < NPH; ++ph) {
            p.ph_lo = ph; p.ph_hi = ph + 1; hipLaunchKernelGGL(mega, dim3(grid), dim3(512), LDS_BYTES, stream, p);
            if (ph == 0) continue;
            const int l = (ph - 1) / PPL, s = (ph - 1) % PPL;
            size_t off = 0, len = 0; bool test = (s == 5);
            switch (s) {
            case 0: off = OFF_LORA; len = OFF_R1 - OFF_LORA; break;
            case 1: case 12: off = OFF_R1; len = (size_t)NTOK * DFF * 2; break;
            case 2: test = false; break;
            case 3: case 5: case 7: case 9: case 11: off = OFF_HN; len = (size_t)NTOK * 1024 * 2; break;
            case 4: off = OFF_R1; len = R1_BYTES; break;
            case 6: off = OFF_R2; len = WS_END - OFF_R2; break;
            case 8: off = OFF_R1 + R1_RWKV; len = (size_t)NTOK * 256 * 4; break;
            default: test = false; break;
            }
            if (!test) continue;
            const unsigned* base = (s == 2) ? (const unsigned*)d_out : (const unsigned*)((unsigned char*)d_ws + off);
            const size_t nw = (s == 2) ? (size_t)NTOK * 1024 : len / 4;
            for (int r = 0; r < NREP; ++r) {
                if (r > 0) hipLaunchKernelGGL(mega, dim3(grid), dim3(512), LDS_BYTES, stream, p);
                hipLaunchKernelGGL(diag_checksum, dim3(2048), dim3(256), 0, stream, base, nw, slots + item * NREP + r);
            }
            ++item;
        }
        hipLaunchKernelGGL(diag_report, dim3(2048), dim3(256), 0, stream, (const unsigned long long*)slots, item, NREP, (float*)d_out, (size_t)NTOK * 1024);
    }
#else
    for (int ph = 0; ph < NPH; ++ph) { p.ph_lo = ph; p.ph_hi = ph + 1; hipLaunchKernelGGL(mega, dim3(grid), dim3(512), LDS_BYTES, stream, p); }
#endif
#endif
}
```

```cpp
#define ATTN_VAR(l) (P.ph_hi > 100000 ? (l) + 1 : 0)
#define GEMM_ALIGN true
#define GEMM_SP2 true
#include <hip/hip_runtime.h>
#include <hip/hip_cooperative_groups.h>
#include <cstdio>
#include <cstdint>
namespace cg = cooperative_groups;

#ifndef MK_LAUNCHES
#define MK_LAUNCHES 1
#endif

namespace pg8 {
#define PG8_LAS __attribute__((address_space(3)))
typedef unsigned short bf16_t;
typedef short bf16x8 __attribute__((ext_vector_type(8)));
typedef float f32x4 __attribute__((ext_vector_type(4)));
typedef unsigned u32x4 __attribute__((ext_vector_type(4)));
constexpr int BM = 256, BK = 64, HALF = 128, HTB = HALF * BK * 2  , STAGE_BYTES = 8 * HTB, NXCD = 8, WGM = 8;

__host__ __device__ __forceinline__ int lds_byte(int r, int c) { const int st = (r >> 4) * 2 + (c >> 5), rr = r & 15, cc = c & 31, ob = rr * 64 + cc * 2; return st * 1024 + (ob ^ (((ob >> 9) & 1) << 5)); }
__host__ __device__ __forceinline__ void stage_rc(int b, int& R, int& C) { const int st = b / 1024, sb = b % 1024, swz = sb ^ (((sb >> 9) & 1) << 5); R = (st >> 1) * 16 + swz / 64; C = (st & 1) * 32 + (swz % 64) / 2; }
__host__ __device__ __forceinline__ int perm32(int rho) { const int n = rho >> 4, i = rho & 15; return 8 * (i >> 2) + 4 * n + (i & 3); }

struct Unit { int pm, pn; };
struct Gemm { const bf16_t* A; const bf16_t* Bt; int M, N, K; };

struct StaticOrder {
    int nM, nN, nwg, G, c;
    __host__ __device__ void init(int M, int N, int G_, int c_) { nM = M / BM; nN = N / BM; nwg = nM * nN; G = G_; c = c_; }
    __host__ __device__ bool next(int i, Unit& u) const {
        const long L = (long)i * G + c; if (L >= nwg) return false;
        int wgid = (int)L; { const int q = nwg / NXCD, r = nwg % NXCD, xcd = wgid % NXCD, off = wgid / NXCD; wgid = (xcd < r ? xcd * (q + 1) : r * (q + 1) + (xcd - r) * q) + off; }
        const int nig = WGM * nN, gid = wgid / nig, fm = gid * WGM, gsz = (nM - fm) < WGM ? (nM - fm) : WGM;
        u.pm = fm + ((wgid % nig) % gsz); u.pn = (wgid % nig) / gsz; return true;
    }
    __device__ __forceinline__ void a_ready(const Unit&) const {}
    __device__ __forceinline__ void done(const Unit&) const {}
};
typedef __bf16 bf16v2_t __attribute__((ext_vector_type(2)));
typedef float f32x2_t __attribute__((ext_vector_type(2)));
__device__ __forceinline__ unsigned cvt_pk_bf16(float lo, float hi) { const f32x2_t v = {lo, hi}; const bf16v2_t b = __builtin_convertvector(v, bf16v2_t); return __builtin_bit_cast(unsigned, b); }

typedef _Float16 h16x2_t __attribute__((ext_vector_type(2)));
__device__ __forceinline__ unsigned cvt_pk_f16(float lo, float hi) { const f32x2_t v = {lo, hi}; const h16x2_t h = __builtin_convertvector(v, h16x2_t); return __builtin_bit_cast(unsigned, h); }
__device__ __forceinline__ f32x2_t f16x2_to_f32(unsigned u) { const h16x2_t h = __builtin_bit_cast(h16x2_t, u); return __builtin_convertvector(h, f32x2_t); }
template <class Epi, class Sched, bool ALIGN_EPI = false, bool SP2 = false>
__device__ __forceinline__ void gemm_phase(PG8_LAS unsigned char* lds, const Gemm g, const Sched& S, const Epi& E, const int tid) {
    const int wid = __builtin_amdgcn_readfirstlane(tid >> 6), lane = tid & 63, wr = wid >> 2, wc = wid & 3, fr = lane & 15, fq = lane >> 4;
    const int K = g.K, nt = K / BK;
    unsigned voffA[2], voffB[2];
#pragma unroll
    for (int i = 0; i < 2; ++i) { int R, C; stage_rc(tid * 16 + i * 8192, R, C); const int Rb = E.perm ? ((R & ~31) + perm32(R & 31)) : R;
        voffA[i] = (unsigned)(R * K + C) * 2u; voffB[i] = (unsigned)(Rb * K + C) * 2u; }
    const size_t kstep = (size_t)(BK * 2);
    const size_t hstep = (size_t)HALF * K * 2;
    const size_t tstep = 2 * hstep;
    const unsigned ldsw = (unsigned)wid * 1024u;
    const int aoff = lds_byte(wr * 64 + fr, fq * 8), boff = lds_byte(wc * 32 + fr, fq * 8);
#define PG8_SA(b, h) (((b) * 2 + (h)) * HTB)
#define PG8_SB(b, h) ((4 + (b) * 2 + (h)) * HTB)
#define PG8_STAGE(bufoff, gbase, voff) do { _Pragma("unroll") for (int _i = 0; _i < 2; ++_i) \
        __builtin_amdgcn_global_load_lds((const unsigned*)((const char*)(gbase) + (voff)[_i]), (PG8_LAS unsigned*)(lds + (bufoff) + ldsw + _i * 8192), 16, 0, 0); } while (0)
#define PG8_LDA(dst, b, h) do { _Pragma("unroll") for (int m = 0; m < 4; ++m) _Pragma("unroll") for (int k = 0; k < 2; ++k) dst[m][k] = *(const PG8_LAS bf16x8*)(lds + PG8_SA(b, h) + aoff + m * 2048 + k * 1024); } while (0)
#define PG8_LDB(dst, b, h) do { _Pragma("unroll") for (int n = 0; n < 2; ++n) _Pragma("unroll") for (int k = 0; k < 2; ++k) dst[n][k] = *(const PG8_LAS bf16x8*)(lds + PG8_SB(b, h) + boff + n * 2048 + k * 1024); } while (0)
#define PG8_MMA(ai, bj, At, Bt) do { __builtin_amdgcn_s_setprio(1); _Pragma("unroll") for (int m = 0; m < 4; ++m) _Pragma("unroll") for (int n = 0; n < 2; ++n) _Pragma("unroll") for (int k = 0; k < 2; ++k) \
        acc[ai][bj][m][n] = __builtin_amdgcn_mfma_f32_16x16x32_bf16(Bt[n][k], At[m][k], acc[ai][bj][m][n], 0, 0, 0); __builtin_amdgcn_s_setprio(0); } while (0)
#define PG8_WAIT_V(n) asm volatile("s_waitcnt vmcnt(" #n ")" ::: "memory")
#define PG8_WAIT_L(n) asm volatile("s_waitcnt lgkmcnt(" #n ")" ::: "memory")
#define PG8_BAR __builtin_amdgcn_s_barrier()
#define PG8_SCHED __builtin_amdgcn_sched_barrier(0)
    Unit cur, nxt; int ui = 0;
    if (!S.next(0, cur)) return;
    f32x4 acc[2][2][4][2];
#pragma unroll
    for (int a = 0; a < 2; ++a)
#pragma unroll
        for (int b = 0; b < 2; ++b)
#pragma unroll
            for (int m = 0; m < 4; ++m)
#pragma unroll
                for (int n = 0; n < 2; ++n) acc[a][b][m][n] = (f32x4){0.f, 0.f, 0.f, 0.f};
    bf16x8 At[4][2], B0[2][2], B1[2][2];
    const char* cA = (const char*)g.A + (size_t)cur.pm * tstep; const char* cB = (const char*)g.Bt + (size_t)cur.pn * tstep;
    S.a_ready(cur);
    if constexpr (SP2) {
        PG8_STAGE(PG8_SB(0, 0), cB, voffB); PG8_STAGE(PG8_SB(0, 1), cB + hstep, voffB); PG8_STAGE(PG8_SA(0, 0), cA, voffA); PG8_STAGE(PG8_SA(0, 1), cA + hstep, voffA);
        if (wr == 1) PG8_BAR;
        PG8_WAIT_V(2); PG8_BAR;
        PG8_STAGE(PG8_SB(1, 0), cB + kstep, voffB); PG8_STAGE(PG8_SA(1, 0), cA + kstep, voffA); PG8_STAGE(PG8_SB(1, 1), cB + hstep + kstep, voffB);
        PG8_WAIT_V(6); PG8_BAR;
    } else {
        PG8_STAGE(PG8_SB(0, 0), cB, voffB); PG8_STAGE(PG8_SA(0, 0), cA, voffA); PG8_STAGE(PG8_SB(0, 1), cB + hstep, voffB); PG8_STAGE(PG8_SA(0, 1), cA + hstep, voffA);
        if (wr == 1) PG8_BAR;
        PG8_WAIT_V(4); PG8_BAR;
        PG8_STAGE(PG8_SB(1, 0), cB + kstep, voffB); PG8_STAGE(PG8_SA(1, 0), cA + kstep, voffA); PG8_STAGE(PG8_SB(1, 1), cB + hstep + kstep, voffB);
        PG8_WAIT_V(6); PG8_BAR;
    }
    for (;;) {
        const bool has_next = S.next(ui + 1, nxt);
        const char* nA = has_next ? (const char*)g.A + (size_t)nxt.pm * tstep : cA; const char* nB = has_next ? (const char*)g.Bt + (size_t)nxt.pn * tstep : cB;
        for (int t = 0; t < nt; t += 2) {
            const bool last = (t == nt - 2);
            const char* a1 = cA + (size_t)(t + 1) * kstep;
            const char* a2 = last ? nA : cA + (size_t)(t + 2) * kstep; const char* b2 = last ? nB : cB + (size_t)(t + 2) * kstep;
            const char* a3 = a2 + kstep; const char* b3 = b2 + kstep;
            if (last && has_next) S.a_ready(nxt);
            if constexpr (SP2) {
            PG8_LDB(B0, 0, 0); PG8_LDB(B1, 0, 1); PG8_SCHED; PG8_LDA(At, 0, 0); PG8_STAGE(PG8_SA(1, 1), a1 + hstep, voffA);
            PG8_WAIT_V(8); PG8_WAIT_L(0); PG8_BAR; PG8_MMA(0, 0, At, B0); PG8_MMA(0, 1, At, B1); PG8_BAR; PG8_SCHED;
            PG8_LDA(At, 0, 1); PG8_STAGE(PG8_SB(0, 0), b2, voffB); PG8_STAGE(PG8_SB(0, 1), b2 + hstep, voffB); PG8_STAGE(PG8_SA(0, 0), a2, voffA);
            PG8_WAIT_V(8); PG8_WAIT_L(0); PG8_BAR; PG8_MMA(1, 0, At, B0); PG8_MMA(1, 1, At, B1); PG8_BAR; PG8_SCHED;
            PG8_LDB(B0, 1, 0); PG8_LDB(B1, 1, 1); PG8_SCHED; PG8_LDA(At, 1, 0); PG8_STAGE(PG8_SA(0, 1), a2 + hstep, voffA);
            PG8_WAIT_V(8); PG8_WAIT_L(0); PG8_BAR; PG8_MMA(0, 0, At, B0); PG8_MMA(0, 1, At, B1); PG8_BAR; PG8_SCHED;
            PG8_LDA(At, 1, 1); PG8_STAGE(PG8_SB(1, 0), b3, voffB); PG8_STAGE(PG8_SB(1, 1), b3 + hstep, voffB); PG8_STAGE(PG8_SA(1, 0), a3, voffA);
            PG8_WAIT_V(8); PG8_WAIT_L(0); PG8_BAR; PG8_MMA(1, 0, At, B0); PG8_MMA(1, 1, At, B1); PG8_BAR; PG8_SCHED;
            } else {
            PG8_LDB(B0, 0, 0); PG8_SCHED; PG8_LDA(At, 0, 0); PG8_STAGE(PG8_SA(1, 1), a1 + hstep, voffA);
            PG8_WAIT_L(8); PG8_BAR; PG8_WAIT_L(0); PG8_MMA(0, 0, At, B0); PG8_BAR; PG8_SCHED;
            PG8_LDB(B1, 0, 1); PG8_STAGE(PG8_SB(0, 0), b2, voffB);
            PG8_BAR; PG8_WAIT_L(0); PG8_MMA(0, 1, At, B1); PG8_BAR;
            PG8_LDA(At, 0, 1); PG8_STAGE(PG8_SA(0, 0), a2, voffA);
            PG8_BAR; PG8_WAIT_L(0); PG8_MMA(1, 0, At, B0); PG8_BAR; PG8_SCHED;
            PG8_STAGE(PG8_SB(0, 1), b2 + hstep, voffB);
            PG8_WAIT_V(6); PG8_BAR; PG8_MMA(1, 1, At, B1); PG8_BAR;
            PG8_LDB(B0, 1, 0); PG8_SCHED; PG8_LDA(At, 1, 0); PG8_STAGE(PG8_SA(0, 1), a2 + hstep, voffA);
            PG8_WAIT_L(8); PG8_BAR; PG8_WAIT_L(0); PG8_MMA(0, 0, At, B0); PG8_BAR; PG8_SCHED;
            PG8_LDB(B1, 1, 1); PG8_STAGE(PG8_SB(1, 0), b3, voffB);
            PG8_BAR; PG8_WAIT_L(0); PG8_MMA(0, 1, At, B1); PG8_BAR;
            PG8_LDA(At, 1, 1); PG8_STAGE(PG8_SA(1, 0), a3, voffA);
            PG8_BAR; PG8_WAIT_L(0); PG8_MMA(1, 0, At, B0); PG8_BAR; PG8_SCHED;
            PG8_STAGE(PG8_SB(1, 1), b3 + hstep, voffB);
            PG8_WAIT_V(6); PG8_BAR; PG8_MMA(1, 1, At, B1); PG8_BAR;
            }
        }
        if constexpr (ALIGN_EPI) { if (wr == 0) PG8_BAR; }
        if constexpr (!Epi::AFTER_DRAIN) { E(acc, cur, wr, wc, fr, fq); S.done(cur); }
        if (!has_next) break;
#pragma unroll
        for (int a = 0; a < 2; ++a)
#pragma unroll
            for (int b = 0; b < 2; ++b)
#pragma unroll
                for (int m = 0; m < 4; ++m)
#pragma unroll
                    for (int n = 0; n < 2; ++n) acc[a][b][m][n] = (f32x4){0.f, 0.f, 0.f, 0.f};
        cur = nxt; cA = nA; cB = nB; ++ui;
        if constexpr (ALIGN_EPI) { if (wr == 1) PG8_BAR; }
    }
    PG8_WAIT_V(0);
    if constexpr (!ALIGN_EPI) { if (wr == 0) PG8_BAR; }
    PG8_BAR;
    if constexpr (Epi::AFTER_DRAIN) { E.fused(acc, cur, wr, wc, fr, fq, lds, wid, lane); S.done(cur); }
#undef PG8_SA
#undef PG8_SB
#undef PG8_STAGE
#undef PG8_LDA
#undef PG8_LDB
#undef PG8_MMA
#undef PG8_WAIT_V
#undef PG8_WAIT_L
#undef PG8_BAR
#undef PG8_SCHED
}

__device__ __forceinline__ float silu_f(float x) { return x * __builtin_amdgcn_rcpf(1.f + __builtin_amdgcn_exp2f(-1.44269504089f * x)); }

struct EpiSwiglu {
    static constexpr bool PERM = true, AFTER_DRAIN = false;
    bf16_t* O;
    __device__ __forceinline__ void operator()(const f32x4 (&acc)[2][2][4][2], const Unit& u, int wr, int wc, int fr, int fq) const {
        const int row0 = u.pm * BM + wr * 64 + fr, col0 = u.pn * 128 + wc * 32 + 8 * fq;
#pragma unroll
        for (int ai = 0; ai < 2; ++ai)
#pragma unroll
            for (int m = 0; m < 4; ++m) {
                bf16_t* rowp = O + (size_t)(row0 + ai * HALF + m * 16) * 2816 + col0;
                const f32x4 g0 = acc[ai][0][m][0], g1 = acc[ai][0][m][1], u0 = acc[ai][1][m][0], u1 = acc[ai][1][m][1];
                u32x4 o;
                o.x = cvt_pk_bf16(silu_f(g0[0]) * u0[0], silu_f(g0[1]) * u0[1]); o.y = cvt_pk_bf16(silu_f(g0[2]) * u0[2], silu_f(g0[3]) * u0[3]);
                o.z = cvt_pk_bf16(silu_f(g1[0]) * u1[0], silu_f(g1[1]) * u1[1]); o.w = cvt_pk_bf16(silu_f(g1[2]) * u1[2], silu_f(g1[3]) * u1[3]);
                *(u32x4*)rowp = o;
            }
    }
};
struct EpiResid {
    static constexpr bool PERM = true, AFTER_DRAIN = false;
    const void* hin; void* hout; const float* gt; float scale; int in_f32, out_f32;
    template <bool INF, bool OUTF> __device__ __forceinline__ void run(const f32x4 (&acc)[2][2][4][2], const f32x4 (&gv)[2][2], int row0, int col0) const {
#pragma unroll
        for (int ai = 0; ai < 2; ++ai)
#pragma unroll
            for (int m = 0; m < 4; ++m) {
                const size_t off = (size_t)(row0 + ai * HALF + m * 16) * 1024 + col0;
#pragma unroll
                for (int bj = 0; bj < 2; ++bj) {
                    const size_t o = off + bj * HALF;
                    f32x4 h0, h1;
                    if (INF) { h0 = *(const f32x4*)((const float*)hin + o); h1 = *(const f32x4*)((const float*)hin + o + 4); }
                    else { const u32x4 u = *(const u32x4*)((const bf16_t*)hin + o); const f32x2_t a = f16x2_to_f32(u[0]), c = f16x2_to_f32(u[1]), d = f16x2_to_f32(u[2]), e = f16x2_to_f32(u[3]);
                           h0 = (f32x4){a[0], a[1], c[0], c[1]}; h1 = (f32x4){d[0], d[1], e[0], e[1]}; }
                    const f32x4 r0 = h0 + gv[bj][0] * acc[ai][bj][m][0], r1 = h1 + gv[bj][1] * acc[ai][bj][m][1];
                    if (OUTF) { *(f32x4*)((float*)hout + o) = r0; *(f32x4*)((float*)hout + o + 4) = r1; }
                    else { u32x4 w; w[0] = cvt_pk_f16(r0[0], r0[1]); w[1] = cvt_pk_f16(r0[2], r0[3]); w[2] = cvt_pk_f16(r1[0], r1[1]); w[3] = cvt_pk_f16(r1[2], r1[3]); *(u32x4*)((bf16_t*)hout + o) = w; }
                }
            }
    }
    __device__ __forceinline__ void operator()(const f32x4 (&acc)[2][2][4][2], const Unit& u, int wr, int wc, int fr, int fq) const {
        const int row0 = u.pm * BM + wr * 64 + fr, col0 = u.pn * BM + wc * 32 + 8 * fq;
        const float* gp = gt + (size_t)(u.pm >> 4) * 9216 + col0;
        f32x4 gv[2][2];
#pragma unroll
        for (int bj = 0; bj < 2; ++bj)
#pragma unroll
            for (int n = 0; n < 2; ++n) { const f32x4 t = *(const f32x4*)(gp + bj * HALF + n * 4); gv[bj][n] = (t + 1.0f) * scale; }
        if (in_f32) run<true, false>(acc, gv, row0, col0); else if (out_f32) run<false, true>(acc, gv, row0, col0); else run<false, false>(acc, gv, row0, col0);
    }
};
struct EpiProj {
    static constexpr bool PERM = true, AFTER_DRAIN = false;
    bf16_t* att; bf16_t* rw; bf16_t* cv;
    template <int LD, bool F16> __device__ __forceinline__ void put(const f32x4 (&acc)[2][2][4][2], bf16_t* base, int row0, int col0) const {
#pragma unroll
        for (int ai = 0; ai < 2; ++ai)
#pragma unroll
            for (int m = 0; m < 4; ++m) { bf16_t* rowp = base + (size_t)(row0 + ai * HALF + m * 16) * LD + col0;
#pragma unroll
                for (int bj = 0; bj < 2; ++bj) { const f32x4 v0 = acc[ai][bj][m][0], v1 = acc[ai][bj][m][1]; u32x4 o;
                    o[0] = F16 ? cvt_pk_f16(v0[0], v0[1]) : cvt_pk_bf16(v0[0], v0[1]); o[1] = F16 ? cvt_pk_f16(v0[2], v0[3]) : cvt_pk_bf16(v0[2], v0[3]);
                    o[2] = F16 ? cvt_pk_f16(v1[0], v1[1]) : cvt_pk_bf16(v1[0], v1[1]); o[3] = F16 ? cvt_pk_f16(v1[2], v1[3]) : cvt_pk_bf16(v1[2], v1[3]);
                    *(u32x4*)(rowp + bj * HALF) = o; } }
    }
    __device__ __forceinline__ void operator()(const f32x4 (&acc)[2][2][4][2], const Unit& u, int wr, int wc, int fr, int fq) const {
        const int row0 = u.pm * BM + wr * 64 + fr, cl = wc * 32 + 8 * fq;
        if (u.pn >= 3 && u.pn < 7) put<1024, true>(acc, rw, row0, (u.pn - 3) * BM + cl);
        else put<768, false>(acc, u.pn < 3 ? att : cv, row0, (u.pn < 3 ? u.pn : u.pn - 7) * BM + cl);
    }
};
struct EpiAny {
    int kind; bool perm;
    EpiSwiglu sw; EpiResid rs; EpiProj pj;
    static constexpr bool AFTER_DRAIN = false;
    __device__ __forceinline__ void operator()(const f32x4 (&acc)[2][2][4][2], const Unit& u, int wr, int wc, int fr, int fq) const {
        if (kind == 0) sw(acc, u, wr, wc, fr, fq); else if (kind == 1) rs(acc, u, wr, wc, fr, fq); else pj(acc, u, wr, wc, fr, fq);
    }
};
}

#define LAS __attribute__((address_space(3)))
using pg8::bf16_t; using pg8::bf16x8; using pg8::f32x4; using pg8::u32x4; using pg8::cvt_pk_bf16; using pg8::cvt_pk_f16; using pg8::f16x2_to_f32; using pg8::f32x2_t;
constexpr int NTOK = 32768, SEQL = 4096, DM = 1024, DFF = 2816, DEPTH = 4;
constexpr int LDS_BYTES = 131072 + 64;
constexpr int PPL = 12;
constexpr int NPH = 1 + DEPTH * PPL;

constexpr size_t OFF_MOD = 0;
constexpr size_t OFF_LORA = OFF_MOD + 1179648;
constexpr size_t OFF_BONUS = OFF_LORA + 131072;
constexpr size_t OFF_WB = OFF_BONUS + 524288;
constexpr size_t WB_FFN1IN = 0, WB_FFN1OUT = 5767168, WB_MIXIN = WB_FFN1OUT + 2883584, WB_MIXOUT = WB_MIXIN + 2621440,
                 WB_FFN2IN = WB_MIXOUT + 1048576, WB_FFN2OUT = WB_FFN2IN + 5767168, WB_ELEMS = WB_FFN2OUT + 2883584;
constexpr size_t OFF_HN = OFF_WB + WB_ELEMS * 2;
constexpr size_t OFF_R1 = OFF_HN + (size_t)NTOK * 1024 * 2;
constexpr size_t R1_CONV = (size_t)NTOK * 768 * 2, R1_RWKV = 2 * R1_CONV, R1_BYTES = (size_t)NTOK * 2816 * 2;
constexpr size_t OFF_R2 = OFF_R1 + R1_BYTES;
constexpr int REC_B = 896;
constexpr size_t R2_G = (size_t)NTOK * 4 * REC_B;
constexpr size_t WS_BAR = OFF_R2 + R2_G + (size_t)NTOK * 256 * 2;
constexpr size_t OFF_WB2 = WS_BAR + 16384;
constexpr size_t OFF_LORA2 = OFF_WB2 + WB_ELEMS * 2;
constexpr size_t OFF_YS = OFF_LORA2 + 131072;
constexpr size_t OFF_HB = OFF_YS + (size_t)NTOK * 256 * 4;
constexpr size_t WS_END = OFF_HB + (size_t)NTOK * 1024 * 2;

struct Params { const float* in[28]; float* out; unsigned char* ws; int ph_lo, ph_hi; };

__device__ __forceinline__ float wave_sum(float v) {
#pragma unroll
    for (int o = 1; o < 64; o <<= 1) v += __shfl_xor(v, o);
    return v;
}
template <int CTRL> __device__ __forceinline__ float dpp_f(float x) { return __int_as_float(__builtin_amdgcn_update_dpp(0, __float_as_int(x), CTRL, 0xf, 0xf, true)); }
__device__ __forceinline__ float rowsum16(float x) {
    x += dpp_f<0x128>(x); x += dpp_f<0x124>(x); x += dpp_f<0x122>(x); x += dpp_f<0x121>(x); return x;
}
__device__ __forceinline__ float bflo(unsigned u) { return __uint_as_float(u << 16); }
__device__ __forceinline__ float bfhi(unsigned u) { return __uint_as_float(u & 0xffff0000u); }
__device__ __forceinline__ float sigmoid_f(float x) { return __builtin_amdgcn_rcpf(1.f + __builtin_amdgcn_exp2f(-1.44269504089f * x)); }

__device__ __forceinline__ void phase_mod(const Params& P, LAS unsigned char* lds, int tid, int wid, int lane, int bid, int nblk) {
    LAS float* cact = (LAS float*)lds;
    LAS float* red = (LAS float*)(lds + 32768);
    const float* c = P.in[1];
    float* MOD = (float*)(P.ws + OFF_MOD);
    for (int i = tid; i < 8192; i += 512) { const float v = c[i]; cact[i] = v / (1.f + __expf(-v)); }
    __syncthreads();
    for (int item = bid; item < 288; item += nblk) {
        const int l = item / 72, j0 = (item % 72) * 128, k0 = wid * 128;
        const float* W = P.in[2] + (size_t)l * 1024 * 9216 + j0 + 2 * lane;
        float a0[8], a1[8];
#pragma unroll
        for (int b = 0; b < 8; ++b) { a0[b] = 0.f; a1[b] = 0.f; }
#pragma unroll 8
        for (int k = 0; k < 128; ++k) {
            const float2 w = *(const float2*)(W + (size_t)(k0 + k) * 9216);
#pragma unroll
            for (int b = 0; b < 8; ++b) { const float ca = cact[b * 1024 + k0 + k]; a0[b] += ca * w.x; a1[b] += ca * w.y; }
        }
#pragma unroll
        for (int b = 0; b < 8; ++b) { red[(wid * 8 + b) * 128 + 2 * lane] = a0[b]; red[(wid * 8 + b) * 128 + 2 * lane + 1] = a1[b]; }
        __syncthreads();
        for (int o = tid; o < 1024; o += 512) {
            const int b = o >> 7, ci = o & 127; float s = 0.f;
#pragma unroll
            for (int w = 0; w < 8; ++w) s += red[(w * 8 + b) * 128 + ci];
            MOD[(size_t)(l * 8 + b) * 9216 + j0 + ci] = s + P.in[3][l * 9216 + j0 + ci];
        }
        __syncthreads();
    }
}

__device__ __forceinline__ void transpose_item(const float* W, int K, int N, bf16_t* WT, int k0, int n0, int drow0, LAS float* scr, int lane) {
#pragma unroll 8
    for (int i = 0; i < 32; ++i) { const int kk = 2 * i + (lane >> 5); scr[kk * 33 + (lane & 31)] = W[(size_t)(k0 + kk) * N + n0 + (lane & 31)]; }
    asm volatile("s_waitcnt lgkmcnt(0)" ::: "memory");
    const int c = lane & 7;
#pragma unroll
    for (int j = 0; j < 4; ++j) { const int n = (lane >> 3) + 8 * j; const LAS float* s = scr + (8 * c) * 33 + n;
        u32x4 o; o.x = cvt_pk_bf16(s[0 * 33], s[1 * 33]); o.y = cvt_pk_bf16(s[2 * 33], s[3 * 33]); o.z = cvt_pk_bf16(s[4 * 33], s[5 * 33]); o.w = cvt_pk_bf16(s[6 * 33], s[7 * 33]);
        *(u32x4*)(WT + (size_t)(drow0 + n) * K + k0 + 8 * c) = o; }
    asm volatile("s_waitcnt lgkmcnt(0)" ::: "memory");
}
__device__ __forceinline__ int swiglu_row(int n0) { return n0 < DFF ? ((n0 >> 7) * 256 + (n0 & 127)) : (((n0 - DFF) >> 7) * 256 + 128 + ((n0 - DFF) & 127)); }
__device__ __forceinline__ void phase_convert(const Params& P, int l, LAS unsigned char* lds, int wid, int lane, int bid, int nblk) {
    LAS float* scr = (LAS float*)(lds + wid * 8448);
    bf16_t* WB = (bf16_t*)(P.ws + ((l & 1) ? OFF_WB2 : OFF_WB));
    bf16_t* LT = (bf16_t*)(P.ws + ((l & 1) ? OFF_LORA2 : OFF_LORA));
    const int gw = bid * 8 + wid, NGW = nblk * 8;
    constexpr int I_IN = 16 * 176, I_OUT = 44 * 32, I_MI = 16 * 80, I_MO = 16 * 32;
    constexpr int NIT = 2 * I_IN + 2 * I_OUT + I_MI + I_MO + 32;
    for (int it = gw; it < NIT; it += NGW) {
        int r = it;
        if (r < I_IN) { const int kb = r / 176, nb = r % 176; transpose_item(P.in[5] + (size_t)l * 1024 * 5632, 1024, 5632, WB + WB_FFN1IN, kb * 64, nb * 32, swiglu_row(nb * 32), scr, lane); continue; } r -= I_IN;
        if (r < I_OUT) { const int kb = r / 32, nb = r % 32; transpose_item(P.in[6] + (size_t)l * 2816 * 1024, 2816, 1024, WB + WB_FFN1OUT, kb * 64, nb * 32, nb * 32, scr, lane); continue; } r -= I_OUT;
        if (r < I_MI) { const int kb = r / 80, nb = r % 80; transpose_item(P.in[8] + (size_t)l * 1024 * 2560, 1024, 2560, WB + WB_MIXIN, kb * 64, nb * 32, nb * 32, scr, lane); continue; } r -= I_MI;
        if (r < I_MO) { const int kb = r / 32, nb = r % 32; transpose_item(P.in[9] + (size_t)l * 1024 * 1024, 1024, 1024, WB + WB_MIXOUT, kb * 64, nb * 32, nb * 32, scr, lane); continue; } r -= I_MO;
        if (r < I_IN) { const int kb = r / 176, nb = r % 176; transpose_item(P.in[26] + (size_t)l * 1024 * 5632, 1024, 5632, WB + WB_FFN2IN, kb * 64, nb * 32, swiglu_row(nb * 32), scr, lane); continue; } r -= I_IN;
        if (r < I_OUT) { const int kb = r / 32, nb = r % 32; transpose_item(P.in[27] + (size_t)l * 2816 * 1024, 2816, 1024, WB + WB_FFN2OUT, kb * 64, nb * 32, nb * 32, scr, lane); continue; } r -= I_OUT;
        if (r < 8) { transpose_item(P.in[15] + (size_t)l * 64 * 256, 64, 256, LT, 0, r * 32, r * 32, scr, lane); continue; } r -= 8;
        if (r < 8) { transpose_item(P.in[17] + (size_t)l * 64 * 256, 64, 256, LT + 16384, 0, r * 32, r * 32, scr, lane); continue; } r -= 8;
        { const int kb = r / 8, nb = r % 8; transpose_item(P.in[18] + (size_t)l * 128 * 256, 128, 256, LT + 32768, kb * 64, nb * 32, nb * 32, scr, lane); }
    }
}

template <bool INF>
__device__ __forceinline__ void phase_norm(const Params& P, const void* hin, const float* gain, const float* modl  , int wid, int lane, int bid, int nblk) {
    bf16_t* HN = (bf16_t*)(P.ws + OFF_HN);
    for (int row0 = (bid * 8 + wid) * 4; row0 < NTOK; row0 += nblk * 32) {
        f32x4 v[4][4]; float ss[4];
#pragma unroll
        for (int r = 0; r < 4; ++r) {
            if (INF) { const f32x4* xr = (const f32x4*)((const float*)hin + (size_t)(row0 + r) * 1024) + lane;
#pragma unroll
                for (int j = 0; j < 4; ++j) v[r][j] = xr[64 * j]; }
            else { const u32x4* xr = (const u32x4*)((const bf16_t*)hin + (size_t)(row0 + r) * 1024) + lane;
#pragma unroll
                for (int j2 = 0; j2 < 2; ++j2) { const u32x4 w = xr[64 * j2]; const f32x2_t a = f16x2_to_f32(w[0]), c = f16x2_to_f32(w[1]), d = f16x2_to_f32(w[2]), e = f16x2_to_f32(w[3]);
                    v[r][2 * j2] = (f32x4){a[0], a[1], c[0], c[1]}; v[r][2 * j2 + 1] = (f32x4){d[0], d[1], e[0], e[1]}; } }
        }
#pragma unroll
        for (int r = 0; r < 4; ++r) { float a = 0.f;
#pragma unroll
            for (int j = 0; j < 4; ++j) a += (v[r][j][0] * v[r][j][0] + v[r][j][1] * v[r][j][1]) + (v[r][j][2] * v[r][j][2] + v[r][j][3] * v[r][j][3]);
            ss[r] = a; }
#pragma unroll
        for (int o = 1; o < 64; o <<= 1) {
#pragma unroll
            for (int r = 0; r < 4; ++r) ss[r] += __shfl_xor(ss[r], o);
        }
        const float* sh = modl + (size_t)(row0 >> 12) * 9216; const float* sc = sh + 1024;
        float rstd[4];
#pragma unroll
        for (int r = 0; r < 4; ++r) rstd[r] = rsqrtf(ss[r] * (1.f / 1024.f) + 1e-6f);
        if (INF) {
#pragma unroll
            for (int j = 0; j < 4; ++j) {
                const int col = lane * 4 + 256 * j;
                const f32x4 gs = *(const f32x4*)(gain + col) * (*(const f32x4*)(sc + col) + 1.0f), s0 = *(const f32x4*)(sh + col);
#pragma unroll
                for (int r = 0; r < 4; ++r) { const f32x4 y = v[r][j] * rstd[r] * gs + s0; uint2 o; o.x = cvt_pk_bf16(y[0], y[1]); o.y = cvt_pk_bf16(y[2], y[3]);
                    ((uint2*)(HN + (size_t)(row0 + r) * 1024) + lane)[64 * j] = o; }
            }
        } else {
#pragma unroll
            for (int j2 = 0; j2 < 2; ++j2) {
                const int col = lane * 8 + 512 * j2;
                const f32x4 gsa = *(const f32x4*)(gain + col) * (*(const f32x4*)(sc + col) + 1.0f), gsb = *(const f32x4*)(gain + col + 4) * (*(const f32x4*)(sc + col + 4) + 1.0f);
                const f32x4 s0a = *(const f32x4*)(sh + col), s0b = *(const f32x4*)(sh + col + 4);
#pragma unroll
                for (int r = 0; r < 4; ++r) { const f32x4 ya = v[r][2 * j2] * rstd[r] * gsa + s0a, yb = v[r][2 * j2 + 1] * rstd[r] * gsb + s0b;
                    u32x4 o; o[0] = cvt_pk_bf16(ya[0], ya[1]); o[1] = cvt_pk_bf16(ya[2], ya[3]); o[2] = cvt_pk_bf16(yb[0], yb[1]); o[3] = cvt_pk_bf16(yb[2], yb[3]);
                    ((u32x4*)(HN + (size_t)(row0 + r) * 1024) + lane)[64 * j2] = o; }
            }
        }
    }
}

__device__ __forceinline__ bf16x8 pack8(const float* f) {
    u32x4 o; o.x = cvt_pk_bf16(f[0], f[1]); o.y = cvt_pk_bf16(f[2], f[3]); o.z = cvt_pk_bf16(f[4], f[5]); o.w = cvt_pk_bf16(f[6], f[7]);
    return __builtin_bit_cast(bf16x8, o);
}
__device__ __forceinline__ void attn_item(const Params& P, int l, int item, LAS unsigned char* lds, int tid, int wid, int lane, int var) {
    const bf16_t* PA = (const bf16_t*)(P.ws + OFF_R1);
    bf16_t* Y = (bf16_t*)(P.ws + OFF_HN);
    const int b = item >> 6, n = (item >> 1) & 31, hk = item & 1;
    LAS bf16_t* Ks = (LAS bf16_t*)lds;
    LAS bf16_t* Vt = (LAS bf16_t*)(lds + 36864);
    const float* kg = P.in[11] + l * 64; const float* qg = P.in[10] + l * 64;
    {
        const int row = tid >> 1, half = tid & 1, kt = n * 128 - 128 + row;
        u32x4 kv[4], vv[4];
        if (kt >= 0) {
            const bf16_t* src = PA + (size_t)(b * SEQL + kt) * 768 + 512 + hk * 64 + half * 32;
#pragma unroll
            for (int i = 0; i < 4; ++i) { kv[i] = ((const u32x4*)src)[i]; vv[i] = ((const u32x4*)(src + 128))[i]; }
        } else {
#pragma unroll
            for (int i = 0; i < 4; ++i) { kv[i] = (u32x4){0u, 0u, 0u, 0u}; vv[i] = (u32x4){0u, 0u, 0u, 0u}; }
        }
        float kf[32]; float ss = 0.f;
#pragma unroll
        for (int i = 0; i < 4; ++i)
#pragma unroll
            for (int j = 0; j < 4; ++j) { const float a = bflo(kv[i][j]), c = bfhi(kv[i][j]); kf[i * 8 + 2 * j] = a; kf[i * 8 + 2 * j + 1] = c; ss += a * a + c * c; }
        ss += __shfl_xor(ss, 1);
        const float rstd = rsqrtf(ss * (1.f / 64.f) + 1e-6f);
#pragma unroll
        for (int i = 0; i < 32; ++i) kf[i] *= rstd * kg[half * 32 + i];
#pragma unroll
        for (int i = 0; i < 4; ++i) *(LAS bf16x8*)(Ks + row * 72 + half * 32 + i * 8) = pack8(kf + i * 8);
        const int r32 = row & 31, kp = (row & ~31) + ((r32 & 15) >> 2) * 8 + (r32 >> 4) * 4 + (r32 & 3);
#pragma unroll
        for (int i = 0; i < 4; ++i)
#pragma unroll
            for (int j = 0; j < 4; ++j) { const unsigned w = vv[i][j]; Vt[(half * 32 + i * 8 + 2 * j) * 264 + kp] = (bf16_t)(w & 0xffffu); Vt[(half * 32 + i * 8 + 2 * j + 1) * 264 + kp] = (bf16_t)(w >> 16); }
    }
    __syncthreads();
    const int fr = lane & 15, fq = lane >> 4, hq = hk * 4 + (wid >> 1);
    const float sink = P.in[12][l * 8 + hq];
    for (int i = 0; i < 4; ++i) {
        if (var == 1) { asm volatile("s_waitcnt vmcnt(0) lgkmcnt(0)" ::: "memory"); __syncthreads(); }
        const int q0 = ((wid & 1) * 4 + i) * 16, kb0 = q0 >> 5;
        const bf16_t* qp = PA + (size_t)(b * SEQL + n * 128 + q0 + fr) * 768 + hq * 64 + fq * 8;
        const u32x4 qa = *(const u32x4*)qp, qb = *(const u32x4*)(qp + 32);
        float qf[16]; float ss = 0.f;
#pragma unroll
        for (int j = 0; j < 4; ++j) { qf[2 * j] = bflo(qa[j]); qf[2 * j + 1] = bfhi(qa[j]); qf[8 + 2 * j] = bflo(qb[j]); qf[8 + 2 * j + 1] = bfhi(qb[j]); }
#pragma unroll
        for (int j = 0; j < 16; ++j) ss += qf[j] * qf[j];
        ss += __shfl_xor(ss, 16); ss += __shfl_xor(ss, 32);
        const float rstd = rsqrtf(ss * (1.f / 64.f) + 1e-6f) * 0.125f;
#pragma unroll
        for (int j = 0; j < 8; ++j) { qf[j] *= rstd * qg[fq * 8 + j]; qf[8 + j] *= rstd * qg[32 + fq * 8 + j]; }
        const bf16x8 Q0 = pack8(qf), Q1 = pack8(qf + 8);
        f32x4 s[10];
#pragma unroll
        for (int tt = 0; tt < 10; ++tt) {
            const LAS bf16_t* kr = Ks + ((2 * kb0 + tt) * 16 + fr) * 72 + fq * 8;
            const bf16x8 K0 = *(const LAS bf16x8*)kr, K1 = *(const LAS bf16x8*)(kr + 32);
            f32x4 z = (f32x4){0.f, 0.f, 0.f, 0.f};
            z = __builtin_amdgcn_mfma_f32_16x16x32_bf16(K0, Q0, z, 0, 0, 0);
            s[tt] = __builtin_amdgcn_mfma_f32_16x16x32_bf16(K1, Q1, z, 0, 0, 0);
        }
        if (var == 3) {
#pragma unroll
            for (int tt = 0; tt < 10; ++tt) s[tt] = (f32x4){0.25f, 0.5f, 0.125f, 0.375f};
        }
        const int qi = q0 + fr;
        float m = sink;
#pragma unroll
        for (int tt = 0; tt < 10; ++tt)
#pragma unroll
            for (int j = 0; j < 4; ++j) {
                const int kidx = (2 * kb0 + tt) * 16 + fq * 4 + j;
                const bool vis = (kidx > qi) && (kidx <= qi + 128) && (n > 0 || kidx >= 128);
                const float sv = vis ? s[tt][j] : -INFINITY; s[tt][j] = sv; m = fmaxf(m, sv);
            }
        m = fmaxf(m, __shfl_xor(m, 16)); m = fmaxf(m, __shfl_xor(m, 32));
        float sum = 0.f;
#pragma unroll
        for (int tt = 0; tt < 10; ++tt)
#pragma unroll
            for (int j = 0; j < 4; ++j) { const float p = __expf(s[tt][j] - m); s[tt][j] = p; sum += p; }
        sum += __shfl_xor(sum, 16); sum += __shfl_xor(sum, 32);
        sum += __expf(sink - m);
        const float inv = 1.f / sum;
        f32x4 o[4];
#pragma unroll
        for (int dt = 0; dt < 4; ++dt) o[dt] = (f32x4){0.f, 0.f, 0.f, 0.f};
        if (var == 2) {
#pragma unroll
            for (int dt = 0; dt < 4; ++dt) o[dt] = s[dt] + s[4 + dt] + s[(8 + dt) > 9 ? 9 : 8 + dt];
        } else
        {
#pragma unroll
        for (int kb = 0; kb < 5; ++kb) {
            float pf[8];
#pragma unroll
            for (int j = 0; j < 4; ++j) { pf[j] = s[2 * kb][j] * inv; pf[4 + j] = s[2 * kb + 1][j] * inv; }
            const bf16x8 Pf = pack8(pf);
#pragma unroll
            for (int dt = 0; dt < 4; ++dt) {
                const bf16x8 Vf = *(const LAS bf16x8*)(Vt + (dt * 16 + fr) * 264 + (kb0 + kb) * 32 + fq * 8);
                o[dt] = __builtin_amdgcn_mfma_f32_16x16x32_bf16(Pf, Vf, o[dt], 0, 0, 0);
            }
        }
        }
#pragma unroll
        for (int dt = 0; dt < 4; ++dt)
#pragma unroll
            for (int j = 0; j < 4; ++j)
                Y[(size_t)(b * SEQL + n * 128 + q0 + fq * 4 + j) * 1024 + hq * 64 + dt * 16 + fr] = (bf16_t)(cvt_pk_bf16(o[dt][j], 0.f) & 0xffffu);
    }
    __syncthreads();
}

__device__ __forceinline__ void conv_part(const Params& P, int l, int tid, int bid, int nblk) {
    const bf16_t* PC = (const bf16_t*)(P.ws + OFF_R1 + R1_CONV);
    bf16_t* Y = (bf16_t*)(P.ws + OFF_HN);
    const float* cw = P.in[24] + l * 768;
    for (int idx = bid * 512 + tid; idx < NTOK * 32; idx += nblk * 512) {
        const int tok = idx >> 5, c = (idx & 31) * 8, t = tok & (SEQL - 1);
        const bf16_t* p = PC + (size_t)tok * 768 + c;
        const u32x4 bg = *(const u32x4*)p;
        float u[3][8];
#pragma unroll
        for (int d = 0; d < 3; ++d) {
            if (t >= d) { const u32x4 cg4 = *(const u32x4*)(p - d * 768 + 256), hg = *(const u32x4*)(p - d * 768 + 512);
#pragma unroll
                for (int j = 0; j < 4; ++j) { u[d][2 * j] = bflo(cg4[j]) * bflo(hg[j]); u[d][2 * j + 1] = bfhi(cg4[j]) * bfhi(hg[j]); }
            } else {
#pragma unroll
                for (int j = 0; j < 8; ++j) u[d][j] = 0.f;
            }
        }
        float y[8];
#pragma unroll
        for (int j = 0; j < 8; ++j) {
            const float bgv = (j & 1) ? bfhi(bg[j >> 1]) : bflo(bg[j >> 1]);
            y[j] = bgv * (cw[c + j] * u[2][j] + cw[256 + c + j] * u[1][j] + cw[512 + c + j] * u[0][j]);
        }
        *(bf16x8*)(Y + (size_t)tok * 1024 + 768 + c) = pack8(y);
    }
}

template <int MODE>
__device__ __forceinline__ void prep_tile(const Params& P, int l, int tile, LAS unsigned char* lds, int tid, int wid, int lane) {
    const bf16_t* PR = (const bf16_t*)(P.ws + OFF_R1 + R1_RWKV);
    unsigned char* REC = P.ws + OFF_R2;
    bf16_t* G = (bf16_t*)(P.ws + OFF_R2 + R2_G);
    float* BON = (float*)(P.ws + OFF_BONUS);
    LAS bf16_t* Xs = (LAS bf16_t*)lds;
    const float* mu = P.in[13] + l * 1024;
    const int tok0 = tile * 64;
    {
        const int t = tid >> 3, seg = tid & 7, tok = tok0 + t; const bool first = (tok & (SEQL - 1)) == 0;
        const bf16_t* p = PR + (size_t)tok * 1024 + 768 + seg * 32;
        const float c1 = seg < 2 ? 2.f : 1.f, c2 = seg < 2 ? 2.f : 1.f, c3 = seg < 2 ? -1.f : 0.f; const bool ident = (seg == 2 || seg == 3);
        if ((MODE == 0) == (seg < 4)) {
#pragma unroll
        for (int i = 0; i < 4; ++i) {
            float xo[8];
            const u32x4 ca = ((const u32x4*)p)[i], cp = first ? (u32x4){0u, 0u, 0u, 0u} : ((const u32x4*)(p - 1024))[i];
#pragma unroll
            for (int hh = 0; hh < 2; ++hh) {
                const f32x2_t a01 = f16x2_to_f32(ca[2 * hh]), a23 = f16x2_to_f32(ca[2 * hh + 1]), p01 = f16x2_to_f32(cp[2 * hh]), p23 = f16x2_to_f32(cp[2 * hh + 1]);
                const f32x4 a = (f32x4){a01[0], a01[1], a23[0], a23[1]};
                const f32x4 pv = (f32x4){p01[0], p01[1], p23[0], p23[1]};
                const f32x4 m = ((const f32x4*)(mu + 768 + seg * 32))[2 * i + hh];
                const f32x4 x = a + m * (pv - a);
#pragma unroll
                for (int j = 0; j < 4; ++j) { const float sg = sigmoid_f(c1 * x[j]) * c2 + c3; xo[hh * 4 + j] = ident ? x[j] : sg; }
            }
            *(LAS bf16x8*)(Xs + t * 264 + seg * 32 + i * 8) = pack8(xo);
        }
        }
    }
    __syncthreads();
    const int fr = lane & 15, fq = lane >> 4, hh = wid & 3;
    const bf16_t* WTw = (const bf16_t*)(P.ws + ((l & 1) ? OFF_LORA2 : OFF_LORA)); const bf16_t* WTa = WTw + 16384; const bf16_t* WTg = WTw + 32768;
    const float* w0 = P.in[14] + l * 256; const float* a0 = P.in[16] + l * 256; const float* k_k = P.in[19] + l * 256;
    const float* k_a = P.in[20] + l * 256; const float* r_k = P.in[21] + l * 256;
#pragma unroll
    for (int ti = 0; ti < 2; ++ti) {
        const int tq = (wid >> 2) * 2 + ti;
        bf16x8 xb[8];
#pragma unroll
        for (int ks = (MODE == 0 ? 0 : 4); ks < (MODE == 0 ? 4 : 8); ++ks) xb[ks] = *(const LAS bf16x8*)(Xs + (tq * 16 + fr) * 264 + ks * 32 + fq * 8);
        f32x4 aw[4], aa[4], ag[4];
#pragma unroll
        for (int ct = 0; ct < 4; ++ct) {
            const int col = hh * 64 + ct * 16 + fr;
            f32x4 z = (f32x4){0.f, 0.f, 0.f, 0.f};
            if (MODE == 0) {
#pragma unroll
            for (int ks = 0; ks < 2; ++ks) z = __builtin_amdgcn_mfma_f32_16x16x32_bf16(*(const bf16x8*)(WTw + col * 64 + ks * 32 + fq * 8), xb[ks], z, 0, 0, 0);
            aw[ct] = z; z = (f32x4){0.f, 0.f, 0.f, 0.f};
#pragma unroll
            for (int ks = 0; ks < 2; ++ks) z = __builtin_amdgcn_mfma_f32_16x16x32_bf16(*(const bf16x8*)(WTa + col * 64 + ks * 32 + fq * 8), xb[2 + ks], z, 0, 0, 0);
            aa[ct] = z; z = (f32x4){0.f, 0.f, 0.f, 0.f};
            } else {
#pragma unroll
            for (int ks = 0; ks < 4; ++ks) z = __builtin_amdgcn_mfma_f32_16x16x32_bf16(*(const bf16x8*)(WTg + col * 128 + ks * 32 + fq * 8), xb[4 + ks], z, 0, 0, 0);
            ag[ct] = z;
            }
        }
        const int tok = tok0 + tq * 16 + fr; const bool first = (tok & (SEQL - 1)) == 0;
        if (MODE == 1) {
#pragma unroll
            for (int ct = 0; ct < 4; ++ct) { const int c4 = hh * 64 + ct * 16 + fq * 4; uint2 go; go.x = cvt_pk_f16(ag[ct][0], ag[ct][1]); go.y = cvt_pk_f16(ag[ct][2], ag[ct][3]);
                *(uint2*)(G + (size_t)tok * 256 + c4) = go; }
            continue;
        }
        const bf16_t* pr = PR + (size_t)tok * 1024;
        unsigned char* rec = REC + ((size_t)tok * 4 + hh) * REC_B;
        f32x4 kkv[4], av[4]; float ss = 0.f, bon = 0.f;
        uint2 cur[4][3], prv[4][3];
#pragma unroll
        for (int ct = 0; ct < 4; ++ct)
#pragma unroll
            for (int q = 0; q < 3; ++q) {
                const int c4 = hh * 64 + ct * 16 + fq * 4;
                cur[ct][q] = *(const uint2*)(pr + q * 256 + c4);
                prv[ct][q] = first ? (uint2){0u, 0u} : *(const uint2*)(pr - 1024 + q * 256 + c4);
            }
#pragma unroll
        for (int ct = 0; ct < 4; ++ct) {
            const int c4 = hh * 64 + ct * 16 + fq * 4, lo = ct * 16 + fq * 4;
            f32x4 x3[3];
#pragma unroll
            for (int q = 0; q < 3; ++q) {
                const f32x4 m = *(const f32x4*)(mu + q * 256 + c4);
                const uint2 cu = cur[ct][q], pu = prv[ct][q];
                const f32x2_t c01 = f16x2_to_f32(cu.x), c23 = f16x2_to_f32(cu.y), q01 = f16x2_to_f32(pu.x), q23 = f16x2_to_f32(pu.y);
                const f32x4 cf = (f32x4){c01[0], c01[1], c23[0], c23[1]}, pf = (f32x4){q01[0], q01[1], q23[0], q23[1]};
                x3[q] = cf + m * (pf - cf);
            }
            const f32x4 r4 = x3[0], k4 = x3[1], v4 = x3[2];
            const f32x4 w0v = *(const f32x4*)(w0 + c4), a0v = *(const f32x4*)(a0 + c4), kkw = *(const f32x4*)(k_k + c4), kaw = *(const f32x4*)(k_a + c4), rkw = *(const f32x4*)(r_k + c4);
            f32x4 dec, a4, kp;
#pragma unroll
            for (int j = 0; j < 4; ++j) {
                const float w = w0v[j] + aw[ct][j];
                dec[j] = __builtin_amdgcn_exp2f((-0.6065306597126334f * 1.4426950408889634f) * sigmoid_f(w));
                a4[j] = sigmoid_f(a0v[j] + aa[ct][j]);
            }
            kkv[ct] = k4 * kkw; av[ct] = a4;
            kp = k4 * ((a4 - 1.0f) * kaw + 1.0f);
#pragma unroll
            for (int j = 0; j < 4; ++j) { ss += kkv[ct][j] * kkv[ct][j]; bon += r4[j] * kp[j] * rkw[j]; }
            *(f32x4*)(rec + lo * 4) = dec;
            { uint2 t; t.x = cvt_pk_f16(r4[0], r4[1]); t.y = cvt_pk_f16(r4[2], r4[3]); *(uint2*)(rec + 256 + 0 * 128 + lo * 2) = t;
              t.x = cvt_pk_f16(kp[0], kp[1]); t.y = cvt_pk_f16(kp[2], kp[3]); *(uint2*)(rec + 256 + 1 * 128 + lo * 2) = t;
              t.x = cvt_pk_f16(v4[0], v4[1]); t.y = cvt_pk_f16(v4[2], v4[3]); *(uint2*)(rec + 256 + 2 * 128 + lo * 2) = t; }
        }
        ss += __shfl_xor(ss, 16); ss += __shfl_xor(ss, 32); bon += __shfl_xor(bon, 16); bon += __shfl_xor(bon, 32);
        const float rn = ss > 1e-24f ? __builtin_amdgcn_rsqf(ss) : 1e12f;
#pragma unroll
        for (int ct = 0; ct < 4; ++ct) { const int lo = ct * 16 + fq * 4; const f32x4 kk = kkv[ct] * rn, ka = kk * av[ct]; uint2 t;
            t.x = cvt_pk_f16(kk[0], kk[1]); t.y = cvt_pk_f16(kk[2], kk[3]); *(uint2*)(rec + 256 + 3 * 128 + lo * 2) = t;
            t.x = cvt_pk_f16(ka[0], ka[1]); t.y = cvt_pk_f16(ka[2], ka[3]); *(uint2*)(rec + 256 + 4 * 128 + lo * 2) = t; }
        if (fq == 0) BON[(size_t)tok * 4 + hh] = bon;
    }
    __syncthreads();
}

__device__ __forceinline__ void scan_stage_piece(LAS float* buf, int idx, u32x4 w) {
    const int s = idx / 56, o = idx % 56;
    if (o < 16) { *(LAS u32x4*)(buf + s * 384 + 64 + o * 4) = w; }
    else {
        const int p = o - 16, q = p >> 3, j = p & 7, dq = q == 0 ? 0 : q + 1;
        LAS float* d = buf + s * 384 + dq * 64 + j * 8;
        const f32x2_t e0 = f16x2_to_f32(w[0]), e1 = f16x2_to_f32(w[1]), e2 = f16x2_to_f32(w[2]), e3 = f16x2_to_f32(w[3]);
        *(LAS f32x4*)d = (f32x4){e0[0], e0[1], e1[0], e1[1]};
        *(LAS f32x4*)(d + 4) = (f32x4){e2[0], e2[1], e3[0], e3[1]};
    }
}
__device__ __forceinline__ void phase_scan(const Params& P, LAS unsigned char* lds, int tid, int wid, int lane, int bid, int nblk) {
    const unsigned char* REC = P.ws + OFF_R2;
    float* YS = (float*)(P.ws + OFF_YS);
    for (int item = bid; item < 128; item += nblk) {
        const int bh = (item & 7) * 4 + ((item >> 3) & 3), rg = item >> 5, b = bh >> 2, h = bh & 3;
        const unsigned char* src0 = REC + ((size_t)(b * SEQL) * 4 + h) * REC_B;
        u32x4 st[7]; const int ltid = tid - 256;
        if (wid >= 4) {
#pragma unroll
            for (int i = 0; i < 7; ++i) { const int idx = ltid + 256 * i, s = idx / 56, o = idx % 56; st[i] = *(const u32x4*)(src0 + (size_t)s * (4 * REC_B) + o * 16); }
#pragma unroll
            for (int i = 0; i < 7; ++i) scan_stage_piece((LAS float*)lds, ltid + 256 * i, st[i]);
        }
        __syncthreads();
        typedef float f32x2v __attribute__((ext_vector_type(2)));
        f32x2v Sa = {0.f, 0.f}, Sb = {0.f, 0.f};
        const int rl = lane >> 4, kq = lane & 15, row = rg * 16 + (wid & 3) * 4 + rl;
        for (int ch = 0; ch < 128; ++ch) {
            if (wid >= 4 && ch + 1 < 128) {
#pragma unroll
                for (int i = 0; i < 7; ++i) { const int idx = ltid + 256 * i, s = idx / 56, o = idx % 56; st[i] = *(const u32x4*)(src0 + (size_t)((ch + 1) * 32 + s) * (4 * REC_B) + o * 16); }
            }
            if (wid < 4) {
                const LAS float* buf = (const LAS float*)(lds + (ch & 1) * 49152);
                float* yp = YS + (size_t)(b * SEQL + ch * 32 + kq) * 256 + h * 64 + row;
                const LAS float* rc = buf + kq * 4;
                const LAS float* rv = buf + 192 + row;
                f32x4 r4 = *(const LAS f32x4*)(rc), w4 = *(const LAS f32x4*)(rc + 64), k4 = *(const LAS f32x4*)(rc + 128), kk4 = *(const LAS f32x4*)(rc + 256), ka4 = *(const LAS f32x4*)(rc + 320);
                float v = rv[0];
                float oacc = 0.f;
#define LO2(x) __builtin_shufflevector(x, x, 0, 1)
#define HI2(x) __builtin_shufflevector(x, x, 2, 3)
#pragma unroll
                for (int s = 0; s < 32; ++s) {
                    f32x4 nr4 = r4, nw4 = w4, nk4 = k4, nkk4 = kk4, nka4 = ka4; float nv = v;
                    if (s + 1 < 32) {
                        const LAS float* rn = rc + (s + 1) * 384;
                        nr4 = *(const LAS f32x4*)(rn); nw4 = *(const LAS f32x4*)(rn + 64); nk4 = *(const LAS f32x4*)(rn + 128); nkk4 = *(const LAS f32x4*)(rn + 256); nka4 = *(const LAS f32x4*)(rn + 320);
                        nv = rv[(s + 1) * 384];
                    }
                    f32x2v d2 = Sa * LO2(kk4); d2 = Sb * HI2(kk4) + d2;
                    const float d = rowsum16(d2[0] + d2[1]);
                    const f32x2v vv = {v, v}, dd = {d, d};
                    f32x2v ta = Sa * LO2(w4), tb = Sb * HI2(w4);
                    ta = vv * LO2(k4) + ta; tb = vv * HI2(k4) + tb;
                    Sa = ta - dd * LO2(ka4); Sb = tb - dd * HI2(ka4);
                    f32x2v o2 = Sa * LO2(r4); o2 = Sb * HI2(r4) + o2;
                    const float o = rowsum16(o2[0] + o2[1]);
                    oacc = (kq == (s & 15)) ? o : oacc;
                    if ((s & 15) == 15) yp[(size_t)(s - 15) * 256] = oacc;
                    r4 = nr4; w4 = nw4; k4 = nk4; kk4 = nkk4; ka4 = nka4; v = nv;
                }
#undef LO2
#undef HI2
            }
            if (wid >= 4 && ch + 1 < 128) {
#pragma unroll
                for (int i = 0; i < 7; ++i) scan_stage_piece((LAS float*)(lds + ((ch + 1) & 1) * 49152), ltid + 256 * i, st[i]);
            }
            __syncthreads();
        }
    }
}

__device__ __forceinline__ void phase_post(const Params& P, int l, int tid, int bid, int nblk) {
    const float* YS = (const float*)(P.ws + OFF_YS);
    const unsigned char* REC = P.ws + OFF_R2;
    const bf16_t* G = (const bf16_t*)(P.ws + OFF_R2 + R2_G);
    const float* BON = (const float*)(P.ws + OFF_BONUS);
    bf16_t* Y = (bf16_t*)(P.ws + OFF_HN);
    const float* gw = P.in[22] + l * 256; const float* gb = P.in[23] + l * 256;
    const int stride = nblk * 512;
    for (int base = bid * 512 + tid; base < NTOK * 64; base += 4 * stride) {
        f32x4 y[4]; uint2 vu[4], gg[4]; float bon[4];
#pragma unroll
        for (int j = 0; j < 4; ++j) {
            const int idx = base + j * stride;
            if (idx < NTOK * 64) {
                const int l16 = idx & 15, th = idx >> 4, tok = th >> 2, h = th & 3, c = h * 64 + l16 * 4;
                y[j] = *(const f32x4*)(YS + (size_t)tok * 256 + c);
                vu[j] = *(const uint2*)(REC + ((size_t)tok * 4 + h) * REC_B + 256 + 2 * 128 + l16 * 8);
                gg[j] = *(const uint2*)(G + (size_t)tok * 256 + c);
                bon[j] = BON[(size_t)tok * 4 + h];
            }
        }
#pragma unroll
        for (int j = 0; j < 4; ++j) {
            const int idx = base + j * stride;
            if (idx < NTOK * 64) {
                const int l16 = idx & 15, th = idx >> 4, tok = th >> 2, h = th & 3, c = h * 64 + l16 * 4;
                const float mean = rowsum16((y[j][0] + y[j][1]) + (y[j][2] + y[j][3])) * (1.f / 64.f);
                const f32x4 d = y[j] - mean;
                const float var = rowsum16((d[0] * d[0] + d[1] * d[1]) + (d[2] * d[2] + d[3] * d[3])) * (1.f / 64.f);
                const float rs = rsqrtf(var + 64e-5f);
                const f32x2_t v01 = f16x2_to_f32(vu[j].x), v23 = f16x2_to_f32(vu[j].y), g01 = f16x2_to_f32(gg[j].x), g23 = f16x2_to_f32(gg[j].y);
                const f32x4 v4 = (f32x4){v01[0], v01[1], v23[0], v23[1]}, g4 = (f32x4){g01[0], g01[1], g23[0], g23[1]};
                const f32x4 o = ((d * rs) * *(const f32x4*)(gw + c) + *(const f32x4*)(gb + c) + v4 * bon[j]) * g4;
                uint2 ov; ov.x = cvt_pk_bf16(o[0], o[1]); ov.y = cvt_pk_bf16(o[2], o[3]);
                *(uint2*)(Y + (size_t)tok * 1024 + 512 + c) = ov;
            }
        }
    }
}

#define XB_TMO      128
#define XB_XCNT(j)  (256  + 64 * (j))
#define XB_XSUB(j)  (1280 + 64 * (j))
#define XB_XGEN(j)  (2304 + 64 * (j))
#define XB_TOP      3328
#define XB_TOPGEN   3392
#define XCD_BAR_WORDS 3456
#define XB_SPIN_CAP (1u << 18)

__device__ __forceinline__ unsigned xb_ld(unsigned* p)              { return __hip_atomic_load(p, __ATOMIC_RELAXED, __HIP_MEMORY_SCOPE_AGENT); }
__device__ __forceinline__ unsigned xb_add(unsigned* p, unsigned v) { return __hip_atomic_fetch_add(p, v, __ATOMIC_RELAXED, __HIP_MEMORY_SCOPE_AGENT); }
__device__ __forceinline__ unsigned xb_xcc_id() { return (unsigned)__builtin_amdgcn_s_getreg((3 << 11) | 20) & 0xFu; }
#define XB_SPIN(cond, bar) do { unsigned _sp = 0; while (cond) { __builtin_amdgcn_s_sleep(1); \
    if ((++_sp & 255u) == 0u) { if (xb_ld(&(bar)[XB_TMO])) break; if (_sp > XB_SPIN_CAP) { atomicAdd(&(bar)[XB_TMO], 1u); break; } } } } while (0)

struct XcdBarrier {
    unsigned* bar; unsigned x;
    volatile LAS unsigned* st;
};

__device__ __forceinline__ XcdBarrier xcd_barrier_post(unsigned* bar, volatile LAS unsigned* st) {
    XcdBarrier b; b.bar = bar; b.x = xb_xcc_id(); b.st = st;
    if (threadIdx.x == 0) (void)xb_add(&bar[XB_XCNT(b.x)], 1u);
    return b;
}
__device__ __forceinline__ void xcd_barrier_complete(unsigned* bar, unsigned x, unsigned& nloc, unsigned& nx) {
    const unsigned G = gridDim.x * gridDim.y * gridDim.z;
    unsigned sum, cnt, mine, sp = 0u;
    for (;;) {
        sum = 0u; cnt = 0u; mine = 0u;
#pragma unroll
        for (unsigned j = 0; j < 16; ++j) { const unsigned c = xb_ld(&bar[XB_XCNT(j)]); sum += c; cnt += (c > 0u) ? 1u : 0u; mine = (j == x) ? c : mine; }
        if (sum == G) break;
        __builtin_amdgcn_s_sleep(1);
        if ((++sp & 255u) == 0u) { if (xb_ld(&bar[XB_TMO])) break; if (sp > XB_SPIN_CAP) { atomicAdd(&bar[XB_TMO], 1u); break; } }
    }
    nloc = mine > 0u ? mine : 1u; nx = cnt > 0u ? cnt : 1u;
}

__device__ __forceinline__ void xcd_barrier(const XcdBarrier& b) {
    asm volatile("s_waitcnt vmcnt(0)" ::: "memory");
    __syncthreads();
    if (threadIdx.x == 0) {
        unsigned* bar = b.bar;
        __builtin_amdgcn_s_waitcnt(0);
        unsigned nloc = b.st[0], nx = b.st[1];
        if (nloc == 0u) { xcd_barrier_complete(bar, b.x, nloc, nx); b.st[0] = nloc; b.st[1] = nx; }
        const unsigned old = xb_add(&bar[XB_XSUB(b.x)], 1u);
        const unsigned gen = old / nloc;
        if (old + 1u == (gen + 1u) * nloc) {
            __builtin_amdgcn_fence(__ATOMIC_RELEASE, "agent");
            asm volatile("s_waitcnt vmcnt(0)" ::: "memory");
            const unsigned og = xb_add(&bar[XB_TOP], 1u);
            const unsigned tg = og / nx;
            if (og + 1u == (tg + 1u) * nx) xb_add(&bar[XB_TOPGEN], 1u);
            else XB_SPIN(xb_ld(&bar[XB_TOPGEN]) == tg, bar);
            __builtin_amdgcn_fence(__ATOMIC_ACQUIRE, "agent");
            xb_add(&bar[XB_XGEN(b.x)], 1u);
            asm volatile("s_waitcnt vmcnt(0)" ::: "memory");
        } else {
            XB_SPIN(xb_ld(&bar[XB_XGEN(b.x)]) == gen, bar);
            __builtin_amdgcn_fence(__ATOMIC_ACQUIRE, "agent");
            asm volatile("s_waitcnt vmcnt(0)" ::: "memory");
        }
    }
    __syncthreads();
}


__global__ __launch_bounds__(512, 2) void mega(Params P) {
    extern __shared__ __attribute__((aligned(16))) unsigned char shm[];
    LAS unsigned char* lds = (LAS unsigned char*)shm;
    const int nblk = gridDim.x;
    volatile LAS unsigned* bst = (volatile LAS unsigned*)(lds + 131072);
    if (threadIdx.x < 2) bst[threadIdx.x] = 0u;
    __syncthreads();
    const XcdBarrier xbar = xcd_barrier_post((unsigned*)(P.ws + WS_BAR), bst);
    float* MOD = (float*)(P.ws + OFF_MOD);
    bf16_t* HN = (bf16_t*)(P.ws + OFF_HN);
    bf16_t* ACT = (bf16_t*)(P.ws + OFF_R1);
#ifdef DIAG_TIME
    unsigned long long tA = 0, tB = 0, tprev = __builtin_amdgcn_s_memrealtime();
#endif
    for (int ph = P.ph_lo; ph < P.ph_hi; ++ph) {
#ifdef DBL_PHASE
      for (int rep = (ph > 0 && DBL_PHASE((ph - 1) % PPL)) ? 0 : 1; rep < 2; ++rep) {
#endif
        int tid = threadIdx.x, bid = blockIdx.x;
        asm volatile("" : "+v"(tid)); asm volatile("" : "+s"(bid));
        const int wid = __builtin_amdgcn_readfirstlane(tid >> 6), lane = tid & 63;
        if (ph == 0) {
#ifndef NO_MOD
            phase_mod(P, lds, tid, wid, lane, bid, nblk);
#endif
            phase_convert(P, 0, lds, wid, lane, bid, nblk);
#ifdef DIAG_POISON
            { u32x4* w = (u32x4*)(P.ws + OFF_LORA); const size_t n16 = (WS_END - OFF_LORA) / 16;
              for (size_t i = (size_t)bid * 512 + tid; i < n16; i += (size_t)nblk * 512) w[i] = (u32x4){0xAAAAAAAAu, 0xAAAAAAAAu, 0xAAAAAAAAu, 0xAAAAAAAAu}; }
#endif
        } else {
            const int l = (ph - 1) / PPL, s = (ph - 1) % PPL;
            bf16_t* HB = (bf16_t*)(P.ws + OFF_HB);
            const bool first_h = (l == 0 && s < 3), last_h = (l == DEPTH - 1 && s == PPL - 1);
            const void* hin = first_h ? (const void*)P.in[0] : (const void*)HB;
            void* hout = last_h ? (void*)P.out : (void*)HB;
            const float* modl = MOD + (size_t)l * 8 * 9216;
            bf16_t* WB = (bf16_t*)(P.ws + ((l & 1) ? OFF_WB2 : OFF_WB));
            pg8::Gemm g{HN, WB, NTOK, 1024, 1024}; pg8::EpiAny E{}; bool is_gemm = true;
            switch (s) {
            case 0:
#ifndef NO_NORM
                if (first_h) phase_norm<true>(P, hin, P.in[4] + l * 1024, modl, wid, lane, bid, nblk); else phase_norm<false>(P, hin, P.in[4] + l * 1024, modl, wid, lane, bid, nblk);
#endif
                is_gemm = false; break;
            case 1: g.Bt = WB + WB_FFN1IN; g.N = 2 * DFF; E.kind = 0; E.perm = true; E.sw.O = ACT; break;
            case 2: g.A = ACT; g.Bt = WB + WB_FFN1OUT; g.K = DFF; E.kind = 1; E.perm = true; E.rs = pg8::EpiResid{hin, hout, modl + 2 * 1024, 0.5f, first_h ? 1 : 0, last_h ? 1 : 0}; break;
            case 3: phase_norm<false>(P, hin, P.in[7] + l * 1024, modl + 3 * 1024, wid, lane, bid, nblk); is_gemm = false; break;
            case 4: g.Bt = WB + WB_MIXIN; g.N = 2560; E.kind = 2; E.perm = true; E.pj = pg8::EpiProj{(bf16_t*)(P.ws + OFF_R1), (bf16_t*)(P.ws + OFF_R1 + R1_RWKV), (bf16_t*)(P.ws + OFF_R1 + R1_CONV)}; break;
            case 5:
                for (int it = bid; it < 512; it += nblk) prep_tile<0>(P, l, it, lds, tid, wid, lane);
                is_gemm = false; break;
            case 6: {
                const int nscan = nblk >> 1;
                if (bid < nscan) phase_scan(P, lds, tid, wid, lane, bid, nscan);
                else {
                    const int vb = bid - nscan, vn = nblk - nscan;
                    for (int it = vb; it < 512; it += vn) attn_item(P, l, it, lds, tid, wid, lane, P.ph_lo < 0 ? 0 : ATTN_VAR(l));
                    conv_part(P, l, tid, vb, vn);
                    for (int it = vb; it < 512; it += vn) prep_tile<1>(P, l, it, lds, tid, wid, lane);
                    if (l + 1 < DEPTH) phase_convert(P, l + 1, lds, wid, lane, vb, vn);
                }
                is_gemm = false; } break;
            case 7: phase_post(P, l, tid, bid, nblk); is_gemm = false; break;
            case 8: g.Bt = WB + WB_MIXOUT; E.kind = 1; E.perm = true; E.rs = pg8::EpiResid{hin, hout, modl + 5 * 1024, 1.0f, first_h ? 1 : 0, last_h ? 1 : 0}; break;
            case 9: phase_norm<false>(P, hin, P.in[25] + l * 1024, modl + 6 * 1024, wid, lane, bid, nblk); is_gemm = false; break;
            case 10: g.Bt = WB + WB_FFN2IN; g.N = 2 * DFF; E.kind = 0; E.perm = true; E.sw.O = ACT; break;
            default: g.A = ACT; g.Bt = WB + WB_FFN2OUT; g.K = DFF; E.kind = 1; E.perm = true; E.rs = pg8::EpiResid{hin, hout, modl + 8 * 1024, 0.5f, first_h ? 1 : 0, last_h ? 1 : 0}; break;
            }
            if (is_gemm) { pg8::StaticOrder S; S.init(NTOK, g.N, nblk, bid); pg8::gemm_phase<pg8::EpiAny, pg8::StaticOrder, GEMM_ALIGN, GEMM_SP2>(lds, g, S, E, tid); }
        }
#ifdef DIAG_TIME
        const unsigned long long twork = __builtin_amdgcn_s_memrealtime();
        cg::this_grid().sync();
        { const unsigned long long tnow = __builtin_amdgcn_s_memrealtime(); const int sx = ph == 0 ? -1 : (ph - 1) % PPL;
          if (TSEL_A(sx)) tA += (TWAIT_A ? tnow - twork : tnow - tprev);
          if (TSEL_B(sx)) tB += (TWAIT_B ? tnow - twork : tnow - tprev);
          tprev = tnow; }
#else
#ifdef DBL_PHASE
        cg::this_grid().sync();
      }
#else
        if (ph + 1 < P.ph_hi) { if (P.ph_hi > 100000) cg::this_grid().sync(); else xcd_barrier(xbar); }
#ifdef EXTRA_SYNC
        if (ph + 1 < P.ph_hi) { cg::this_grid().sync(); }
#endif
#endif
#endif
    }
#ifdef DIAG_TIME
    {
        unsigned long long* tw = (unsigned long long*)(P.ws + WS_END);
        if (blockIdx.x == 0 && threadIdx.x == 0) { tw[0] = tA; tw[1] = tB; __threadfence(); }
        cg::this_grid().sync();
        const float fa = (float)__hip_atomic_load(tw, __ATOMIC_RELAXED, __HIP_MEMORY_SCOPE_AGENT) * 0.01f * 100.0f, fb = (float)__hip_atomic_load(tw + 1, __ATOMIC_RELAXED, __HIP_MEMORY_SCOPE_AGENT) * 0.01f;
        for (size_t i = (size_t)blockIdx.x * 512 + threadIdx.x; i < (size_t)NTOK * 1024; i += (size_t)gridDim.x * 512) P.out[i] = (i == 0) ? fa : fb;
    }
#endif
}


#ifdef DIAG_SELFTEST
__global__ void diag_checksum(const unsigned* p, size_t nwords, unsigned long long* slot) {
    unsigned long long acc = 0;
    for (size_t i = (size_t)blockIdx.x * blockDim.x + threadIdx.x; i < nwords; i += (size_t)gridDim.x * blockDim.x) acc += (unsigned long long)p[i] * (unsigned long long)(2 * i + 1);
    for (int o = 1; o < 64; o <<= 1) acc += __shfl_xor(acc, o);
    if ((threadIdx.x & 63) == 0) atomicAdd(slot, acc);
}
__global__ void diag_report(const unsigned long long* slots, int nitems, int nrep, float* out, size_t n) {
    int code = 0;
    for (int k = 0; k < nitems; ++k) for (int r = 1; r < nrep; ++r) if (slots[k * nrep + r] != slots[k * nrep]) { code |= 1 << k; break; }
    if (code == 0) return;
    const float c = 4.0f * exp2f((float)code);
    for (size_t i = (size_t)blockIdx.x * blockDim.x + threadIdx.x; i < n; i += (size_t)gridDim.x * blockDim.x) out[i] = c;
}
#endif
extern "C" void kernel_launch(void* const* d_in, const int* in_sizes, int n_in, void* d_out, int out_size, void* d_ws, size_t ws_size, hipStream_t stream) {
    static int grid = 0;
    if (grid == 0) {
        if (n_in != 28 || out_size != NTOK * DM || ws_size < WS_END) { fprintf(stderr, "kernel_launch: unexpected shapes (n_in %d out %d ws %zu need %zu)\n", n_in, out_size, ws_size, (size_t)WS_END); grid = -1; return; }
        int dev = 0, cus = 0, per_cu = 0;
        hipGetDevice(&dev); hipDeviceGetAttribute(&cus, hipDeviceAttributeMultiprocessorCount, dev);
        if (hipFuncSetAttribute((const void*)mega, hipFuncAttributeMaxDynamicSharedMemorySize, LDS_BYTES) != hipSuccess) { fprintf(stderr, "kernel_launch: hipFuncSetAttribute failed\n"); grid = -1; return; }
        if (hipOccupancyMaxActiveBlocksPerMultiprocessor(&per_cu, (const void*)mega, 512, LDS_BYTES) != hipSuccess || per_cu < 1) { fprintf(stderr, "kernel_launch: occupancy query failed (%d)\n", per_cu); per_cu = 1; (void)hipGetLastError(); }
        grid = cus * per_cu;
    }
    if (grid < 0) return;
    Params p{};
    for (int i = 0; i < 28; ++i) p.in[i] = (const float*)d_in[i];
    p.out = (float*)d_out; p.ws = (unsigned char*)d_ws;
#if MK_LAUNCHES == 1
    if (hipMemsetAsync((unsigned char*)d_ws + WS_BAR, 0, 16384, stream) != hipSuccess) { fprintf(stderr, "kernel_launch: memset of barrier words failed\n"); return; }
    p.ph_lo = 0; p.ph_hi = NPH;
    void* args[] = {&p};
    hipError_t e = hipLaunchCooperativeKernel((const void*)mega, dim3(grid), dim3(512), args, LDS_BYTES, stream);
    if (e != hipSuccess) fprintf(stderr, "cooperative launch failed: %s (grid %d)\n", hipGetErrorString(e), grid);
#else
#ifdef DIAG_SELFTEST
    {
        constexpr int NREP = 4;
        unsigned long long* slots = (unsigned long long*)((unsigned char*)d_ws + WS_END);
        hipMemsetAsync(slots, 0, 64 * NREP * 8, stream);
        int item = 0;
        for (int ph = 0; ph < NPH; ++ph) {
            p.ph_lo = ph; p.ph_hi = ph + 1; hipLaunchKernelGGL(mega, dim3(grid), dim3(512), LDS_BYTES, stream, p);
            if (ph == 0) continue;
            const int l = (ph - 1) / PPL, s = (ph - 1) % PPL;
            size_t off = 0, len = 0; bool test = (s == 5);
            switch (s) {
            case 0: off = OFF_LORA; len = OFF_R1 - OFF_LORA; break;
            case 1: case 12: off = OFF_R1; len = (size_t)NTOK * DFF * 2; break;
            case 2: test = false; break;
            case 3: case 5: case 7: case 9: case 11: off = OFF_HN; len = (size_t)NTOK * 1024 * 2; break;
            case 4: off = OFF_R1; len = R1_BYTES; break;
            case 6: off = OFF_R2; len = WS_END - OFF_R2; break;
            case 8: off = OFF_R1 + R1_RWKV; len = (size_t)NTOK * 256 * 4; break;
            default: test = false; break;
            }
            if (!test) continue;
            const unsigned* base = (s == 2) ? (const unsigned*)d_out : (const unsigned*)((unsigned char*)d_ws + off);
            const size_t nw = (s == 2) ? (size_t)NTOK * 1024 : len / 4;
            for (int r = 0; r < NREP; ++r) {
                if (r > 0) hipLaunchKernelGGL(mega, dim3(grid), dim3(512), LDS_BYTES, stream, p);
                hipLaunchKernelGGL(diag_checksum, dim3(2048), dim3(256), 0, stream, base, nw, slots + item * NREP + r);
            }
            ++item;
        }
        hipLaunchKernelGGL(diag_report, dim3(2048), dim3(256), 0, stream, (const unsigned long long*)slots, item, NREP, (float*)d_out, (size_t)NTOK * 1024);
    }
#else
    for (int ph = 0; ph < NPH; ++ph) { p.ph_lo = ph; p.ph_hi = ph + 1; hipLaunchKernelGGL(mega, dim3(grid), dim3(512), LDS_BYTES, stream, p); }
#endif
#endif
}
```

```cpp
#define ATTN_VAR(l) (P.ph_hi > 100000 ? (l) + 1 : 0)
#define GEMM_ALIGN true
#define GEMM_SP2 true
#include <hip/hip_runtime.h>
#include <hip/hip_cooperative_groups.h>
#include <cstdio>
#include <cstdint>
namespace cg = cooperative_groups;

#ifndef MK_LAUNCHES
#define MK_LAUNCHES 1
#endif

namespace pg8 {
#define PG8_LAS __attribute__((address_space(3)))
typedef unsigned short bf16_t;
typedef short bf16x8 __attribute__((ext_vector_type(8)));
typedef float f32x4 __attribute__((ext_vector_type(4)));
typedef unsigned u32x4 __attribute__((ext_vector_type(4)));
constexpr int BM = 256, BK = 64, HALF = 128, HTB = HALF * BK * 2  , STAGE_BYTES = 8 * HTB, NXCD = 8, WGM = 8;

__host__ __device__ __forceinline__ int lds_byte(int r, int c) { const int st = (r >> 4) * 2 + (c >> 5), rr = r & 15, cc = c & 31, ob = rr * 64 + cc * 2; return st * 1024 + (ob ^ (((ob >> 9) & 1) << 5)); }
__host__ __device__ __forceinline__ void stage_rc(int b, int& R, int& C) { const int st = b / 1024, sb = b % 1024, swz = sb ^ (((sb >> 9) & 1) << 5); R = (st >> 1) * 16 + swz / 64; C = (st & 1) * 32 + (swz % 64) / 2; }
__host__ __device__ __forceinline__ int perm32(int rho) { const int n = rho >> 4, i = rho & 15; return 8 * (i >> 2) + 4 * n + (i & 3); }

struct Unit { int pm, pn; };
struct Gemm { const bf16_t* A; const bf16_t* Bt; int M, N, K; };

struct StaticOrder {
    int nM, nN, nwg, G, c;
    __host__ __device__ void init(int M, int N, int G_, int c_) { nM = M / BM; nN = N / BM; nwg = nM * nN; G = G_; c = c_; }
    __host__ __device__ bool next(int i, Unit& u) const {
        const long L = (long)i * G + c; if (L >= nwg) return false;
        int wgid = (int)L; { const int q = nwg / NXCD, r = nwg % NXCD, xcd = wgid % NXCD, off = wgid / NXCD; wgid = (xcd < r ? xcd * (q + 1) : r * (q + 1) + (xcd - r) * q) + off; }
        const int nig = WGM * nN, gid = wgid / nig, fm = gid * WGM, gsz = (nM - fm) < WGM ? (nM - fm) : WGM;
        u.pm = fm + ((wgid % nig) % gsz); u.pn = (wgid % nig) / gsz; return true;
    }
    __device__ __forceinline__ void a_ready(const Unit&) const {}
    __device__ __forceinline__ void done(const Unit&) const {}
};
typedef __bf16 bf16v2_t __attribute__((ext_vector_type(2)));
typedef float f32x2_t __attribute__((ext_vector_type(2)));
__device__ __forceinline__ unsigned cvt_pk_bf16(float lo, float hi) { const f32x2_t v = {lo, hi}; const bf16v2_t b = __builtin_convertvector(v, bf16v2_t); return __builtin_bit_cast(unsigned, b); }

typedef _Float16 h16x2_t __attribute__((ext_vector_type(2)));
__device__ __forceinline__ unsigned cvt_pk_f16(float lo, float hi) { const f32x2_t v = {lo, hi}; const h16x2_t h = __builtin_convertvector(v, h16x2_t); return __builtin_bit_cast(unsigned, h); }
__device__ __forceinline__ f32x2_t f16x2_to_f32(unsigned u) { const h16x2_t h = __builtin_bit_cast(h16x2_t, u); return __builtin_convertvector(h, f32x2_t); }
template <class Epi, class Sched, bool ALIGN_EPI = false, bool SP2 = false>
__device__ __forceinline__ void gemm_phase(PG8_LAS unsigned char* lds, const Gemm g, const Sched& S, const Epi& E, const int tid) {
    const int wid = __builtin_amdgcn_readfirstlane(tid >> 6), lane = tid & 63, wr = wid >> 2, wc = wid & 3, fr = lane & 15, fq = lane >> 4;
    const int K = g.K, nt = K / BK;
    unsigned voffA[2], voffB[2];
#pragma unroll
    for (int i = 0; i < 2; ++i) { int R, C; stage_rc(tid * 16 + i * 8192, R, C); const int Rb = E.perm ? ((R & ~31) + perm32(R & 31)) : R;
        voffA[i] = (unsigned)(R * K + C) * 2u; voffB[i] = (unsigned)(Rb * K + C) * 2u; }
    const size_t kstep = (size_t)(BK * 2);
    const size_t hstep = (size_t)HALF * K * 2;
    const size_t tstep = 2 * hstep;
    const unsigned ldsw = (unsigned)wid * 1024u;
    const int aoff = lds_byte(wr * 64 + fr, fq * 8), boff = lds_byte(wc * 32 + fr, fq * 8);
#define PG8_SA(b, h) (((b) * 2 + (h)) * HTB)
#define PG8_SB(b, h) ((4 + (b) * 2 + (h)) * HTB)
#define PG8_STAGE(bufoff, gbase, voff) do { _Pragma("unroll") for (int _i = 0; _i < 2; ++_i) \
        __builtin_amdgcn_global_load_lds((const unsigned*)((const char*)(gbase) + (voff)[_i]), (PG8_LAS unsigned*)(lds + (bufoff) + ldsw + _i * 8192), 16, 0, 0); } while (0)
#define PG8_LDA(dst, b, h) do { _Pragma("unroll") for (int m = 0; m < 4; ++m) _Pragma("unroll") for (int k = 0; k < 2; ++k) dst[m][k] = *(const PG8_LAS bf16x8*)(lds + PG8_SA(b, h) + aoff + m * 2048 + k * 1024); } while (0)
#define PG8_LDB(dst, b, h) do { _Pragma("unroll") for (int n = 0; n < 2; ++n) _Pragma("unroll") for (int k = 0; k < 2; ++k) dst[n][k] = *(const PG8_LAS bf16x8*)(lds + PG8_SB(b, h) + boff + n * 2048 + k * 1024); } while (0)
#define PG8_MMA(ai, bj, At, Bt) do { __builtin_amdgcn_s_setprio(1); _Pragma("unroll") for (int m = 0; m < 4; ++m) _Pragma("unroll") for (int n = 0; n < 2; ++n) _Pragma("unroll") for (int k = 0; k < 2; ++k) \
        acc[ai][bj][m][n] = __builtin_amdgcn_mfma_f32_16x16x32_bf16(Bt[n][k], At[m][k], acc[ai][bj][m][n], 0, 0, 0); __builtin_amdgcn_s_setprio(0); } while (0)
#define PG8_WAIT_V(n) asm volatile("s_waitcnt vmcnt(" #n ")" ::: "memory")
#define PG8_WAIT_L(n) asm volatile("s_waitcnt lgkmcnt(" #n ")" ::: "memory")
#define PG8_BAR __builtin_amdgcn_s_barrier()
#define PG8_SCHED __builtin_amdgcn_sched_barrier(0)
    Unit cur, nxt; int ui = 0;
    if (!S.next(0, cur)) return;
    f32x4 acc[2][2][4][2];
#pragma unroll
    for (int a = 0; a < 2; ++a)
#pragma unroll
        for (int b = 0; b < 2; ++b)
#pragma unroll
            for (int m = 0; m < 4; ++m)
#pragma unroll
                for (int n = 0; n < 2; ++n) acc[a][b][m][n] = (f32x4){0.f, 0.f, 0.f, 0.f};
    bf16x8 At[4][2], B0[2][2], B1[2][2];
    const char* cA = (const char*)g.A + (size_t)cur.pm * tstep; const char* cB = (const char*)g.Bt + (size_t)cur.pn * tstep;
    S.a_ready(cur);
    if constexpr (SP2) {
        PG8_STAGE(PG8_SB(0, 0), cB, voffB); PG8_STAGE(PG8_SB(0, 1), cB + hstep, voffB); PG8_STAGE(PG8_SA(0, 0), cA, voffA); PG8_STAGE(PG8_SA(0, 1), cA + hstep, voffA);
        if (wr == 1) PG8_BAR;
        PG8_WAIT_V(2); PG8_BAR;
        PG8_STAGE(PG8_SB(1, 0), cB + kstep, voffB); PG8_STAGE(PG8_SA(1, 0), cA + kstep, voffA); PG8_STAGE(PG8_SB(1, 1), cB + hstep + kstep, voffB);
        PG8_WAIT_V(6); PG8_BAR;
    } else {
        PG8_STAGE(PG8_SB(0, 0), cB, voffB); PG8_STAGE(PG8_SA(0, 0), cA, voffA); PG8_STAGE(PG8_SB(0, 1), cB + hstep, voffB); PG8_STAGE(PG8_SA(0, 1), cA + hstep, voffA);
        if (wr == 1) PG8_BAR;
        PG8_WAIT_V(4); PG8_BAR;
        PG8_STAGE(PG8_SB(1, 0), cB + kstep, voffB); PG8_STAGE(PG8_SA(1, 0), cA + kstep, voffA); PG8_STAGE(PG8_SB(1, 1), cB + hstep + kstep, voffB);
        PG8_WAIT_V(6); PG8_BAR;
    }
    for (;;) {
        const bool has_next = S.next(ui + 1, nxt);
        const char* nA = has_next ? (const char*)g.A + (size_t)nxt.pm * tstep : cA; const char* nB = has_next ? (const char*)g.Bt + (size_t)nxt.pn * tstep : cB;
        for (int t = 0; t < nt; t += 2) {
            const bool last = (t == nt - 2);
            const char* a1 = cA + (size_t)(t + 1) * kstep;
            const char* a2 = last ? nA : cA + (size_t)(t + 2) * kstep; const char* b2 = last ? nB : cB + (size_t)(t + 2) * kstep;
            const char* a3 = a2 + kstep; const char* b3 = b2 + kstep;
            if (last && has_next) S.a_ready(nxt);
            if constexpr (SP2) {
            PG8_LDB(B0, 0, 0); PG8_LDB(B1, 0, 1); PG8_SCHED; PG8_LDA(At, 0, 0); PG8_STAGE(PG8_SA(1, 1), a1 + hstep, voffA);
            PG8_WAIT_V(8); PG8_WAIT_L(0); PG8_BAR; PG8_MMA(0, 0, At, B0); PG8_MMA(0, 1, At, B1); PG8_BAR; PG8_SCHED;
            PG8_LDA(At, 0, 1); PG8_STAGE(PG8_SB(0, 0), b2, voffB); PG8_STAGE(PG8_SB(0, 1), b2 + hstep, voffB); PG8_STAGE(PG8_SA(0, 0), a2, voffA);
            PG8_WAIT_V(8); PG8_WAIT_L(0); PG8_BAR; PG8_MMA(1, 0, At, B0); PG8_MMA(1, 1, At, B1); PG8_BAR; PG8_SCHED;
            PG8_LDB(B0, 1, 0); PG8_LDB(B1, 1, 1); PG8_SCHED; PG8_LDA(At, 1, 0); PG8_STAGE(PG8_SA(0, 1), a2 + hstep, voffA);
            PG8_WAIT_V(8); PG8_WAIT_L(0); PG8_BAR; PG8_MMA(0, 0, At, B0); PG8_MMA(0, 1, At, B1); PG8_BAR; PG8_SCHED;
            PG8_LDA(At, 1, 1); PG8_STAGE(PG8_SB(1, 0), b3, voffB); PG8_STAGE(PG8_SB(1, 1), b3 + hstep, voffB); PG8_STAGE(PG8_SA(1, 0), a3, voffA);
            PG8_WAIT_V(8); PG8_WAIT_L(0); PG8_BAR; PG8_MMA(1, 0, At, B0); PG8_MMA(1, 1, At, B1); PG8_BAR; PG8_SCHED;
            } else {
            PG8_LDB(B0, 0, 0); PG8_SCHED; PG8_LDA(At, 0, 0); PG8_STAGE(PG8_SA(1, 1), a1 + hstep, voffA);
            PG8_WAIT_L(8); PG8_BAR; PG8_WAIT_L(0); PG8_MMA(0, 0, At, B0); PG8_BAR; PG8_SCHED;
            PG8_LDB(B1, 0, 1); PG8_STAGE(PG8_SB(0, 0), b2, voffB);
            PG8_BAR; PG8_WAIT_L(0); PG8_MMA(0, 1, At, B1); PG8_BAR;
            PG8_LDA(At, 0, 1); PG8_STAGE(PG8_SA(0, 0), a2, voffA);
            PG8_BAR; PG8_WAIT_L(0); PG8_MMA(1, 0, At, B0); PG8_BAR; PG8_SCHED;
            PG8_STAGE(PG8_SB(0, 1), b2 + hstep, voffB);
            PG8_WAIT_V(6); PG8_BAR; PG8_MMA(1, 1, At, B1); PG8_BAR;
            PG8_LDB(B0, 1, 0); PG8_SCHED; PG8_LDA(At, 1, 0); PG8_STAGE(PG8_SA(0, 1), a2 + hstep, voffA);
            PG8_WAIT_L(8); PG8_BAR; PG8_WAIT_L(0); PG8_MMA(0, 0, At, B0); PG8_BAR; PG8_SCHED;
            PG8_LDB(B1, 1, 1); PG8_STAGE(PG8_SB(1, 0), b3, voffB);
            PG8_BAR; PG8_WAIT_L(0); PG8_MMA(0, 1, At, B1); PG8_BAR;
            PG8_LDA(At, 1, 1); PG8_STAGE(PG8_SA(1, 0), a3, voffA);
            PG8_BAR; PG8_WAIT_L(0); PG8_MMA(1, 0, At, B0); PG8_BAR; PG8_SCHED;
            PG8_STAGE(PG8_SB(1, 1), b3 + hstep, voffB);
            PG8_WAIT_V(6); PG8_BAR; PG8_MMA(1, 1, At, B1); PG8_BAR;
            }
        }
        if constexpr (ALIGN_EPI) { if (wr == 0) PG8_BAR; }
        if constexpr (!Epi::AFTER_DRAIN) { E(acc, cur, wr, wc, fr, fq); S.done(cur); }
        if (!has_next) break;
#pragma unroll
        for (int a = 0; a < 2; ++a)
#pragma unroll
            for (int b = 0; b < 2; ++b)
#pragma unroll
                for (int m = 0; m < 4; ++m)
#pragma unroll
                    for (int n = 0; n < 2; ++n) acc[a][b][m][n] = (f32x4){0.f, 0.f, 0.f, 0.f};
        cur = nxt; cA = nA; cB = nB; ++ui;
        if constexpr (ALIGN_EPI) { if (wr == 1) PG8_BAR; }
    }
    PG8_WAIT_V(0);
    if constexpr (!ALIGN_EPI) { if (wr == 0) PG8_BAR; }
    PG8_BAR;
    if constexpr (Epi::AFTER_DRAIN) { E.fused(acc, cur, wr, wc, fr, fq, lds, wid, lane); S.done(cur); }
#undef PG8_SA
#undef PG8_SB
#undef PG8_STAGE
#undef PG8_LDA
#undef PG8_LDB
#undef PG8_MMA
#undef PG8_WAIT_V
#undef PG8_WAIT_L
#undef PG8_BAR
#undef PG8_SCHED
}

__device__ __forceinline__ float silu_f(float x) { return x * __builtin_amdgcn_rcpf(1.f + __builtin_amdgcn_exp2f(-1.44269504089f * x)); }

struct EpiSwiglu {
    static constexpr bool PERM = true, AFTER_DRAIN = false;
    bf16_t* O;
    __device__ __forceinline__ void operator()(const f32x4 (&acc)[2][2][4][2], const Unit& u, int wr, int wc, int fr, int fq) const {
        const int row0 = u.pm * BM + wr * 64 + fr, col0 = u.pn * 128 + wc * 32 + 8 * fq;
#pragma unroll
        for (int ai = 0; ai < 2; ++ai)
#pragma unroll
            for (int m = 0; m < 4; ++m) {
                bf16_t* rowp = O + (size_t)(row0 + ai * HALF + m * 16) * 2816 + col0;
                const f32x4 g0 = acc[ai][0][m][0], g1 = acc[ai][0][m][1], u0 = acc[ai][1][m][0], u1 = acc[ai][1][m][1];
                u32x4 o;
                o.x = cvt_pk_bf16(silu_f(g0[0]) * u0[0], silu_f(g0[1]) * u0[1]); o.y = cvt_pk_bf16(silu_f(g0[2]) * u0[2], silu_f(g0[3]) * u0[3]);
                o.z = cvt_pk_bf16(silu_f(g1[0]) * u1[0], silu_f(g1[1]) * u1[1]); o.w = cvt_pk_bf16(silu_f(g1[2]) * u1[2], silu_f(g1[3]) * u1[3]);
                *(u32x4*)rowp = o;
            }
    }
};
struct EpiResid {
    static constexpr bool PERM = true, AFTER_DRAIN = false;
    const void* hin; void* hout; const float* gt; float scale; int in_f32, out_f32;
    template <bool INF, bool OUTF> __device__ __forceinline__ void run(const f32x4 (&acc)[2][2][4][2], const f32x4 (&gv)[2][2], int row0, int col0) const {
#pragma unroll
        for (int ai = 0; ai < 2; ++ai)
#pragma unroll
            for (int m = 0; m < 4; ++m) {
                const size_t off = (size_t)(row0 + ai * HALF + m * 16) * 1024 + col0;
#pragma unroll
                for (int bj = 0; bj < 2; ++bj) {
                    const size_t o = off + bj * HALF;
                    f32x4 h0, h1;
                    if (INF) { h0 = *(const f32x4*)((const float*)hin + o); h1 = *(const f32x4*)((const float*)hin + o + 4); }
                    else { const u32x4 u = *(const u32x4*)((const bf16_t*)hin + o); const f32x2_t a = f16x2_to_f32(u[0]), c = f16x2_to_f32(u[1]), d = f16x2_to_f32(u[2]), e = f16x2_to_f32(u[3]);
                           h0 = (f32x4){a[0], a[1], c[0], c[1]}; h1 = (f32x4){d[0], d[1], e[0], e[1]}; }
                    const f32x4 r0 = h0 + gv[bj][0] * acc[ai][bj][m][0], r1 = h1 + gv[bj][1] * acc[ai][bj][m][1];
                    if (OUTF) { *(f32x4*)((float*)hout + o) = r0; *(f32x4*)((float*)hout + o + 4) = r1; }
                    else { u32x4 w; w[0] = cvt_pk_f16(r0[0], r0[1]); w[1] = cvt_pk_f16(r0[2], r0[3]); w[2] = cvt_pk_f16(r1[0], r1[1]); w[3] = cvt_pk_f16(r1[2], r1[3]); *(u32x4*)((bf16_t*)hout + o) = w; }
                }
            }
    }
    __device__ __forceinline__ void operator()(const f32x4 (&acc)[2][2][4][2], const Unit& u, int wr, int wc, int fr, int fq) const {
        const int row0 = u.pm * BM + wr * 64 + fr, col0 = u.pn * BM + wc * 32 + 8 * fq;
        const float* gp = gt + (size_t)(u.pm >> 4) * 9216 + col0;
        f32x4 gv[2][2];
#pragma unroll
        for (int bj = 0; bj < 2; ++bj)
#pragma unroll
            for (int n = 0; n < 2; ++n) { const f32x4 t = *(const f32x4*)(gp + bj * HALF + n * 4); gv[bj][n] = (t + 1.0f) * scale; }
        if (in_f32) run<true, false>(acc, gv, row0, col0); else if (out_f32) run<false, true>(acc, gv, row0, col0); else run<false, false>(acc, gv, row0, col0);
    }
};
struct EpiProj {
    static constexpr bool PERM = true, AFTER_DRAIN = false;
    bf16_t* att; bf16_t* rw; bf16_t* cv;
    template <int LD, bool F16> __device__ __forceinline__ void put(const f32x4 (&acc)[2][2][4][2], bf16_t* base, int row0, int col0) const {
#pragma unroll
        for (int ai = 0; ai < 2; ++ai)
#pragma unroll
            for (int m = 0; m < 4; ++m) { bf16_t* rowp = base + (size_t)(row0 + ai * HALF + m * 16) * LD + col0;
#pragma unroll
                for (int bj = 0; bj < 2; ++bj) { const f32x4 v0 = acc[ai][bj][m][0], v1 = acc[ai][bj][m][1]; u32x4 o;
                    o[0] = F16 ? cvt_pk_f16(v0[0], v0[1]) : cvt_pk_bf16(v0[0], v0[1]); o[1] = F16 ? cvt_pk_f16(v0[2], v0[3]) : cvt_pk_bf16(v0[2], v0[3]);
                    o[2] = F16 ? cvt_pk_f16(v1[0], v1[1]) : cvt_pk_bf16(v1[0], v1[1]); o[3] = F16 ? cvt_pk_f16(v1[2], v1[3]) : cvt_pk_bf16(v1[2], v1[3]);
                    *(u32x4*)(rowp + bj * HALF) = o; } }
    }
    __device__ __forceinline__ void operator()(const f32x4 (&acc)[2][2][4][2], const Unit& u, int wr, int wc, int fr, int fq) const {
        const int row0 = u.pm * BM + wr * 64 + fr, cl = wc * 32 + 8 * fq;
        if (u.pn >= 3 && u.pn < 7) put<1024, true>(acc, rw, row0, (u.pn - 3) * BM + cl);
        else put<768, false>(acc, u.pn < 3 ? att : cv, row0, (u.pn < 3 ? u.pn : u.pn - 7) * BM + cl);
    }
};
struct EpiAny {
    int kind; bool perm;
    EpiSwiglu sw; EpiResid rs; EpiProj pj;
    static constexpr bool AFTER_DRAIN = false;
    __device__ __forceinline__ void operator()(const f32x4 (&acc)[2][2][4][2], const Unit& u, int wr, int wc, int fr, int fq) const {
        if (kind == 0) sw(acc, u, wr, wc, fr, fq); else if (kind == 1) rs(acc, u, wr, wc, fr, fq); else pj(acc, u, wr, wc, fr, fq);
    }
};
}

#define LAS __attribute__((address_space(3)))
using pg8::bf16_t; using pg8::bf16x8; using pg8::f32x4; using pg8::u32x4; using pg8::cvt_pk_bf16; using pg8::cvt_pk_f16; using pg8::f16x2_to_f32; using pg8::f32x2_t;
constexpr int NTOK = 32768, SEQL = 4096, DM = 1024, DFF = 2816, DEPTH = 4;
constexpr int LDS_BYTES = 131072 + 64;
constexpr int PPL = 12;
constexpr int NPH = 1 + DEPTH * PPL;

constexpr size_t OFF_MOD = 0;
constexpr size_t OFF_LORA = OFF_MOD + 1179648;
constexpr size_t OFF_BONUS = OFF_LORA + 131072;
constexpr size_t OFF_WB = OFF_BONUS + 524288;
constexpr size_t WB_FFN1IN = 0, WB_FFN1OUT = 5767168, WB_MIXIN = WB_FFN1OUT + 2883584, WB_MIXOUT = WB_MIXIN + 2621440,
                 WB_FFN2IN = WB_MIXOUT + 1048576, WB_FFN2OUT = WB_FFN2IN + 5767168, WB_ELEMS = WB_FFN2OUT + 2883584;
constexpr size_t OFF_HN = OFF_WB + WB_ELEMS * 2;
constexpr size_t OFF_R1 = OFF_HN + (size_t)NTOK * 1024 * 2;
constexpr size_t R1_CONV = (size_t)NTOK * 768 * 2, R1_RWKV = 2 * R1_CONV, R1_BYTES = (size_t)NTOK * 2816 * 2;
constexpr size_t OFF_R2 = OFF_R1 + R1_BYTES;
constexpr int REC_B = 896;
constexpr size_t R2_G = (size_t)NTOK * 4 * REC_B;
constexpr size_t WS_BAR = OFF_R2 + R2_G + (size_t)NTOK * 256 * 2;
constexpr size_t OFF_WB2 = WS_BAR + 16384;
constexpr size_t OFF_LORA2 = OFF_WB2 + WB_ELEMS * 2;
constexpr size_t OFF_YS = OFF_LORA2 + 131072;
constexpr size_t OFF_HB = OFF_YS + (size_t)NTOK * 256 * 4;
constexpr size_t WS_END = OFF_HB + (size_t)NTOK * 1024 * 2;

struct Params { const float* in[28]; float* out; unsigned char* ws; int ph_lo, ph_hi; };

__device__ __forceinline__ float wave_sum(float v) {
#pragma unroll
    for (int o = 1; o < 64; o <<= 1) v += __shfl_xor(v, o);
    return v;
}
template <int CTRL> __device__ __forceinline__ float dpp_f(float x) { return __int_as_float(__builtin_amdgcn_update_dpp(0, __float_as_int(x), CTRL, 0xf, 0xf, true)); }
__device__ __forceinline__ float rowsum16(float x) {
    x += dpp_f<0x128>(x); x += dpp_f<0x124>(x); x += dpp_f<0x122>(x); x += dpp_f<0x121>(x); return x;
}
__device__ __forceinline__ float bflo(unsigned u) { return __uint_as_float(u << 16); }
__device__ __forceinline__ float bfhi(unsigned u) { return __uint_as_float(u & 0xffff0000u); }
__device__ __forceinline__ float sigmoid_f(float x) { return __builtin_amdgcn_rcpf(1.f + __builtin_amdgcn_exp2f(-1.44269504089f * x)); }

__device__ __forceinline__ void phase_mod(const Params& P, LAS unsigned char* lds, int tid, int wid, int lane, int bid, int nblk) {
    LAS float* cact = (LAS float*)lds;
    LAS float* red = (LAS float*)(lds + 32768);
    const float* c = P.in[1];
    float* MOD = (float*)(P.ws + OFF_MOD);
    for (int i = tid; i < 8192; i += 512) { const float v = c[i]; cact[i] = v / (1.f + __expf(-v)); }
    __syncthreads();
    for (int item = bid; item < 288; item += nblk) {
        const int l = item / 72, j0 = (item % 72) * 128, k0 = wid * 128;
        const float* W = P.in[2] + (size_t)l * 1024 * 9216 + j0 + 2 * lane;
        float a0[8], a1[8];
#pragma unroll
        for (int b = 0; b < 8; ++b) { a0[b] = 0.f; a1[b] = 0.f; }
#pragma unroll 8
        for (int k = 0; k < 128; ++k) {
            const float2 w = *(const float2*)(W + (size_t)(k0 + k) * 9216);
#pragma unroll
            for (int b = 0; b < 8; ++b) { const float ca = cact[b * 1024 + k0 + k]; a0[b] += ca * w.x; a1[b] += ca * w.y; }
        }
#pragma unroll
        for (int b = 0; b < 8; ++b) { red[(wid * 8 + b) * 128 + 2 * lane] = a0[b]; red[(wid * 8 + b) * 128 + 2 * lane + 1] = a1[b]; }
        __syncthreads();
        for (int o = tid; o < 1024; o += 512) {
            const int b = o >> 7, ci = o & 127; float s = 0.f;
#pragma unroll
            for (int w = 0; w < 8; ++w) s += red[(w * 8 + b) * 128 + ci];
            MOD[(size_t)(l * 8 + b) * 9216 + j0 + ci] = s + P.in[3][l * 9216 + j0 + ci];
        }
        __syncthreads();
    }
}

__device__ __forceinline__ void transpose_item(const float* W, int K, int N, bf16_t* WT, int k0, int n0, int drow0, LAS float* scr, int lane) {
#pragma unroll 8
    for (int i = 0; i < 32; ++i) { const int kk = 2 * i + (lane >> 5); scr[kk * 33 + (lane & 31)] = W[(size_t)(k0 + kk) * N + n0 + (lane & 31)]; }
    asm volatile("s_waitcnt lgkmcnt(0)" ::: "memory");
    const int c = lane & 7;
#pragma unroll
    for (int j = 0; j < 4; ++j) { const int n = (lane >> 3) + 8 * j; const LAS float* s = scr + (8 * c) * 33 + n;
        u32x4 o; o.x = cvt_pk_bf16(s[0 * 33], s[1 * 33]); o.y = cvt_pk_bf16(s[2 * 33], s[3 * 33]); o.z = cvt_pk_bf16(s[4 * 33], s[5 * 33]); o.w = cvt_pk_bf16(s[6 * 33], s[7 * 33]);
        *(u32x4*)(WT + (size_t)(drow0 + n) * K + k0 + 8 * c) = o; }
    asm volatile("s_waitcnt lgkmcnt(0)" ::: "memory");
}
__device__ __forceinline__ int swiglu_row(int n0) { return n0 < DFF ? ((n0 >> 7) * 256 + (n0 & 127)) : (((n0 - DFF) >> 7) * 256 + 128 + ((n0 - DFF) & 127)); }
__device__ __forceinline__ void phase_convert(const Params& P, int l, LAS unsigned char* lds, int wid, int lane, int bid, int nblk) {
    LAS float* scr = (LAS float*)(lds + wid * 8448);
    bf16_t* WB = (bf16_t*)(P.ws + ((l & 1) ? OFF_WB2 : OFF_WB));
    bf16_t* LT = (bf16_t*)(P.ws + ((l & 1) ? OFF_LORA2 : OFF_LORA));
    const int gw = bid * 8 + wid, NGW = nblk * 8;
    constexpr int I_IN = 16 * 176, I_OUT = 44 * 32, I_MI = 16 * 80, I_MO = 16 * 32;
    constexpr int NIT = 2 * I_IN + 2 * I_OUT + I_MI + I_MO + 32;
    for (int it = gw; it < NIT; it += NGW) {
        int r = it;
        if (r < I_IN) { const int kb = r / 176, nb = r % 176; transpose_item(P.in[5] + (size_t)l * 1024 * 5632, 1024, 5632, WB + WB_FFN1IN, kb * 64, nb * 32, swiglu_row(nb * 32), scr, lane); continue; } r -= I_IN;
        if (r < I_OUT) { const int kb = r / 32, nb = r % 32; transpose_item(P.in[6] + (size_t)l * 2816 * 1024, 2816, 1024, WB + WB_FFN1OUT, kb * 64, nb * 32, nb * 32, scr, lane); continue; } r -= I_OUT;
        if (r < I_MI) { const int kb = r / 80, nb = r % 80; transpose_item(P.in[8] + (size_t)l * 1024 * 2560, 1024, 2560, WB + WB_MIXIN, kb * 64, nb * 32, nb * 32, scr, lane); continue; } r -= I_MI;
        if (r < I_MO) { const int kb = r / 32, nb = r % 32; transpose_item(P.in[9] + (size_t)l * 1024 * 1024, 1024, 1024, WB + WB_MIXOUT, kb * 64, nb * 32, nb * 32, scr, lane); continue; } r -= I_MO;
        if (r < I_IN) { const int kb = r / 176, nb = r % 176; transpose_item(P.in[26] + (size_t)l * 1024 * 5632, 1024, 5632, WB + WB_FFN2IN, kb * 64, nb * 32, swiglu_row(nb * 32), scr, lane); continue; } r -= I_IN;
        if (r < I_OUT) { const int kb = r / 32, nb = r % 32; transpose_item(P.in[27] + (size_t)l * 2816 * 1024, 2816, 1024, WB + WB_FFN2OUT, kb * 64, nb * 32, nb * 32, scr, lane); continue; } r -= I_OUT;
        if (r < 8) { transpose_item(P.in[15] + (size_t)l * 64 * 256, 64, 256, LT, 0, r * 32, r * 32, scr, lane); continue; } r -= 8;
        if (r < 8) { transpose_item(P.in[17] + (size_t)l * 64 * 256, 64, 256, LT + 16384, 0, r * 32, r * 32, scr, lane); continue; } r -= 8;
        { const int kb = r / 8, nb = r % 8; transpose_item(P.in[18] + (size_t)l * 128 * 256, 128, 256, LT + 32768, kb * 64, nb * 32, nb * 32, scr, lane); }
    }
}

template <bool INF>
__device__ __forceinline__ void phase_norm(const Params& P, const void* hin, const float* gain, const float* modl  , int wid, int lane, int bid, int nblk) {
    bf16_t* HN = (bf16_t*)(P.ws + OFF_HN);
    for (int row0 = (bid * 8 + wid) * 4; row0 < NTOK; row0 += nblk * 32) {
        f32x4 v[4][4]; float ss[4];
#pragma unroll
        for (int r = 0; r < 4; ++r) {
            if (INF) { const f32x4* xr = (const f32x4*)((const float*)hin + (size_t)(row0 + r) * 1024) + lane;
#pragma unroll
                for (int j = 0; j < 4; ++j) v[r][j] = xr[64 * j]; }
            else { const u32x4* xr = (const u32x4*)((const bf16_t*)hin + (size_t)(row0 + r) * 1024) + lane;
#pragma unroll
                for (int j2 = 0; j2 < 2; ++j2) { const u32x4 w = xr[64 * j2]; const f32x2_t a = f16x2_to_f32(w[0]), c = f16x2_to_f32(w[1]), d = f16x2_to_f32(w[2]), e = f16x2_to_f32(w[3]);
                    v[r][2 * j2] = (f32x4){a[0], a[1], c[0], c[1]}; v[r][2 * j2 + 1] = (f32x4){d[0], d[1], e[0], e[1]}; } }
        }
#pragma unroll
        for (int r = 0; r < 4; ++r) { float a = 0.f;
#pragma unroll
            for (int j = 0; j < 4; ++j) a += (v[r][j][0] * v[r][j][0] + v[r][j][1] * v[r][j][1]) + (v[r][j][2] * v[r][j][2] + v[r][j][3] * v[r][j][3]);
            ss[r] = a; }
#pragma unroll
        for (int o = 1; o < 64; o <<= 1) {
#pragma unroll
            for (int r = 0; r < 4; ++r) ss[r] += __shfl_xor(ss[r], o);
        }
        const float* sh = modl + (size_t)(row0 >> 12) * 9216; const float* sc = sh + 1024;
        float rstd[4];
#pragma unroll
        for (int r = 0; r < 4; ++r) rstd[r] = rsqrtf(ss[r] * (1.f / 1024.f) + 1e-6f);
        if (INF) {
#pragma unroll
            for (int j = 0; j < 4; ++j) {
                const int col = lane * 4 + 256 * j;
                const f32x4 gs = *(const f32x4*)(gain + col) * (*(const f32x4*)(sc + col) + 1.0f), s0 = *(const f32x4*)(sh + col);
#pragma unroll
                for (int r = 0; r < 4; ++r) { const f32x4 y = v[r][j] * rstd[r] * gs + s0; uint2 o; o.x = cvt_pk_bf16(y[0], y[1]); o.y = cvt_pk_bf16(y[2], y[3]);
                    ((uint2*)(HN + (size_t)(row0 + r) * 1024) + lane)[64 * j] = o; }
            }
        } else {
#pragma unroll
            for (int j2 = 0; j2 < 2; ++j2) {
                const int col = lane * 8 + 512 * j2;
                const f32x4 gsa = *(const f32x4*)(gain + col) * (*(const f32x4*)(sc + col) + 1.0f), gsb = *(const f32x4*)(gain + col + 4) * (*(const f32x4*)(sc + col + 4) + 1.0f);
                const f32x4 s0a = *(const f32x4*)(sh + col), s0b = *(const f32x4*)(sh + col + 4);
#pragma unroll
                for (int r = 0; r < 4; ++r) { const f32x4 ya = v[r][2 * j2] * rstd[r] * gsa + s0a, yb = v[r][2 * j2 + 1] * rstd[r] * gsb + s0b;
                    u32x4 o; o[0] = cvt_pk_bf16(ya[0], ya[1]); o[1] = cvt_pk_bf16(ya[2], ya[3]); o[2] = cvt_pk_bf16(yb[0], yb[1]); o[3] = cvt_pk_bf16(yb[2], yb[3]);
                    ((u32x4*)(HN + (size_t)(row0 + r) * 1024) + lane)[64 * j2] = o; }
            }
        }
    }
}

__device__ __forceinline__ bf16x8 pack8(const float* f) {
    u32x4 o; o.x = cvt_pk_bf16(f[0], f[1]); o.y = cvt_pk_bf16(f[2], f[3]); o.z = cvt_pk_bf16(f[4], f[5]); o.w = cvt_pk_bf16(f[6], f[7]);
    return __builtin_bit_cast(bf16x8, o);
}
__device__ __forceinline__ void attn_item(const Params& P, int l, int item, LAS unsigned char* lds, int tid, int wid, int lane, int var) {
    const bf16_t* PA = (const bf16_t*)(P.ws + OFF_R1);
    bf16_t* Y = (bf16_t*)(P.ws + OFF_HN);
    const int b = item >> 6, n = (item >> 1) & 31, hk = item & 1;
    LAS bf16_t* Ks = (LAS bf16_t*)lds;
    LAS bf16_t* Vt = (LAS bf16_t*)(lds + 36864);
    const float* kg = P.in[11] + l * 64; const float* qg = P.in[10] + l * 64;
    {
        const int row = tid >> 1, half = tid & 1, kt = n * 128 - 128 + row;
        u32x4 kv[4], vv[4];
        if (kt >= 0) {
            const bf16_t* src = PA + (size_t)(b * SEQL + kt) * 768 + 512 + hk * 64 + half * 32;
#pragma unroll
            for (int i = 0; i < 4; ++i) { kv[i] = ((const u32x4*)src)[i]; vv[i] = ((const u32x4*)(src + 128))[i]; }
        } else {
#pragma unroll
            for (int i = 0; i < 4; ++i) { kv[i] = (u32x4){0u, 0u, 0u, 0u}; vv[i] = (u32x4){0u, 0u, 0u, 0u}; }
        }
        float kf[32]; float ss = 0.f;
#pragma unroll
        for (int i = 0; i < 4; ++i)
#pragma unroll
            for (int j = 0; j < 4; ++j) { const float a = bflo(kv[i][j]), c = bfhi(kv[i][j]); kf[i * 8 + 2 * j] = a; kf[i * 8 + 2 * j + 1] = c; ss += a * a + c * c; }
        ss += __shfl_xor(ss, 1);
        const float rstd = rsqrtf(ss * (1.f / 64.f) + 1e-6f);
#pragma unroll
        for (int i = 0; i < 32; ++i) kf[i] *= rstd * kg[half * 32 + i];
#pragma unroll
        for (int i = 0; i < 4; ++i) *(LAS bf16x8*)(Ks + row * 72 + half * 32 + i * 8) = pack8(kf + i * 8);
        const int r32 = row & 31, kp = (row & ~31) + ((r32 & 15) >> 2) * 8 + (r32 >> 4) * 4 + (r32 & 3);
#pragma unroll
        for (int i = 0; i < 4; ++i)
#pragma unroll
            for (int j = 0; j < 4; ++j) { const unsigned w = vv[i][j]; Vt[(half * 32 + i * 8 + 2 * j) * 264 + kp] = (bf16_t)(w & 0xffffu); Vt[(half * 32 + i * 8 + 2 * j + 1) * 264 + kp] = (bf16_t)(w >> 16); }
    }
    __syncthreads();
    const int fr = lane & 15, fq = lane >> 4, hq = hk * 4 + (wid >> 1);
    const float sink = P.in[12][l * 8 + hq];
    for (int i = 0; i < 4; ++i) {
        if (var == 1) { asm volatile("s_waitcnt vmcnt(0) lgkmcnt(0)" ::: "memory"); __syncthreads(); }
        const int q0 = ((wid & 1) * 4 + i) * 16, kb0 = q0 >> 5;
        const bf16_t* qp = PA + (size_t)(b * SEQL + n * 128 + q0 + fr) * 768 + hq * 64 + fq * 8;
        const u32x4 qa = *(const u32x4*)qp, qb = *(const u32x4*)(qp + 32);
        float qf[16]; float ss = 0.f;
#pragma unroll
        for (int j = 0; j < 4; ++j) { qf[2 * j] = bflo(qa[j]); qf[2 * j + 1] = bfhi(qa[j]); qf[8 + 2 * j] = bflo(qb[j]); qf[8 + 2 * j + 1] = bfhi(qb[j]); }
#pragma unroll
        for (int j = 0; j < 16; ++j) ss += qf[j] * qf[j];
        ss += __shfl_xor(ss, 16); ss += __shfl_xor(ss, 32);
        const float rstd = rsqrtf(ss * (1.f / 64.f) + 1e-6f) * 0.125f;
#pragma unroll
        for (int j = 0; j < 8; ++j) { qf[j] *= rstd * qg[fq * 8 + j]; qf[8 + j] *= rstd * qg[32 + fq * 8 + j]; }
        const bf16x8 Q0 = pack8(qf), Q1 = pack8(qf + 8);
        f32x4 s[10];
#pragma unroll
        for (int tt = 0; tt < 10; ++tt) {
            const LAS bf16_t* kr = Ks + ((2 * kb0 + tt) * 16 + fr) * 72 + fq * 8;
            const bf16x8 K0 = *(const LAS bf16x8*)kr, K1 = *(const LAS bf16x8*)(kr + 32);
            f32x4 z = (f32x4){0.f, 0.f, 0.f, 0.f};
            z = __builtin_amdgcn_mfma_f32_16x16x32_bf16(K0, Q0, z, 0, 0, 0);
            s[tt] = __builtin_amdgcn_mfma_f32_16x16x32_bf16(K1, Q1, z, 0, 0, 0);
        }
        if (var == 3) {
#pragma unroll
            for (int tt = 0; tt < 10; ++tt) s[tt] = (f32x4){0.25f, 0.5f, 0.125f, 0.375f};
        }
        const int qi = q0 + fr;
        float m = sink;
#pragma unroll
        for (int tt = 0; tt < 10; ++tt)
#pragma unroll
            for (int j = 0; j < 4; ++j) {
                const int kidx = (2 * kb0 + tt) * 16 + fq * 4 + j;
                const bool vis = (kidx > qi) && (kidx <= qi + 128) && (n > 0 || kidx >= 128);
                const float sv = vis ? s[tt][j] : -INFINITY; s[tt][j] = sv; m = fmaxf(m, sv);
            }
        m = fmaxf(m, __shfl_xor(m, 16)); m = fmaxf(m, __shfl_xor(m, 32));
        float sum = 0.f;
#pragma unroll
        for (int tt = 0; tt < 10; ++tt)
#pragma unroll
            for (int j = 0; j < 4; ++j) { const float p = __expf(s[tt][j] - m); s[tt][j] = p; sum += p; }
        sum += __shfl_xor(sum, 16); sum += __shfl_xor(sum, 32);
        sum += __expf(sink - m);
        const float inv = 1.f / sum;
        f32x4 o[4];
#pragma unroll
        for (int dt = 0; dt < 4; ++dt) o[dt] = (f32x4){0.f, 0.f, 0.f, 0.f};
        if (var == 2) {
#pragma unroll
            for (int dt = 0; dt < 4; ++dt) o[dt] = s[dt] + s[4 + dt] + s[(8 + dt) > 9 ? 9 : 8 + dt];
        } else
        {
#pragma unroll
        for (int kb = 0; kb < 5; ++kb) {
            float pf[8];
#pragma unroll
            for (int j = 0; j < 4; ++j) { pf[j] = s[2 * kb][j] * inv; pf[4 + j] = s[2 * kb + 1][j] * inv; }
            const bf16x8 Pf = pack8(pf);
#pragma unroll
            for (int dt = 0; dt < 4; ++dt) {
                const bf16x8 Vf = *(const LAS bf16x8*)(Vt + (dt * 16 + fr) * 264 + (kb0 + kb) * 32 + fq * 8);
                o[dt] = __builtin_amdgcn_mfma_f32_16x16x32_bf16(Pf, Vf, o[dt], 0, 0, 0);
            }
        }
        }
#pragma unroll
        for (int dt = 0; dt < 4; ++dt)
#pragma unroll
            for (int j = 0; j < 4; ++j)
                Y[(size_t)(b * SEQL + n * 128 + q0 + fq * 4 + j) * 1024 + hq * 64 + dt * 16 + fr] = (bf16_t)(cvt_pk_bf16(o[dt][j], 0.f) & 0xffffu);
    }
    __syncthreads();
}

__device__ __forceinline__ void conv_part(const Params& P, int l, int tid, int bid, int nblk) {
    const bf16_t* PC = (const bf16_t*)(P.ws + OFF_R1 + R1_CONV);
    bf16_t* Y = (bf16_t*)(P.ws + OFF_HN);
    const float* cw = P.in[24] + l * 768;
    for (int idx = bid * 512 + tid; idx < NTOK * 32; idx += nblk * 512) {
        const int tok = idx >> 5, c = (idx & 31) * 8, t = tok & (SEQL - 1);
        const bf16_t* p = PC + (size_t)tok * 768 + c;
        const u32x4 bg = *(const u32x4*)p;
        float u[3][8];
#pragma unroll
        for (int d = 0; d < 3; ++d) {
            if (t >= d) { const u32x4 cg4 = *(const u32x4*)(p - d * 768 + 256), hg = *(const u32x4*)(p - d * 768 + 512);
#pragma unroll
                for (int j = 0; j < 4; ++j) { u[d][2 * j] = bflo(cg4[j]) * bflo(hg[j]); u[d][2 * j + 1] = bfhi(cg4[j]) * bfhi(hg[j]); }
            } else {
#pragma unroll
                for (int j = 0; j < 8; ++j) u[d][j] = 0.f;
            }
        }
        float y[8];
#pragma unroll
        for (int j = 0; j < 8; ++j) {
            const float bgv = (j & 1) ? bfhi(bg[j >> 1]) : bflo(bg[j >> 1]);
            y[j] = bgv * (cw[c + j] * u[2][j] + cw[256 + c + j] * u[1][j] + cw[512 + c + j] * u[0][j]);
        }
        *(bf16x8*)(Y + (size_t)tok * 1024 + 768 + c) = pack8(y);
    }
}

template <int MODE>
__device__ __forceinline__ void prep_tile(const Params& P, int l, int tile, LAS unsigned char* lds, int tid, int wid, int lane) {
    const bf16_t* PR = (const bf16_t*)(P.ws + OFF_R1 + R1_RWKV);
    unsigned char* REC = P.ws + OFF_R2;
    bf16_t* G = (bf16_t*)(P.ws + OFF_R2 + R2_G);
    float* BON = (float*)(P.ws + OFF_BONUS);
    LAS bf16_t* Xs = (LAS bf16_t*)lds;
    const float* mu = P.in[13] + l * 1024;
    const int tok0 = tile * 64;
    {
        const int t = tid >> 3, seg = tid & 7, tok = tok0 + t; const bool first = (tok & (SEQL - 1)) == 0;
        const bf16_t* p = PR + (size_t)tok * 1024 + 768 + seg * 32;
        const float c1 = seg < 2 ? 2.f : 1.f, c2 = seg < 2 ? 2.f : 1.f, c3 = seg < 2 ? -1.f : 0.f; const bool ident = (seg == 2 || seg == 3);
        if ((MODE == 0) == (seg < 4)) {
#pragma unroll
        for (int i = 0; i < 4; ++i) {
            float xo[8];
            const u32x4 ca = ((const u32x4*)p)[i], cp = first ? (u32x4){0u, 0u, 0u, 0u} : ((const u32x4*)(p - 1024))[i];
#pragma unroll
            for (int hh = 0; hh < 2; ++hh) {
                const f32x2_t a01 = f16x2_to_f32(ca[2 * hh]), a23 = f16x2_to_f32(ca[2 * hh + 1]), p01 = f16x2_to_f32(cp[2 * hh]), p23 = f16x2_to_f32(cp[2 * hh + 1]);
                const f32x4 a = (f32x4){a01[0], a01[1], a23[0], a23[1]};
                const f32x4 pv = (f32x4){p01[0], p01[1], p23[0], p23[1]};
                const f32x4 m = ((const f32x4*)(mu + 768 + seg * 32))[2 * i + hh];
                const f32x4 x = a + m * (pv - a);
#pragma unroll
                for (int j = 0; j < 4; ++j) { const float sg = sigmoid_f(c1 * x[j]) * c2 + c3; xo[hh * 4 + j] = ident ? x[j] : sg; }
            }
            *(LAS bf16x8*)(Xs + t * 264 + seg * 32 + i * 8) = pack8(xo);
        }
        }
    }
    __syncthreads();
    const int fr = lane & 15, fq = lane >> 4, hh = wid & 3;
    const bf16_t* WTw = (const bf16_t*)(P.ws + ((l & 1) ? OFF_LORA2 : OFF_LORA)); const bf16_t* WTa = WTw + 16384; const bf16_t* WTg = WTw + 32768;
    const float* w0 = P.in[14] + l * 256; const float* a0 = P.in[16] + l * 256; const float* k_k = P.in[19] + l * 256;
    const float* k_a = P.in[20] + l * 256; const float* r_k = P.in[21] + l * 256;
#pragma unroll
    for (int ti = 0; ti < 2; ++ti) {
        const int tq = (wid >> 2) * 2 + ti;
        bf16x8 xb[8];
#pragma unroll
        for (int ks = (MODE == 0 ? 0 : 4); ks < (MODE == 0 ? 4 : 8); ++ks) xb[ks] = *(const LAS bf16x8*)(Xs + (tq * 16 + fr) * 264 + ks * 32 + fq * 8);
        f32x4 aw[4], aa[4], ag[4];
#pragma unroll
        for (int ct = 0; ct < 4; ++ct) {
            const int col = hh * 64 + ct * 16 + fr;
            f32x4 z = (f32x4){0.f, 0.f, 0.f, 0.f};
            if (MODE == 0) {
#pragma unroll
            for (int ks = 0; ks < 2; ++ks) z = __builtin_amdgcn_mfma_f32_16x16x32_bf16(*(const bf16x8*)(WTw + col * 64 + ks * 32 + fq * 8), xb[ks], z, 0, 0, 0);
            aw[ct] = z; z = (f32x4){0.f, 0.f, 0.f, 0.f};
#pragma unroll
            for (int ks = 0; ks < 2; ++ks) z = __builtin_amdgcn_mfma_f32_16x16x32_bf16(*(const bf16x8*)(WTa + col * 64 + ks * 32 + fq * 8), xb[2 + ks], z, 0, 0, 0);
            aa[ct] = z; z = (f32x4){0.f, 0.f, 0.f, 0.f};
            } else {
#pragma unroll
            for (int ks = 0; ks < 4; ++ks) z = __builtin_amdgcn_mfma_f32_16x16x32_bf16(*(const bf16x8*)(WTg + col * 128 + ks * 32 + fq * 8), xb[4 + ks], z, 0, 0, 0);
            ag[ct] = z;
            }
        }
        const int tok = tok0 + tq * 16 + fr; const bool first = (tok & (SEQL - 1)) == 0;
        if (MODE == 1) {
#pragma unroll
            for (int ct = 0; ct < 4; ++ct) { const int c4 = hh * 64 + ct * 16 + fq * 4; uint2 go; go.x = cvt_pk_f16(ag[ct][0], ag[ct][1]); go.y = cvt_pk_f16(ag[ct][2], ag[ct][3]);
                *(uint2*)(G + (size_t)tok * 256 + c4) = go; }
            continue;
        }
        const bf16_t* pr = PR + (size_t)tok * 1024;
        unsigned char* rec = REC + ((size_t)tok * 4 + hh) * REC_B;
        f32x4 kkv[4], av[4]; float ss = 0.f, bon = 0.f;
        uint2 cur[4][3], prv[4][3];
#pragma unroll
        for (int ct = 0; ct < 4; ++ct)
#pragma unroll
            for (int q = 0; q < 3; ++q) {
                const int c4 = hh * 64 + ct * 16 + fq * 4;
                cur[ct][q] = *(const uint2*)(pr + q * 256 + c4);
                prv[ct][q] = first ? (uint2){0u, 0u} : *(const uint2*)(pr - 1024 + q * 256 + c4);
            }
#pragma unroll
        for (int ct = 0; ct < 4; ++ct) {
            const int c4 = hh * 64 + ct * 16 + fq * 4, lo = ct * 16 + fq * 4;
            f32x4 x3[3];
#pragma unroll
            for (int q = 0; q < 3; ++q) {
                const f32x4 m = *(const f32x4*)(mu + q * 256 + c4);
                const uint2 cu = cur[ct][q], pu = prv[ct][q];
                const f32x2_t c01 = f16x2_to_f32(cu.x), c23 = f16x2_to_f32(cu.y), q01 = f16x2_to_f32(pu.x), q23 = f16x2_to_f32(pu.y);
                const f32x4 cf = (f32x4){c01[0], c01[1], c23[0], c23[1]}, pf = (f32x4){q01[0], q01[1], q23[0], q23[1]};
                x3[q] = cf + m * (pf - cf);
            }
            const f32x4 r4 = x3[0], k4 = x3[1], v4 = x3[2];
            const f32x4 w0v = *(const f32x4*)(w0 + c4), a0v = *(const f32x4*)(a0 + c4), kkw = *(const f32x4*)(k_k + c4), kaw = *(const f32x4*)(k_a + c4), rkw = *(const f32x4*)(r_k + c4);
            f32x4 dec, a4, kp;
#pragma unroll
            for (int j = 0; j < 4; ++j) {
                const float w = w0v[j] + aw[ct][j];
                dec[j] = __builtin_amdgcn_exp2f((-0.6065306597126334f * 1.4426950408889634f) * sigmoid_f(w));
                a4[j] = sigmoid_f(a0v[j] + aa[ct][j]);
            }
            kkv[ct] = k4 * kkw; av[ct] = a4;
            kp = k4 * ((a4 - 1.0f) * kaw + 1.0f);
#pragma unroll
            for (int j = 0; j < 4; ++j) { ss += kkv[ct][j] * kkv[ct][j]; bon += r4[j] * kp[j] * rkw[j]; }
            *(f32x4*)(rec + lo * 4) = dec;
            { uint2 t; t.x = cvt_pk_f16(r4[0], r4[1]); t.y = cvt_pk_f16(r4[2], r4[3]); *(uint2*)(rec + 256 + 0 * 128 + lo * 2) = t;
              t.x = cvt_pk_f16(kp[0], kp[1]); t.y = cvt_pk_f16(kp[2], kp[3]); *(uint2*)(rec + 256 + 1 * 128 + lo * 2) = t;
              t.x = cvt_pk_f16(v4[0], v4[1]); t.y = cvt_pk_f16(v4[2], v4[3]); *(uint2*)(rec + 256 + 2 * 128 + lo * 2) = t; }
        }
        ss += __shfl_xor(ss, 16); ss += __shfl_xor(ss, 32); bon += __shfl_xor(bon, 16); bon += __shfl_xor(bon, 32);
        const float rn = ss > 1e-24f ? __builtin_amdgcn_rsqf(ss) : 1e12f;
#pragma unroll
        for (int ct = 0; ct < 4; ++ct) { const int lo = ct * 16 + fq * 4; const f32x4 kk = kkv[ct] * rn, ka = kk * av[ct]; uint2 t;
            t.x = cvt_pk_f16(kk[0], kk[1]); t.y = cvt_pk_f16(kk[2], kk[3]); *(uint2*)(rec + 256 + 3 * 128 + lo * 2) = t;
            t.x = cvt_pk_f16(ka[0], ka[1]); t.y = cvt_pk_f16(ka[2], ka[3]); *(uint2*)(rec + 256 + 4 * 128 + lo * 2) = t; }
        if (fq == 0) BON[(size_t)tok * 4 + hh] = bon;
    }
    __syncthreads();
}

__device__ __forceinline__ void scan_stage_piece(LAS float* buf, int idx, u32x4 w) {
    const int s = idx / 56, o = idx % 56;
    if (o < 16) { *(LAS u32x4*)(buf + s * 384 + 64 + o * 4) = w; }
    else {
        const int p = o - 16, q = p >> 3, j = p & 7, dq = q == 0 ? 0 : q + 1;
        LAS float* d = buf + s * 384 + dq * 64 + j * 8;
        const f32x2_t e0 = f16x2_to_f32(w[0]), e1 = f16x2_to_f32(w[1]), e2 = f16x2_to_f32(w[2]), e3 = f16x2_to_f32(w[3]);
        *(LAS f32x4*)d = (f32x4){e0[0], e0[1], e1[0], e1[1]};
        *(LAS f32x4*)(d + 4) = (f32x4){e2[0], e2[1], e3[0], e3[1]};
    }
}
__device__ __forceinline__ void phase_scan(const Params& P, LAS unsigned char* lds, int tid, int wid, int lane, int bid, int nblk) {
    const unsigned char* REC = P.ws + OFF_R2;
    float* YS = (float*)(P.ws + OFF_YS);
    for (int item = bid; item < 128; item += nblk) {
        const int bh = (item & 7) * 4 + ((item >> 3) & 3), rg = item >> 5, b = bh >> 2, h = bh & 3;
        const unsigned char* src0 = REC + ((size_t)(b * SEQL) * 4 + h) * REC_B;
        u32x4 st[7]; const int ltid = tid - 256;
        if (wid >= 4) {
#pragma unroll
            for (int i = 0; i < 7; ++i) { const int idx = ltid + 256 * i, s = idx / 56, o = idx % 56; st[i] = *(const u32x4*)(src0 + (size_t)s * (4 * REC_B) + o * 16); }
#pragma unroll
            for (int i = 0; i < 7; ++i) scan_stage_piece((LAS float*)lds, ltid + 256 * i, st[i]);
        }
        __syncthreads();
        typedef float f32x2v __attribute__((ext_vector_type(2)));
        f32x2v Sa = {0.f, 0.f}, Sb = {0.f, 0.f};
        const int rl = lane >> 4, kq = lane & 15, row = rg * 16 + (wid & 3) * 4 + rl;
        for (int ch = 0; ch < 128; ++ch) {
            if (wid >= 4 && ch + 1 < 128) {
#pragma unroll
                for (int i = 0; i < 7; ++i) { const int idx = ltid + 256 * i, s = idx / 56, o = idx % 56; st[i] = *(const u32x4*)(src0 + (size_t)((ch + 1) * 32 + s) * (4 * REC_B) + o * 16); }
            }
            if (wid < 4) {
                const LAS float* buf = (const LAS float*)(lds + (ch & 1) * 49152);
                float* yp = YS + (size_t)(b * SEQL + ch * 32 + kq) * 256 + h * 64 + row;
                const LAS float* rc = buf + kq * 4;
                const LAS float* rv = buf + 192 + row;
                f32x4 r4 = *(const LAS f32x4*)(rc), w4 = *(const LAS f32x4*)(rc + 64), k4 = *(const LAS f32x4*)(rc + 128), kk4 = *(const LAS f32x4*)(rc + 256), ka4 = *(const LAS f32x4*)(rc + 320);
                float v = rv[0];
                float oacc = 0.f;
#define LO2(x) __builtin_shufflevector(x, x, 0, 1)
#define HI2(x) __builtin_shufflevector(x, x, 2, 3)
#pragma unroll
                for (int s = 0; s < 32; ++s) {
                    f32x4 nr4 = r4, nw4 = w4, nk4 = k4, nkk4 = kk4, nka4 = ka4; float nv = v;
                    if (s + 1 < 32) {
                        const LAS float* rn = rc + (s + 1) * 384;
                        nr4 = *(const LAS f32x4*)(rn); nw4 = *(const LAS f32x4*)(rn + 64); nk4 = *(const LAS f32x4*)(rn + 128); nkk4 = *(const LAS f32x4*)(rn + 256); nka4 = *(const LAS f32x4*)(rn + 320);
                        nv = rv[(s + 1) * 384];
                    }
                    f32x2v d2 = Sa * LO2(kk4); d2 = Sb * HI2(kk4) + d2;
                    const float d = rowsum16(d2[0] + d2[1]);
                    const f32x2v vv = {v, v}, dd = {d, d};
                    f32x2v ta = Sa * LO2(w4), tb = Sb * HI2(w4);
                    ta = vv * LO2(k4) + ta; tb = vv * HI2(k4) + tb;
                    Sa = ta - dd * LO2(ka4); Sb = tb - dd * HI2(ka4);
                    f32x2v o2 = Sa * LO2(r4); o2 = Sb * HI2(r4) + o2;
                    const float o = rowsum16(o2[0] + o2[1]);
                    oacc = (kq == (s & 15)) ? o : oacc;
                    if ((s & 15) == 15) yp[(size_t)(s - 15) * 256] = oacc;
                    r4 = nr4; w4 = nw4; k4 = nk4; kk4 = nkk4; ka4 = nka4; v = nv;
                }
#undef LO2
#undef HI2
            }
            if (wid >= 4 && ch + 1 < 128) {
#pragma unroll
                for (int i = 0; i < 7; ++i) scan_stage_piece((LAS float*)(lds + ((ch + 1) & 1) * 49152), ltid + 256 * i, st[i]);
            }
            __syncthreads();
        }
    }
}

__device__ __forceinline__ float rowsum8(float x) {
    x += dpp_f<0xB1>(x); x += dpp_f<0x4E>(x); x += dpp_f<0x141>(x); return x;
}
__device__ __forceinline__ void phase_post(const Params& P, int l, int tid, int bid, int nblk) {
    const float* YS = (const float*)(P.ws + OFF_YS);
    const unsigned char* REC = P.ws + OFF_R2;
    const bf16_t* G = (const bf16_t*)(P.ws + OFF_R2 + R2_G);
    const float* BON = (const float*)(P.ws + OFF_BONUS);
    bf16_t* Y = (bf16_t*)(P.ws + OFF_HN);
    const float* gw = P.in[22] + l * 256; const float* gb = P.in[23] + l * 256;
    const int stride = nblk * 512;
    for (int base = bid * 512 + tid; base < NTOK * 32; base += 4 * stride) {
        f32x4 ya[4], yb[4]; u32x4 vu[4], gg[4]; float bon[4];
#pragma unroll
        for (int j = 0; j < 4; ++j) {
            const int idx = base + j * stride;
            if (idx < NTOK * 32) {
                const int l8 = idx & 7, th = idx >> 3, tok = th >> 2, h = th & 3, c = h * 64 + l8 * 8;
                ya[j] = *(const f32x4*)(YS + (size_t)tok * 256 + c); yb[j] = *(const f32x4*)(YS + (size_t)tok * 256 + c + 4);
                vu[j] = *(const u32x4*)(REC + ((size_t)tok * 4 + h) * REC_B + 256 + 2 * 128 + l8 * 16);
                gg[j] = *(const u32x4*)(G + (size_t)tok * 256 + c);
                bon[j] = BON[(size_t)tok * 4 + h];
            }
        }
#pragma unroll
        for (int j = 0; j < 4; ++j) {
            const int idx = base + j * stride;
            if (idx < NTOK * 32) {
                const int l8 = idx & 7, th = idx >> 3, tok = th >> 2, h = th & 3, c = h * 64 + l8 * 8;
                const float mean = rowsum8(((ya[j][0] + ya[j][1]) + (ya[j][2] + ya[j][3])) + ((yb[j][0] + yb[j][1]) + (yb[j][2] + yb[j][3]))) * (1.f / 64.f);
                const f32x4 da = ya[j] - mean, db = yb[j] - mean;
                const float var = rowsum8(((da[0] * da[0] + da[1] * da[1]) + (da[2] * da[2] + da[3] * da[3])) + ((db[0] * db[0] + db[1] * db[1]) + (db[2] * db[2] + db[3] * db[3]))) * (1.f / 64.f);
                const float rs = rsqrtf(var + 64e-5f);
                const f32x2_t v0 = f16x2_to_f32(vu[j][0]), v1 = f16x2_to_f32(vu[j][1]), v2 = f16x2_to_f32(vu[j][2]), v3 = f16x2_to_f32(vu[j][3]);
                const f32x2_t g0 = f16x2_to_f32(gg[j][0]), g1 = f16x2_to_f32(gg[j][1]), g2 = f16x2_to_f32(gg[j][2]), g3 = f16x2_to_f32(gg[j][3]);
                const f32x4 va = (f32x4){v0[0], v0[1], v1[0], v1[1]}, vb = (f32x4){v2[0], v2[1], v3[0], v3[1]}, ga = (f32x4){g0[0], g0[1], g1[0], g1[1]}, gbv = (f32x4){g2[0], g2[1], g3[0], g3[1]};
                const f32x4 oa = ((da * rs) * *(const f32x4*)(gw + c) + *(const f32x4*)(gb + c) + va * bon[j]) * ga;
                const f32x4 ob = ((db * rs) * *(const f32x4*)(gw + c + 4) + *(const f32x4*)(gb + c + 4) + vb * bon[j]) * gbv;
                u32x4 ov; ov[0] = cvt_pk_bf16(oa[0], oa[1]); ov[1] = cvt_pk_bf16(oa[2], oa[3]); ov[2] = cvt_pk_bf16(ob[0], ob[1]); ov[3] = cvt_pk_bf16(ob[2], ob[3]);
                *(u32x4*)(Y + (size_t)tok * 1024 + 512 + c) = ov;
            }
        }
    }
}

#define XB_TMO      128
#define XB_XCNT(j)  (256  + 64 * (j))
#define XB_XSUB(j)  (1280 + 64 * (j))
#define XB_XGEN(j)  (2304 + 64 * (j))
#define XB_TOP      3328
#define XB_TOPGEN   3392
#define XCD_BAR_WORDS 3456
#define XB_SPIN_CAP (1u << 18)

__device__ __forceinline__ unsigned xb_ld(unsigned* p)              { return __hip_atomic_load(p, __ATOMIC_RELAXED, __HIP_MEMORY_SCOPE_AGENT); }
__device__ __forceinline__ unsigned xb_add(unsigned* p, unsigned v) { return __hip_atomic_fetch_add(p, v, __ATOMIC_RELAXED, __HIP_MEMORY_SCOPE_AGENT); }
__device__ __forceinline__ unsigned xb_xcc_id() { return (unsigned)__builtin_amdgcn_s_getreg((3 << 11) | 20) & 0xFu; }
#define XB_SPIN(cond, bar) do { unsigned _sp = 0; while (cond) { __builtin_amdgcn_s_sleep(1); \
    if ((++_sp & 255u) == 0u) { if (xb_ld(&(bar)[XB_TMO])) break; if (_sp > XB_SPIN_CAP) { atomicAdd(&(bar)[XB_TMO], 1u); break; } } } } while (0)

struct XcdBarrier {
    unsigned* bar; unsigned x;
    volatile LAS unsigned* st;
};

__device__ __forceinline__ XcdBarrier xcd_barrier_post(unsigned* bar, volatile LAS unsigned* st) {
    XcdBarrier b; b.bar = bar; b.x = xb_xcc_id(); b.st = st;
    if (threadIdx.x == 0) (void)xb_add(&bar[XB_XCNT(b.x)], 1u);
    return b;
}
__device__ __forceinline__ void xcd_barrier_complete(unsigned* bar, unsigned x, unsigned& nloc, unsigned& nx) {
    const unsigned G = gridDim.x * gridDim.y * gridDim.z;
    unsigned sum, cnt, mine, sp = 0u;
    for (;;) {
        sum = 0u; cnt = 0u; mine = 0u;
#pragma unroll
        for (unsigned j = 0; j < 16; ++j) { const unsigned c = xb_ld(&bar[XB_XCNT(j)]); sum += c; cnt += (c > 0u) ? 1u : 0u; mine = (j == x) ? c : mine; }
        if (sum == G) break;
        __builtin_amdgcn_s_sleep(1);
        if ((++sp & 255u) == 0u) { if (xb_ld(&bar[XB_TMO])) break; if (sp > XB_SPIN_CAP) { atomicAdd(&bar[XB_TMO], 1u); break; } }
    }
    nloc = mine > 0u ? mine : 1u; nx = cnt > 0u ? cnt : 1u;
}

__device__ __forceinline__ void xcd_barrier(const XcdBarrier& b) {
    asm volatile("s_waitcnt vmcnt(0)" ::: "memory");
    __syncthreads();
    if (threadIdx.x == 0) {
        unsigned* bar = b.bar;
        __builtin_amdgcn_s_waitcnt(0);
        unsigned nloc = b.st[0], nx = b.st[1];
        if (nloc == 0u) { xcd_barrier_complete(bar, b.x, nloc, nx); b.st[0] = nloc; b.st[1] = nx; }
        const unsigned old = xb_add(&bar[XB_XSUB(b.x)], 1u);
        const unsigned gen = old / nloc;
        if (old + 1u == (gen + 1u) * nloc) {
            __builtin_amdgcn_fence(__ATOMIC_RELEASE, "agent");
            asm volatile("s_waitcnt vmcnt(0)" ::: "memory");
            const unsigned og = xb_add(&bar[XB_TOP], 1u);
            const unsigned tg = og / nx;
            if (og + 1u == (tg + 1u) * nx) xb_add(&bar[XB_TOPGEN], 1u);
            else XB_SPIN(xb_ld(&bar[XB_TOPGEN]) == tg, bar);
            __builtin_amdgcn_fence(__ATOMIC_ACQUIRE, "agent");
            xb_add(&bar[XB_XGEN(b.x)], 1u);
            asm volatile("s_waitcnt vmcnt(0)" ::: "memory");
        } else {
            XB_SPIN(xb_ld(&bar[XB_XGEN(b.x)]) == gen, bar);
            __builtin_amdgcn_fence(__ATOMIC_ACQUIRE, "agent");
            asm volatile("s_waitcnt vmcnt(0)" ::: "memory");
        }
    }
    __syncthreads();
}


__global__ __launch_bounds__(512, 2) void mega(Params P) {
    extern __shared__ __attribute__((aligned(16))) unsigned char shm[];
    LAS unsigned char* lds = (LAS unsigned char*)shm;
    const int nblk = gridDim.x;
    volatile LAS unsigned* bst = (volatile LAS unsigned*)(lds + 131072);
    if (threadIdx.x < 2) bst[threadIdx.x] = 0u;
    __syncthreads();
    const XcdBarrier xbar = xcd_barrier_post((unsigned*)(P.ws + WS_BAR), bst);
    float* MOD = (float*)(P.ws + OFF_MOD);
    bf16_t* HN = (bf16_t*)(P.ws + OFF_HN);
    bf16_t* ACT = (bf16_t*)(P.ws + OFF_R1);
#ifdef DIAG_TIME
    unsigned long long tA = 0, tB = 0, tprev = __builtin_amdgcn_s_memrealtime();
#endif
    for (int ph = P.ph_lo; ph < P.ph_hi; ++ph) {
#ifdef DBL_PHASE
      for (int rep = (ph > 0 && DBL_PHASE((ph - 1) % PPL)) ? 0 : 1; rep < 2; ++rep) {
#endif
        int tid = threadIdx.x, bid = blockIdx.x;
        asm volatile("" : "+v"(tid)); asm volatile("" : "+s"(bid));
        const int wid = __builtin_amdgcn_readfirstlane(tid >> 6), lane = tid & 63;
        if (ph == 0) {
#ifndef NO_MOD
            phase_mod(P, lds, tid, wid, lane, bid, nblk);
#endif
            phase_convert(P, 0, lds, wid, lane, bid, nblk);
#ifdef DIAG_POISON
            { u32x4* w = (u32x4*)(P.ws + OFF_LORA); const size_t n16 = (WS_END - OFF_LORA) / 16;
              for (size_t i = (size_t)bid * 512 + tid; i < n16; i += (size_t)nblk * 512) w[i] = (u32x4){0xAAAAAAAAu, 0xAAAAAAAAu, 0xAAAAAAAAu, 0xAAAAAAAAu}; }
#endif
        } else {
            const int l = (ph - 1) / PPL, s = (ph - 1) % PPL;
            bf16_t* HB = (bf16_t*)(P.ws + OFF_HB);
            const bool first_h = (l == 0 && s < 3), last_h = (l == DEPTH - 1 && s == PPL - 1);
            const void* hin = first_h ? (const void*)P.in[0] : (const void*)HB;
            void* hout = last_h ? (void*)P.out : (void*)HB;
            const float* modl = MOD + (size_t)l * 8 * 9216;
            bf16_t* WB = (bf16_t*)(P.ws + ((l & 1) ? OFF_WB2 : OFF_WB));
            pg8::Gemm g{HN, WB, NTOK, 1024, 1024}; pg8::EpiAny E{}; bool is_gemm = true;
            switch (s) {
            case 0:
#ifndef NO_NORM
                if (first_h) phase_norm<true>(P, hin, P.in[4] + l * 1024, modl, wid, lane, bid, nblk); else phase_norm<false>(P, hin, P.in[4] + l * 1024, modl, wid, lane, bid, nblk);
#endif
                is_gemm = false; break;
            case 1: g.Bt = WB + WB_FFN1IN; g.N = 2 * DFF; E.kind = 0; E.perm = true; E.sw.O = ACT; break;
            case 2: g.A = ACT; g.Bt = WB + WB_FFN1OUT; g.K = DFF; E.kind = 1; E.perm = true; E.rs = pg8::EpiResid{hin, hout, modl + 2 * 1024, 0.5f, first_h ? 1 : 0, last_h ? 1 : 0}; break;
            case 3: phase_norm<false>(P, hin, P.in[7] + l * 1024, modl + 3 * 1024, wid, lane, bid, nblk); is_gemm = false; break;
            case 4: g.Bt = WB + WB_MIXIN; g.N = 2560; E.kind = 2; E.perm = true; E.pj = pg8::EpiProj{(bf16_t*)(P.ws + OFF_R1), (bf16_t*)(P.ws + OFF_R1 + R1_RWKV), (bf16_t*)(P.ws + OFF_R1 + R1_CONV)}; break;
            case 5:
                for (int it = bid; it < 512; it += nblk) prep_tile<0>(P, l, it, lds, tid, wid, lane);
                is_gemm = false; break;
            case 6: {
                const int nscan = nblk >> 1;
                if (bid < nscan) phase_scan(P, lds, tid, wid, lane, bid, nscan);
                else {
                    const int vb = bid - nscan, vn = nblk - nscan;
                    for (int it = vb; it < 512; it += vn) attn_item(P, l, it, lds, tid, wid, lane, P.ph_lo < 0 ? 0 : ATTN_VAR(l));
                    conv_part(P, l, tid, vb, vn);
                    for (int it = vb; it < 512; it += vn) prep_tile<1>(P, l, it, lds, tid, wid, lane);
                    if (l + 1 < DEPTH) phase_convert(P, l + 1, lds, wid, lane, vb, vn);
                }
                is_gemm = false; } break;
            case 7: phase_post(P, l, tid, bid, nblk); is_gemm = false; break;
            case 8: g.Bt = WB + WB_MIXOUT; E.kind = 1; E.perm = true; E.rs = pg8::EpiResid{hin, hout, modl + 5 * 1024, 1.0f, first_h ? 1 : 0, last_h ? 1 : 0}; break;
            case 9: phase_norm<false>(P, hin, P.in[25] + l * 1024, modl + 6 * 1024, wid, lane, bid, nblk); is_gemm = false; break;
            case 10: g.Bt = WB + WB_FFN2IN; g.N = 2 * DFF; E.kind = 0; E.perm = true; E.sw.O = ACT; break;
            default: g.A = ACT; g.Bt = WB + WB_FFN2OUT; g.K = DFF; E.kind = 1; E.perm = true; E.rs = pg8::EpiResid{hin, hout, modl + 8 * 1024, 0.5f, first_h ? 1 : 0, last_h ? 1 : 0}; break;
            }
            if (is_gemm) { pg8::StaticOrder S; S.init(NTOK, g.N, nblk, bid); pg8::gemm_phase<pg8::EpiAny, pg8::StaticOrder, GEMM_ALIGN, GEMM_SP2>(lds, g, S, E, tid); }
        }
#ifdef DIAG_TIME
        const unsigned long long twork = __builtin_amdgcn_s_memrealtime();
        cg::this_grid().sync();
        { const unsigned long long tnow = __builtin_amdgcn_s_memrealtime(); const int sx = ph == 0 ? -1 : (ph - 1) % PPL;
          if (TSEL_A(sx)) tA += (TWAIT_A ? tnow - twork : tnow - tprev);
          if (TSEL_B(sx)) tB += (TWAIT_B ? tnow - twork : tnow - tprev);
          tprev = tnow; }
#else
#ifdef DBL_PHASE
        cg::this_grid().sync();
      }
#else
        if (ph + 1 < P.ph_hi) { if (P.ph_hi > 100000) cg::this_grid().sync(); else xcd_barrier(xbar); }
#ifdef EXTRA_SYNC
        if (ph + 1 < P.ph_hi) { cg::this_grid().sync(); }
#endif
#endif
#endif
    }
#ifdef DIAG_TIME
    {
        unsigned long long* tw = (unsigned long long*)(P.ws + WS_END);
        if (blockIdx.x == 0 && threadIdx.x == 0) { tw[0] = tA; tw[1] = tB; __threadfence(); }
        cg::this_grid().sync();
        const float fa = (float)__hip_atomic_load(tw, __ATOMIC_RELAXED, __HIP_MEMORY_SCOPE_AGENT) * 0.01f * 100.0f, fb = (float)__hip_atomic_load(tw + 1, __ATOMIC_RELAXED, __HIP_MEMORY_SCOPE_AGENT) * 0.01f;
        for (size_t i = (size_t)blockIdx.x * 512 + threadIdx.x; i < (size_t)NTOK * 1024; i += (size_t)gridDim.x * 512) P.out[i] = (i == 0) ? fa : fb;
    }
#endif
}


#ifdef DIAG_SELFTEST
__global__ void diag_checksum(const unsigned* p, size_t nwords, unsigned long long* slot) {
    unsigned long long acc = 0;
    for (size_t i = (size_t)blockIdx.x * blockDim.x + threadIdx.x; i < nwords; i += (size_t)gridDim.x * blockDim.x) acc += (unsigned long long)p[i] * (unsigned long long)(2 * i + 1);
    for (int o = 1; o < 64; o <<= 1) acc += __shfl_xor(acc, o);
    if ((threadIdx.x & 63) == 0) atomicAdd(slot, acc);
}
__global__ void diag_report(const unsigned long long* slots, int nitems, int nrep, float* out, size_t n) {
    int code = 0;
    for (int k = 0; k < nitems; ++k) for (int r = 1; r < nrep; ++r) if (slots[k * nrep + r] != slots[k * nrep]) { code |= 1 << k; break; }
    if (code == 0) return;
    const float c = 4.0f * exp2f((float)code);
    for (size_t i = (size_t)blockIdx.x * blockDim.x + threadIdx.x; i < n; i += (size_t)gridDim.x * blockDim.x) out[i] = c;
}
#endif
extern "C" void kernel_launch(void* const* d_in, const int* in_sizes, int n_in, void* d_out, int out_size, void* d_ws, size_t ws_size, hipStream_t stream) {
    static int grid = 0;
    if (grid == 0) {
        if (n_in != 28 || out_size != NTOK * DM || ws_size < WS_END) { fprintf(stderr, "kernel_launch: unexpected shapes (n_in %d out %d ws %zu need %zu)\n", n_in, out_size, ws_size, (size_t)WS_END); grid = -1; return; }
        int dev = 0, cus = 0, per_cu = 0;
        hipGetDevice(&dev); hipDeviceGetAttribute(&cus, hipDeviceAttributeMultiprocessorCount, dev);
        if (hipFuncSetAttribute((const void*)mega, hipFuncAttributeMaxDynamicSharedMemorySize, LDS_BYTES) != hipSuccess) { fprintf(stderr, "kernel_launch: hipFuncSetAttribute failed\n"); grid = -1; return; }
        if (hipOccupancyMaxActiveBlocksPerMultiprocessor(&per_cu, (const void*)mega, 512, LDS_BYTES) != hipSuccess || per_cu < 1) { fprintf(stderr, "kernel_launch: occupancy query failed (%d)\n", per_cu); per_cu = 1; (void)hipGetLastError(); }
        grid = cus * per_cu;
    }
    if (grid < 0) return;
    Params p{};
    for (int i = 0; i < 28; ++i) p.in[i] = (const float*)d_in[i];
    p.out = (float*)d_out; p.ws = (unsigned char*)d_ws;
#if MK_LAUNCHES == 1
    if (hipMemsetAsync((unsigned char*)d_ws + WS_BAR, 0, 16384, stream) != hipSuccess) { fprintf(stderr, "kernel_launch: memset of barrier words failed\n"); return; }
    p.ph_lo = 0; p.ph_hi = NPH;
    void* args[] = {&p};
    hipError_t e = hipLaunchCooperativeKernel((const void*)mega, dim3(grid), dim3(512), args, LDS_BYTES, stream);
    if (e != hipSuccess) fprintf(stderr, "cooperative launch failed: %s (grid %d)\n", hipGetErrorString(e), grid);
#else
#ifdef DIAG_SELFTEST
    {
        constexpr int NREP = 4;
        unsigned long long* slots = (unsigned long long*)((unsigned char*)d_ws + WS_END);
        hipMemsetAsync(slots, 0, 64 * NREP * 8, stream);
        int item = 0;
        for (int ph = 0; ph < NPH; ++ph) {
            p.ph_lo = ph; p.ph_hi = ph + 1; hipLaunchKernelGGL(mega, dim3(grid), dim3(512), LDS_BYTES, stream, p);
            if (ph == 0) continue;
            const int l = (ph - 1) / PPL, s = (ph - 1) % PPL;
            size_t off = 0, len = 0; bool test = (s == 5);
            switch (s) {
            case 0: off = OFF_LORA; len = OFF_R1 - OFF_LORA; break;
            case 1: case 12: off = OFF_R1; len = (size_t)NTOK * DFF * 2; break;
            case 2: test = false; break;
            case 3: case 5: case 7: case 9: case 11: off = OFF_HN; len = (size_t)NTOK * 1024 * 2; break;
            case 4: off = OFF_R1; len = R1_BYTES; break;
            case 6: off = OFF_R2; len = WS_END - OFF_R2; break;
            case 8: off = OFF_R1 + R1_RWKV; len = (size_t)NTOK * 256 * 4; break;
            default: test = false; break;
            }
            if (!test) continue;
            const unsigned* base = (s == 2) ? (const unsigned*)d_out : (const unsigned*)((unsigned char*)d_ws + off);
            const size_t nw = (s == 2) ? (size_t)NTOK * 1024 : len / 4;
            for (int r = 0; r < NREP; ++r) {
                if (r > 0) hipLaunchKernelGGL(mega, dim3(grid), dim3(512), LDS_BYTES, stream, p);
                hipLaunchKernelGGL(diag_checksum, dim3(2048), dim3(256), 0, stream, base, nw, slots + item * NREP + r);
            }
            ++item;
        }
        hipLaunchKernelGGL(diag_report, dim3(2048), dim3(256), 0, stream, (const unsigned long long*)slots, item, NREP, (float*)d_out, (size_t)NTOK * 1024);
    }
#else
    for (int ph = 0; ph < NPH; ++ph) { p.ph_lo = ph; p.ph_hi = ph + 1; hipLaunchKernelGGL(mega, dim3(grid), dim3(512), LDS_BYTES, stream, p); }
#endif
#endif
}
```
